# Optimizing an MI355X kernel written in HIP

```python
import math
import jax, jax.numpy as jnp
from jax import lax
import numpy as np

D_MODEL = 1024
BATCH = 16
SEQ = 256
DEPTH = 4
DEC_BATCH = 4
DEC_SEQ = 4096
PAST_LEN = 256

GRID_W = 64
N_EVEN = (DEPTH + 1) // 2
N_ODD = DEPTH // 2

FNET_W = D_MODEL // 2
FNET_GROUPS = 4
FNET_GW = FNET_W // FNET_GROUPS
CONV_W = D_MODEL // 2
CONV_K = 3
EVEN_IN = FNET_W + 3 * CONV_W
EVEN_MIX = FNET_W + CONV_W

LRU_W = D_MODEL // 2
LRU_HEADS = 8
LRU_HD = LRU_W // LRU_HEADS
LRU_CONV_K = 4
LRU_C = 8.0
WKV_W = D_MODEL // 2
WKV_N = 64
WKV_H = WKV_W // WKV_N
DECAY_RANK = 64
ICLR_RANK = 64
GATE_RANK = 128
WKV_IN = 3 * WKV_W + 2 * DECAY_RANK + 2 * ICLR_RANK + GATE_RANK
ODD_IN = 2 * LRU_W + WKV_IN
ODD_MIX = LRU_W + WKV_W
DECAY_SCALE = math.exp(-0.5)
WKV_GN_EPS = 64e-5

PEER_HEADS = 8
N_KEYS = 128
N_EXPERTS = N_KEYS * N_KEYS
PEER_TOPK = 16
PEER_DK = 256
PEER_HALF = PEER_DK // 2
PEER_BLOCK = 128

ALPHA = (2 * DEPTH) ** 0.25
BETA = (8 * DEPTH) ** -0.25
LN_EPS = 1e-6

kernel_name = 'hybrid_fnet_conv_rglru_rwkv7_peer_diffusion_step'


def _layer_norm(x, g=None, b=None, eps=LN_EPS):
    xf = x.astype(jnp.float32)
    mu = xf.mean(-1, keepdims=True)
    var = jnp.square(xf - mu).mean(-1, keepdims=True)
    y = (xf - mu) * lax.rsqrt(var + eps)
    if g is not None:
        y = y * g.astype(jnp.float32) + b.astype(jnp.float32)
    return y.astype(x.dtype)


def _sincos(pos, dim):
    omega = 1.0 / (10000.0 ** (jnp.arange(dim // 2, dtype=jnp.float32) / (dim // 2)))
    ang = pos.astype(jnp.float32)[:, None] * omega[None, :]
    return jnp.concatenate([jnp.sin(ang), jnp.cos(ang)], -1)


def _grid_pos_embed(n_tok):
    rows = n_tok // GRID_W
    half = D_MODEL // 2
    er = _sincos(jnp.arange(rows), half)
    ec = _sincos(jnp.arange(GRID_W), half)
    emb = jnp.concatenate([jnp.broadcast_to(er[:, None, :], (rows, GRID_W, half)),
                           jnp.broadcast_to(ec[None, :, :], (rows, GRID_W, half))], -1)
    return emb.reshape(rows * GRID_W, D_MODEL)


def _modulation(cvec, w_mod, b_mod):
    m = jax.nn.silu(cvec) @ w_mod + b_mod
    return jnp.split(m[:, None, :], 6, axis=-1)


def _fourier_mix(a):
    B, S, _ = a.shape
    ag = a.astype(jnp.float32).reshape(B, S, FNET_GROUPS, FNET_GW)
    y = jnp.fft.fft2(ag, axes=(1, 3), norm='ortho').real
    return y.reshape(B, S, FNET_W).astype(a.dtype)


def _short_conv_mix(bg, cg, xin, w, bias):
    S = xin.shape[1]
    zp = jnp.pad(cg * xin, ((0, 0), (1, 1), (0, 0)))
    y = zp[:, 0:S] * w[0] + zp[:, 1:S + 1] * w[1] + zp[:, 2:S + 2] * w[2] + bias
    return bg * y


def _linear_scan(a, b, h0):
    def comb(l, r):
        return (l[0] * r[0], r[0] * l[1] + r[1])
    a_cum, b_cum = lax.associative_scan(comb, (a, b), axis=1)
    h = a_cum * h0[:, None, :] + b_cum
    return h, h[:, -1]


def _rglru_dir(xs, conv_w, conv_b, wa, ba, wx, bx, lam, h0):
    f32 = jnp.float32
    B, S, _ = xs.shape
    xs = xs.astype(f32)
    xp = jnp.pad(xs, ((0, 0), (LRU_CONV_K - 1, 0), (0, 0)))
    xc = conv_b.astype(f32) + xp[:, 0:S] * conv_w[0].astype(f32)
    for j in range(1, LRU_CONV_K):
        xc = xc + xp[:, j:j + S] * conv_w[j].astype(f32)
    xh = xc.reshape(B, S, LRU_HEADS, LRU_HD)
    gate_r = jax.nn.sigmoid(jnp.einsum('bshi,hij->bshj', xh, wa.astype(f32)).reshape(B, S, LRU_W) + ba.astype(f32))
    gate_i = jax.nn.sigmoid(jnp.einsum('bshi,hij->bshj', xh, wx.astype(f32)).reshape(B, S, LRU_W) + bx.astype(f32))
    log_a = -LRU_C * gate_r * jax.nn.softplus(-lam.astype(f32))
    a = jnp.exp(log_a)
    b = jnp.sqrt(-jnp.expm1(2.0 * log_a)) * (gate_i * xc)
    return _linear_scan(a, b, h0)


def _lru_mix(xb, gb, conv_w, conv_b, wa, ba, wx, bx, lam, h0):
    y = 0.0
    finals = []
    for d in range(2):
        xs = xb if d == 0 else xb[:, ::-1]
        h, hf = _rglru_dir(xs, conv_w[d], conv_b[d], wa[d], ba[d], wx[d], bx[d], lam[d],
                           h0[:, d].astype(jnp.float32))
        y = y + (h if d == 0 else h[:, ::-1])
        finals.append(hf)
    y = y * jax.nn.gelu(gb.astype(jnp.float32))
    return y, jnp.stack(finals, 1)


def _wkv_scan(r, w, k, v, kk, a, s0):
    def step(state, inp):
        r_t, w_t, k_t, v_t, kk_t, a_t = inp
        sk = jnp.einsum('bhij,bhj->bhi', state, kk_t)
        state = (state * w_t[:, :, None, :]
                 - sk[..., None] * (kk_t * a_t)[:, :, None, :]
                 + v_t[..., None] * k_t[:, :, None, :])
        return state, jnp.einsum('bhij,bhj->bhi', state, r_t)
    xs = tuple(jnp.moveaxis(t, 1, 0) for t in (r, w, k, v, kk, a))
    s_fin, ys = lax.scan(step, s0, xs)
    return jnp.moveaxis(ys, 0, 1), s_fin


def _rwkv_mix(z, mu, w0, w2, a0, a2, k_k, k_a, r_k, g2, gn_g, gn_b, s0):
    f32 = jnp.float32
    B, S, _ = z.shape
    z = z.astype(f32)
    zp = jnp.pad(z, ((0, 0), (1, 1), (0, 0)))
    z = z + mu.astype(f32) * (0.5 * (zp[:, 0:S] + zp[:, 2:S + 2]) - z)
    o1 = WKV_W
    o2 = o1 + WKV_W
    o3 = o2 + WKV_W
    o4 = o3 + 2 * DECAY_RANK
    o5 = o4 + 2 * ICLR_RANK
    r, k, v = z[..., 0:o1], z[..., o1:o2], z[..., o2:o3]
    wd, ad, gd = z[..., o3:o4], z[..., o4:o5], z[..., o5:]
    g = jax.nn.sigmoid(gd) @ g2.astype(f32)
    heads = lambda t: t.reshape(B, S, WKV_H, WKV_N)
    r_h, v_h = heads(r), heads(v)
    y_sum = 0.0
    bonus = 0.0
    finals = []
    for d in range(2):
        wz = w0[d] + jnp.tanh(wd[..., d * DECAY_RANK:(d + 1) * DECAY_RANK]) @ w2[d].astype(f32)
        decay = heads(jnp.exp(-DECAY_SCALE * jax.nn.sigmoid(wz)))
        iclr = jax.nn.sigmoid(a0[d] + ad[..., d * ICLR_RANK:(d + 1) * ICLR_RANK] @ a2[d].astype(f32))
        kk = heads(k * k_k[d])
        kk = kk * lax.rsqrt(jnp.maximum(jnp.sum(kk * kk, -1, keepdims=True), 1e-24))
        km = heads(k * (1.0 + (iclr - 1.0) * k_a[d]))
        seqs = (r_h, decay, km, v_h, kk, heads(iclr))
        if d == 1:
            seqs = tuple(t[:, ::-1] for t in seqs)
        y, s_fin = _wkv_scan(*seqs, s0[:, d].astype(f32))
        y_sum = y_sum + (y if d == 0 else y[:, ::-1])
        bonus = bonus + jnp.sum(r_h * km * r_k.astype(f32), -1, keepdims=True) * v_h
        finals.append(s_fin)
    m = y_sum.mean(-1, keepdims=True)
    var = jnp.square(y_sum - m).mean(-1, keepdims=True)
    yn = ((y_sum - m) * lax.rsqrt(var + WKV_GN_EPS)).reshape(B, S, WKV_W) * gn_g + gn_b
    out = (yn + bonus.reshape(B, S, WKV_W)) * g
    return out, jnp.stack(finals, 1)


def _peer(h, wq, keys, u_tab, v_tab):
    B, S, D = h.shape
    T = B * S
    ht = h.reshape(T, D)
    q = (ht @ wq).reshape(T, PEER_HEADS, 2, PEER_HALF)
    s = jnp.einsum('thpc,hpkc->thpk', q, keys).astype(jnp.float32)
    v1, i1 = lax.top_k(s[:, :, 0], PEER_TOPK)
    v2, i2 = lax.top_k(s[:, :, 1], PEER_TOPK)
    cand = (v1[..., :, None] + v2[..., None, :]).reshape(T, PEER_HEADS, PEER_TOPK * PEER_TOPK)
    sc, ci = lax.top_k(cand, PEER_TOPK)
    e1 = jnp.take_along_axis(i1, ci // PEER_TOPK, -1)
    e2 = jnp.take_along_axis(i2, ci % PEER_TOPK, -1)
    idx = e1 * N_KEYS + e2
    gate = jax.nn.softmax(sc, axis=-1).astype(h.dtype)
    nb = T // PEER_BLOCK

    def block(args):
        hb, ib, gb = args
        act = jax.nn.gelu(jnp.einsum('td,thkd->thk', hb, u_tab[ib]))
        return jnp.einsum('thk,thkd->td', gb * act, v_tab[ib])

    out = lax.map(block, (ht.reshape(nb, PEER_BLOCK, D),
                          idx.reshape(nb, PEER_BLOCK, PEER_HEADS, PEER_TOPK),
                          gate.reshape(nb, PEER_BLOCK, PEER_HEADS, PEER_TOPK)))
    return out.reshape(B, S, D)


def _trunk(x, cvec, lru_state, wkv_state, P):
    lru_out = []
    wkv_out = []
    for l in range(DEPTH):
        sh1, sc1, g1, sh2, sc2, g2 = _modulation(cvec, P['w_mod'][l], P['b_mod'][l])
        h = _layer_norm(x) * (1.0 + sc1) + sh1
        j = l // 2
        if l % 2 == 0:
            z = h @ P['w_in_e'][j]
            a_in = z[..., 0:FNET_W]
            b_g = z[..., FNET_W:FNET_W + CONV_W]
            c_g = z[..., FNET_W + CONV_W:FNET_W + 2 * CONV_W]
            x_in = z[..., FNET_W + 2 * CONV_W:]
            y = jnp.concatenate([_fourier_mix(a_in),
                                 _short_conv_mix(b_g, c_g, x_in, P['sconv_w'][j], P['sconv_b'][j])], -1)
            mix = y.astype(x.dtype) @ P['w_out_e'][j]
        else:
            z = h @ P['w_in_o'][j]
            y_lru, h_fin = _lru_mix(z[..., 0:LRU_W], z[..., LRU_W:2 * LRU_W],
                                    P['lru_conv_w'][j], P['lru_conv_b'][j], P['lru_wa'][j], P['lru_ba'][j],
                                    P['lru_wx'][j], P['lru_bx'][j], P['lru_lambda'][j], lru_state[:, j])
            y_wkv, s_fin = _rwkv_mix(z[..., 2 * LRU_W:], P['wkv_mu'][j], P['wkv_w0'][j], P['wkv_w2'][j],
                                     P['wkv_a0'][j], P['wkv_a2'][j], P['wkv_kk'][j], P['wkv_ka'][j],
                                     P['wkv_rk'][j], P['wkv_g2'][j], P['wkv_gn_g'][j], P['wkv_gn_b'][j],
                                     wkv_state[:, j])
            mix = jnp.concatenate([y_lru, y_wkv], -1).astype(x.dtype) @ P['w_out_o'][j]
            lru_out.append(h_fin)
            wkv_out.append(s_fin)
        x = _layer_norm(ALPHA * x + g1 * mix, P['ln1_g'][l], P['ln1_b'][l])
        h2 = _layer_norm(x) * (1.0 + sc2) + sh2
        ffn = _peer(h2, P['peer_wq'][l], P['peer_keys'][l], P['peer_u'][l], P['peer_v'][l])
        x = _layer_norm(ALPHA * x + g2 * ffn, P['ln2_g'][l], P['ln2_b'][l])
    return x, jnp.stack(lru_out, 1), jnp.stack(wkv_out, 1)


def setup_inputs(seed: int = 0) -> dict:
    key = jax.random.key(seed)
    ks = list(jax.random.split(key, 48))
    f32 = jnp.float32

    def nrm(i, shape, scale):
        return jax.random.normal(ks[i], shape, f32) * scale

    a_init = 0.9 + 0.099 * jax.random.uniform(ks[40], (N_ODD, 2, LRU_W), f32)
    return {
        'x_prompt': nrm(0, (BATCH, SEQ, D_MODEL), 1.0),
        'x_sample': nrm(1, (DEC_BATCH, DEC_SEQ, D_MODEL), 1.0),
        'state_lru': nrm(2, (DEC_BATCH, N_ODD, 2, LRU_W), 0.5),
        'state_wkv': nrm(3, (DEC_BATCH, N_ODD, 2, WKV_H, WKV_N, WKV_N), 0.5),
        'c': nrm(4, (DEC_BATCH, D_MODEL), 1.0),
        'c_ctx': nrm(5, (D_MODEL,), 1.0),
        'w_mod': nrm(6, (DEPTH, D_MODEL, 6 * D_MODEL), 0.2 * D_MODEL ** -0.5),
        'b_mod': nrm(7, (DEPTH, 6 * D_MODEL), 0.01),
        'ln1_g': 1.0 + nrm(8, (DEPTH, D_MODEL), 0.01),
        'ln1_b': nrm(9, (DEPTH, D_MODEL), 0.01),
        'ln2_g': 1.0 + nrm(10, (DEPTH, D_MODEL), 0.01),
        'ln2_b': nrm(11, (DEPTH, D_MODEL), 0.01),
        'w_in_e': nrm(12, (N_EVEN, D_MODEL, EVEN_IN), D_MODEL ** -0.5),
        'w_out_e': nrm(13, (N_EVEN, EVEN_MIX, D_MODEL), BETA * EVEN_MIX ** -0.5),
        'sconv_w': nrm(14, (N_EVEN, CONV_K, CONV_W), CONV_K ** -0.5),
        'sconv_b': nrm(15, (N_EVEN, CONV_W), 0.01),
        'w_in_o': nrm(16, (N_ODD, D_MODEL, ODD_IN), D_MODEL ** -0.5),
        'w_out_o': nrm(17, (N_ODD, ODD_MIX, D_MODEL), BETA * ODD_MIX ** -0.5),
        'lru_conv_w': nrm(18, (N_ODD, 2, LRU_CONV_K, LRU_W), 0.5),
        'lru_conv_b': nrm(19, (N_ODD, 2, LRU_W), 0.01),
        'lru_wa': nrm(20, (N_ODD, 2, LRU_HEADS, LRU_HD, LRU_HD), LRU_HD ** -0.5),
        'lru_ba': nrm(21, (N_ODD, 2, LRU_W), 0.01),
        'lru_wx': nrm(22, (N_ODD, 2, LRU_HEADS, LRU_HD, LRU_HD), LRU_HD ** -0.5),
        'lru_bx': nrm(23, (N_ODD, 2, LRU_W), 0.01),
        'lru_lambda': jnp.log(a_init) - jnp.log1p(-a_init),
        'wkv_mu': jax.random.uniform(ks[24], (N_ODD, WKV_IN), f32),
        'wkv_w0': nrm(25, (N_ODD, 2, WKV_W), 0.5),
        'wkv_w2': nrm(26, (N_ODD, 2, DECAY_RANK, WKV_W), 0.1),
        'wkv_a0': nrm(27, (N_ODD, 2, WKV_W), 0.5),
        'wkv_a2': nrm(28, (N_ODD, 2, ICLR_RANK, WKV_W), 0.1),
        'wkv_kk': 1.0 + nrm(29, (N_ODD, 2, WKV_W), 0.1),
        'wkv_ka': 1.0 + nrm(30, (N_ODD, 2, WKV_W), 0.1),
        'wkv_rk': nrm(31, (N_ODD, WKV_H, WKV_N), 0.1),
        'wkv_g2': nrm(32, (N_ODD, GATE_RANK, WKV_W), GATE_RANK ** -0.5),
        'wkv_gn_g': 1.0 + nrm(33, (N_ODD, WKV_W), 0.01),
        'wkv_gn_b': nrm(34, (N_ODD, WKV_W), 0.01),
        'peer_wq': nrm(35, (DEPTH, D_MODEL, PEER_HEADS * PEER_DK), D_MODEL ** -0.5),
        'peer_keys': nrm(36, (DEPTH, PEER_HEADS, 2, N_KEYS, PEER_HALF), PEER_HALF ** -0.5),
        'peer_u': nrm(37, (DEPTH, N_EXPERTS, D_MODEL), D_MODEL ** -0.5),
        'peer_v': nrm(38, (DEPTH, N_EXPERTS, D_MODEL), BETA),
    }


def reference(x_prompt, x_sample, state_lru, state_wkv, c, c_ctx, w_mod, b_mod, ln1_g, ln1_b, ln2_g, ln2_b,
              w_in_e, w_out_e, sconv_w, sconv_b, w_in_o, w_out_o, lru_conv_w, lru_conv_b, lru_wa, lru_ba,
              lru_wx, lru_bx, lru_lambda, wkv_mu, wkv_w0, wkv_w2, wkv_a0, wkv_a2, wkv_kk, wkv_ka, wkv_rk,
              wkv_g2, wkv_gn_g, wkv_gn_b, peer_wq, peer_keys, peer_u, peer_v):
    P = dict(w_mod=w_mod, b_mod=b_mod, ln1_g=ln1_g, ln1_b=ln1_b, ln2_g=ln2_g, ln2_b=ln2_b,
             w_in_e=w_in_e, w_out_e=w_out_e, sconv_w=sconv_w, sconv_b=sconv_b,
             w_in_o=w_in_o, w_out_o=w_out_o, lru_conv_w=lru_conv_w, lru_conv_b=lru_conv_b,
             lru_wa=lru_wa, lru_ba=lru_ba, lru_wx=lru_wx, lru_bx=lru_bx, lru_lambda=lru_lambda,
             wkv_mu=wkv_mu, wkv_w0=wkv_w0, wkv_w2=wkv_w2, wkv_a0=wkv_a0, wkv_a2=wkv_a2,
             wkv_kk=wkv_kk, wkv_ka=wkv_ka, wkv_rk=wkv_rk, wkv_g2=wkv_g2, wkv_gn_g=wkv_gn_g,
             wkv_gn_b=wkv_gn_b, peer_wq=peer_wq, peer_keys=peer_keys, peer_u=peer_u, peer_v=peer_v)

    bp = x_prompt.shape[0]
    lru0 = jnp.zeros((bp, N_ODD, 2, LRU_W), jnp.float32)
    wkv0 = jnp.zeros((bp, N_ODD, 2, WKV_H, WKV_N, WKV_N), jnp.float32)
    y_prompt, lru_new, wkv_new = _trunk(x_prompt, c_ctx[None, :], lru0, wkv0, P)

    xs = x_sample + _grid_pos_embed(x_sample.shape[1]).astype(x_sample.dtype)[None]
    y_sample, _, _ = _trunk(xs, c, state_lru, state_wkv, P)

    return (y_prompt, y_sample, lru_new.astype(x_prompt.dtype), wkv_new.astype(x_prompt.dtype))
```

```cpp
#include <hip/hip_runtime.h>
#include <hip/hip_cooperative_groups.h>
#include <cstdio>
#include <cstdint>
namespace cg = cooperative_groups;

#ifndef MULTI
#define MULTI 0
#endif

typedef unsigned short bf16_t;
using bf16x8 = __attribute__((ext_vector_type(8))) short;
using f32x16 = __attribute__((ext_vector_type(16))) float;
#define DI __device__ __forceinline__
#define MFMA(a, b, c) __builtin_amdgcn_mfma_f32_32x32x16_bf16((a), (b), (c), 0, 0, 0)

constexpr int T = 20480;
constexpr int NTHR = 256;
constexpr int LDS_BYTES = 71680;
constexpr float ALPHA_F = 1.681792830507429f;

constexpr size_t MiB = 1u << 20;
constexpr size_t OFF_TABU = 0;
constexpr size_t OFF_TABV = OFF_TABU + 32 * MiB;
constexpr size_t OFF_BT_IN_E = OFF_TABV + 32 * MiB;
constexpr size_t OFF_BT_OUT_E = OFF_BT_IN_E + 10 * MiB;
constexpr size_t OFF_BT_IN_O = OFF_BT_OUT_E + 4 * MiB;
constexpr size_t OFF_BT_OUT_O = OFF_BT_IN_O + 12 * MiB;
constexpr size_t OFF_BT_WQ = OFF_BT_OUT_O + 4 * MiB;
constexpr size_t OFF_BT_W2 = OFF_BT_WQ + 16 * MiB;
constexpr size_t OFF_BT_A2 = OFF_BT_W2 + 256 * 1024;
constexpr size_t OFF_BT_G2 = OFF_BT_A2 + 256 * 1024;
constexpr size_t OFF_BT_GATE = OFF_BT_G2 + 256 * 1024;
constexpr size_t OFF_D256 = OFF_BT_GATE + 2 * MiB;
constexpr size_t OFF_MOD = OFF_D256 + 256 * 1024;
constexpr size_t OFF_D4096 = OFF_MOD + 512 * 1024;
constexpr size_t OFF_X = OFF_D4096 + 64 * MiB;
constexpr size_t OFF_Z = OFF_X + 80 * MiB;
constexpr size_t OFF_YMIX = OFF_Z + 115 * MiB;
constexpr size_t OFF_MIX = OFF_YMIX + 40 * MiB;
constexpr size_t OFF_H = OFF_MIX + 80 * MiB;
constexpr size_t OFF_XC = OFF_H + 40 * MiB;
constexpr size_t OFF_LRIN = OFF_XC + 40 * MiB;
constexpr size_t OFF_KKN = OFF_LRIN + 15 * MiB;
constexpr size_t OFF_KS = OFF_KKN + 40 * MiB;
constexpr size_t OFF_RS = OFF_KS + 20 * MiB;
constexpr size_t OFF_VS = OFF_RS + 20 * MiB;
constexpr size_t OFF_LB = OFF_VS + 20 * MiB;
constexpr size_t OFF_WD = OFF_LB + 40 * MiB;
constexpr size_t OFF_KKA = OFF_WD + 80 * MiB;
constexpr size_t OFF_KM = OFF_KKA + 40 * MiB;
constexpr size_t OFF_G = OFF_KM + 40 * MiB;
constexpr size_t WS_END = OFF_G + 20 * MiB;

struct Params {
  const float* in[40];
  float* out;
  unsigned char* ws;
};

enum {
  I_XP = 0, I_XS, I_SLRU, I_SWKV, I_C, I_CCTX, I_WMOD, I_BMOD, I_LN1G, I_LN1B, I_LN2G, I_LN2B, I_WINE, I_WOUTE, I_SCW, I_SCB,
  I_WINO, I_WOUTO, I_LCW, I_LCB, I_LWA, I_LBA, I_LWX, I_LBX, I_LLAM, I_MU, I_W0, I_W2, I_A0, I_A2, I_KK, I_KA, I_RK, I_G2, I_GNG,
  I_GNB, I_WQ, I_KEYS, I_PU, I_PV
};

DI int tidx() { int t = __builtin_amdgcn_workitem_id_x(); asm volatile("" : "+v"(t)); return t; }
DI unsigned f2bf(float x) { unsigned u = __float_as_uint(x); u += 0x7fffu + ((u >> 16) & 1u); return u >> 16; }
DI unsigned pack2(float a, float b) { return f2bf(a) | (f2bf(b) << 16); }
DI float bflo(unsigned u) { return __uint_as_float(u << 16); }
DI float bfhi(unsigned u) { return __uint_as_float(u & 0xffff0000u); }
DI float bf2f(bf16_t h) { return __uint_as_float(((unsigned)h) << 16); }
DI float sigm(float x) { return 1.f / (1.f + __expf(-x)); }
DI float gelu_t(float x) { float u = 0.7978845608028654f * (x + 0.044715f * x * x * x); return x * sigm(2.f * u); }
DI float tanh_f(float x) { return 2.f * sigm(2.f * x) - 1.f; }

template <int CTRL> DI float dpp_mov(float x) {
  return __int_as_float(__builtin_amdgcn_update_dpp(0, __float_as_int(x), CTRL, 0xF, 0xF, true));
}
DI float sum8(float x) { x += dpp_mov<0xB1>(x); x += dpp_mov<0x4E>(x); x += dpp_mov<0x141>(x); return x; }
DI float sum16(float x) { x = sum8(x); x += dpp_mov<0x140>(x); return x; }
DI float max16(float x) {
  x = fmaxf(x, dpp_mov<0xB1>(x)); x = fmaxf(x, dpp_mov<0x4E>(x)); x = fmaxf(x, dpp_mov<0x141>(x)); x = fmaxf(x, dpp_mov<0x140>(x));
  return x;
}
DI float wave_sum(float x) { x = sum16(x); x += __shfl_xor(x, 16); x += __shfl_xor(x, 32); return x; }

DI void tok_info(int t, int& seq, int& s, int& S, int& cv) {
  if (t < 4096) { seq = t >> 8; s = t & 255; S = 256; cv = 0; }
  else { int u = t - 4096; seq = 16 + (u >> 12); s = u & 4095; S = 4096; cv = 1 + (u >> 12); }
}
DI size_t pqt_base(int seq) { return seq < 16 ? (size_t)seq * 512 * 512 : (size_t)16 * 512 * 512 + (size_t)(seq - 16) * 512 * 8192; }

DI void load_row(const float* p, int lane, float (&v)[16]) {
  const float4* q = (const float4*)(p + lane * 8);
  float4 a = q[0], b = q[1];
  const float4* q2 = (const float4*)(p + 512 + lane * 8);
  float4 c = q2[0], d = q2[1];
  v[0] = a.x; v[1] = a.y; v[2] = a.z; v[3] = a.w; v[4] = b.x; v[5] = b.y; v[6] = b.z; v[7] = b.w;
  v[8] = c.x; v[9] = c.y; v[10] = c.z; v[11] = c.w; v[12] = d.x; v[13] = d.y; v[14] = d.z; v[15] = d.w;
}
DI void store_row(float* p, int lane, const float (&v)[16]) {
  float4* q = (float4*)(p + lane * 8);
  q[0] = make_float4(v[0], v[1], v[2], v[3]); q[1] = make_float4(v[4], v[5], v[6], v[7]);
  float4* q2 = (float4*)(p + 512 + lane * 8);
  q2[0] = make_float4(v[8], v[9], v[10], v[11]); q2[1] = make_float4(v[12], v[13], v[14], v[15]);
}
DI void store_row_bf(bf16_t* p, int lane, const float (&v)[16]) {
  uint4 a, b;
  a.x = pack2(v[0], v[1]); a.y = pack2(v[2], v[3]); a.z = pack2(v[4], v[5]); a.w = pack2(v[6], v[7]);
  b.x = pack2(v[8], v[9]); b.y = pack2(v[10], v[11]); b.z = pack2(v[12], v[13]); b.w = pack2(v[14], v[15]);
  *(uint4*)(p + lane * 8) = a;
  *(uint4*)(p + 512 + lane * 8) = b;
}
DI void unpack8(uint4 u, float (&v)[8]) {
  v[0] = bflo(u.x); v[1] = bfhi(u.x); v[2] = bflo(u.y); v[3] = bfhi(u.y); v[4] = bflo(u.z); v[5] = bfhi(u.z); v[6] = bflo(u.w); v[7] = bfhi(u.w);
}
DI uint4 pack8(const float (&v)[8]) {
  uint4 a; a.x = pack2(v[0], v[1]); a.y = pack2(v[2], v[3]); a.z = pack2(v[4], v[5]); a.w = pack2(v[6], v[7]); return a;
}
DI void load8f(const float* p, float (&v)[8]) {
  float4 a = ((const float4*)p)[0], b = ((const float4*)p)[1];
  v[0] = a.x; v[1] = a.y; v[2] = a.z; v[3] = a.w; v[4] = b.x; v[5] = b.y; v[6] = b.z; v[7] = b.w;
}
DI void ln16(float (&y)[16]) {
  float s = 0.f;
#pragma unroll
  for (int i = 0; i < 16; ++i) s += y[i];
  float mu = wave_sum(s) * (1.f / 1024.f);
  float v = 0.f;
#pragma unroll
  for (int i = 0; i < 16; ++i) { float d = y[i] - mu; v += d * d; }
  v = wave_sum(v) * (1.f / 1024.f);
  float rs = rsqrtf(v + 1e-6f);
#pragma unroll
  for (int i = 0; i < 16; ++i) y[i] = (y[i] - mu) * rs;
}

constexpr int LDT = 72;

template <bool SWAP>
DI void gemm_mainloop(const bf16_t* __restrict__ A, int lda, const bf16_t* __restrict__ B, int ldb, int K,
                      f32x16 (&acc)[2][2], bf16_t* As, bf16_t* Bs) {
  const int tid = tidx(), lane = tid & 63, wave = tid >> 6;
  const int wm = wave >> 1, wn = wave & 1;
  const int lrow = tid >> 3, lck = tid & 7;
  const bf16_t* ap = A + (size_t)lrow * lda + lck * 8;
  const bf16_t* bp = B + (size_t)lrow * ldb + lck * 8;
  const size_t sa = (size_t)32 * lda, sb = (size_t)32 * ldb;
  uint4 ra0, ra1, ra2, ra3, rb0, rb1, rb2, rb3;
  ra0 = *(const uint4*)(ap); ra1 = *(const uint4*)(ap + sa); ra2 = *(const uint4*)(ap + 2 * sa); ra3 = *(const uint4*)(ap + 3 * sa);
  rb0 = *(const uint4*)(bp); rb1 = *(const uint4*)(bp + sb); rb2 = *(const uint4*)(bp + 2 * sb); rb3 = *(const uint4*)(bp + 3 * sb);
#pragma unroll
  for (int mi = 0; mi < 2; ++mi)
#pragma unroll
    for (int ni = 0; ni < 2; ++ni)
#pragma unroll
      for (int r = 0; r < 16; ++r) acc[mi][ni][r] = 0.f;
  const int KT = K / 64;
  const int fr = (lane & 31) * LDT + (lane >> 5) * 8;
  bf16_t* asw = As + lrow * LDT + lck * 8;
  bf16_t* bsw = Bs + lrow * LDT + lck * 8;
  for (int kt = 0; kt < KT; ++kt) {
    __syncthreads();
    *(uint4*)(asw) = ra0; *(uint4*)(asw + 32 * LDT) = ra1; *(uint4*)(asw + 64 * LDT) = ra2; *(uint4*)(asw + 96 * LDT) = ra3;
    *(uint4*)(bsw) = rb0; *(uint4*)(bsw + 32 * LDT) = rb1; *(uint4*)(bsw + 64 * LDT) = rb2; *(uint4*)(bsw + 96 * LDT) = rb3;
    __syncthreads();
    if (kt + 1 < KT) {
      const bf16_t* a2 = ap + (kt + 1) * 64;
      const bf16_t* b2 = bp + (kt + 1) * 64;
      ra0 = *(const uint4*)(a2); ra1 = *(const uint4*)(a2 + sa); ra2 = *(const uint4*)(a2 + 2 * sa); ra3 = *(const uint4*)(a2 + 3 * sa);
      rb0 = *(const uint4*)(b2); rb1 = *(const uint4*)(b2 + sb); rb2 = *(const uint4*)(b2 + 2 * sb); rb3 = *(const uint4*)(b2 + 3 * sb);
    }
#pragma unroll
    for (int kk = 0; kk < 4; ++kk) {
      const bf16x8 af0 = *(const bf16x8*)(As + (wm * 64) * LDT + fr + kk * 16);
      const bf16x8 af1 = *(const bf16x8*)(As + (wm * 64 + 32) * LDT + fr + kk * 16);
      const bf16x8 bf0 = *(const bf16x8*)(Bs + (wn * 64) * LDT + fr + kk * 16);
      const bf16x8 bf1 = *(const bf16x8*)(Bs + (wn * 64 + 32) * LDT + fr + kk * 16);
      if (SWAP) {
        acc[0][0] = MFMA(bf0, af0, acc[0][0]); acc[0][1] = MFMA(bf1, af0, acc[0][1]);
        acc[1][0] = MFMA(bf0, af1, acc[1][0]); acc[1][1] = MFMA(bf1, af1, acc[1][1]);
      } else {
        acc[0][0] = MFMA(af0, bf0, acc[0][0]); acc[0][1] = MFMA(af0, bf1, acc[0][1]);
        acc[1][0] = MFMA(af1, bf0, acc[1][0]); acc[1][1] = MFMA(af1, bf1, acc[1][1]);
      }
    }
  }
}

template <bool SWAP, class F>
DI void gemm_epilogue(const f32x16 (&acc)[2][2], F f) {
  const int lane = tidx() & 63, wave = tidx() >> 6;
  const int wm = wave >> 1, wn = wave & 1;
#pragma unroll
  for (int mi = 0; mi < 2; ++mi)
#pragma unroll
    for (int ni = 0; ni < 2; ++ni)
#pragma unroll
      for (int r = 0; r < 16; ++r) {
        const int i = (r & 3) + 8 * (r >> 2) + 4 * (lane >> 5);
        const int j = lane & 31;
        int m, n;
        if (!SWAP) { m = wm * 64 + mi * 32 + i; n = wn * 64 + ni * 32 + j; }
        else { n = wn * 64 + ni * 32 + i; m = wm * 64 + mi * 32 + j; }
        f(m, n, acc[mi][ni][r]);
        if ((r & 3) == 3) __builtin_amdgcn_sched_barrier(0);
      }
}
template <class F>
DI void gemm_epilogue2(const f32x16 (&a0)[2][2], const f32x16 (&a1)[2][2], F f) {
  const int lane = tidx() & 63, wave = tidx() >> 6;
  const int wm = wave >> 1, wn = wave & 1;
#pragma unroll
  for (int mi = 0; mi < 2; ++mi)
#pragma unroll
    for (int ni = 0; ni < 2; ++ni)
#pragma unroll
      for (int r = 0; r < 16; ++r) {
        const int i = (r & 3) + 8 * (r >> 2) + 4 * (lane >> 5);
        const int j = lane & 31;
        f(wm * 64 + mi * 32 + i, wn * 64 + ni * 32 + j, a0[mi][ni][r], a1[mi][ni][r]);
      }
}

DI int tr_tiles(int job) {
  if (job < 2) return 384; if (job < 4) return 256; if (job < 6) return 736; if (job < 8) return 256;
  if (job < 12) return 512; if (job < 20) return 8; return 16;
}
DI void phase_prep(const Params& p, unsigned char* smem, int bid, int nb) {
  const int tid = tidx();
  constexpr int N_MOD = 384, N_TR = 768 + 512 + 1472 + 512 + 2048 + 32 + 32 + 32, N_FOLD = 256, N_GATE = 512, N_DFT = 16384 + 64;
  constexpr int TOTAL = N_MOD + N_TR + N_FOLD + N_GATE + N_DFT;
  unsigned char* ws = p.ws;
  for (int it = bid; it < TOTAL; it += nb) {
    if (it < N_MOD) {
      const int l = it / 96, cchunk = it % 96;
      float* sil = (float*)smem;
      float* red = sil + 5 * 1024;
      __syncthreads();
      for (int i = tid; i < 5120; i += NTHR) {
        int cv = i >> 10, k = i & 1023;
        float c = (cv == 0) ? p.in[I_CCTX][k] : p.in[I_C][(cv - 1) * 1024 + k];
        sil[i] = c * sigm(c);
      }
      __syncthreads();
      const int col = cchunk * 64 + (tid & 63), kg = tid >> 6;
      const float* w = p.in[I_WMOD] + (size_t)l * 1024 * 6144 + col;
      float a0 = 0.f, a1 = 0.f, a2 = 0.f, a3 = 0.f, a4 = 0.f;
#pragma unroll 8
      for (int k = kg * 256; k < kg * 256 + 256; ++k) {
        float wv = w[(size_t)k * 6144];
        a0 += sil[k] * wv; a1 += sil[1024 + k] * wv; a2 += sil[2048 + k] * wv; a3 += sil[3072 + k] * wv; a4 += sil[4096 + k] * wv;
      }
      const int c = tid & 63;
      red[(kg * 5 + 0) * 64 + c] = a0; red[(kg * 5 + 1) * 64 + c] = a1; red[(kg * 5 + 2) * 64 + c] = a2;
      red[(kg * 5 + 3) * 64 + c] = a3; red[(kg * 5 + 4) * 64 + c] = a4;
      __syncthreads();
      for (int i = tid; i < 320; i += NTHR) {
        int cv = i >> 6, cc = i & 63;
        float s = red[(0 * 5 + cv) * 64 + cc] + red[(1 * 5 + cv) * 64 + cc] + red[(2 * 5 + cv) * 64 + cc] + red[(3 * 5 + cv) * 64 + cc];
        s += p.in[I_BMOD][l * 6144 + cchunk * 64 + cc];
        ((float*)(ws + OFF_MOD))[(l * 5 + cv) * 6144 + cchunk * 64 + cc] = s;
      }
    } else if (it < N_MOD + N_TR) {
      int r = it - N_MOD, job = 0;
      for (job = 0; job < 22; ++job) { int nt = tr_tiles(job); if (r < nt) break; r -= nt; }
      const float* src; bf16_t* dst; int lds, ldd, N;
      if (job < 2) { src = p.in[I_WINE] + (size_t)job * 1024 * 2048 + 512; lds = 2048; N = 1536; dst = (bf16_t*)(ws + OFF_BT_IN_E) + (size_t)job * 2560 * 1024 + (size_t)1024 * 1024; ldd = 1024; }
      else if (job < 4) { int j = job - 2; src = p.in[I_WOUTE] + (size_t)j * 1024 * 1024; lds = 1024; N = 1024; dst = (bf16_t*)(ws + OFF_BT_OUT_E) + (size_t)j * 1024 * 1024; ldd = 1024; }
      else if (job < 6) { int j = job - 4; src = p.in[I_WINO] + (size_t)j * 1024 * 2944; lds = 2944; N = 2944; dst = (bf16_t*)(ws + OFF_BT_IN_O) + (size_t)j * 2944 * 1024; ldd = 1024; }
      else if (job < 8) { int j = job - 6; src = p.in[I_WOUTO] + (size_t)j * 1024 * 1024; lds = 1024; N = 1024; dst = (bf16_t*)(ws + OFF_BT_OUT_O) + (size_t)j * 1024 * 1024; ldd = 1024; }
      else if (job < 12) { int j = job - 8; src = p.in[I_WQ] + (size_t)j * 1024 * 2048; lds = 2048; N = 2048; dst = (bf16_t*)(ws + OFF_BT_WQ) + (size_t)j * 2048 * 1024; ldd = 1024; }
      else if (job < 16) { int j = job - 12; src = p.in[I_W2] + (size_t)j * 64 * 512; lds = 512; N = 512; dst = (bf16_t*)(ws + OFF_BT_W2) + (size_t)j * 512 * 64; ldd = 64; }
      else if (job < 20) { int j = job - 16; src = p.in[I_A2] + (size_t)j * 64 * 512; lds = 512; N = 512; dst = (bf16_t*)(ws + OFF_BT_A2) + (size_t)j * 512 * 64; ldd = 64; }
      else { int j = job - 20; src = p.in[I_G2] + (size_t)j * 128 * 512; lds = 512; N = 512; dst = (bf16_t*)(ws + OFF_BT_G2) + (size_t)j * 512 * 128; ldd = 128; }
      const int ntn = N / 64;
      const int k0 = (r / ntn) * 64, n0 = (r % ntn) * 64;
      float* tl = (float*)smem;
      __syncthreads();
#pragma unroll 4
      for (int ps = 0; ps < 16; ++ps) {
        int kr = ps * 4 + (tid >> 6), n = tid & 63;
        tl[kr * 65 + n] = src[(size_t)(k0 + kr) * lds + n0 + n];
      }
      __syncthreads();
#pragma unroll 4
      for (int ps = 0; ps < 8; ++ps) {
        int nr = ps * 8 + (tid >> 5), k2 = tid & 31;
        unsigned v = pack2(tl[(2 * k2) * 65 + nr], tl[(2 * k2 + 1) * 65 + nr]);
        *(unsigned*)(dst + (size_t)(n0 + nr) * ldd + k0 + 2 * k2) = v;
      }
    } else if (it < N_MOD + N_TR + N_FOLD) {
      int r = it - N_MOD - N_TR;
      const int j = r >> 7, rr = r & 127, which = rr >> 6, g = (rr >> 4) & 3, kt = rr & 15;
      const int k0 = kt * 64;
      float* Wl = (float*)smem;
      float* tab = Wl + 64 * 129;
      __syncthreads();
      if (tid < 128) { float fr = (float)tid * (1.f / 128.f); tab[tid] = which ? __builtin_amdgcn_sinf(fr) : __builtin_amdgcn_cosf(fr); }
      for (int ps = 0; ps < 32; ++ps) {
        int kr = ps * 2 + (tid >> 7), c = tid & 127;
        Wl[kr * 129 + c] = p.in[I_WINE][(size_t)j * 1024 * 2048 + (size_t)(k0 + kr) * 2048 + g * 128 + c];
      }
      __syncthreads();
      const int k = tid & 63, nq = tid >> 6;
      bf16_t* dst = (bf16_t*)(ws + OFF_BT_IN_E) + (size_t)j * 2560 * 1024;
      for (int i = 0; i < 32; ++i) {
        const int np = nq * 32 + i;
        float s = 0.f;
#pragma unroll 8
        for (int c = 0; c < 128; ++c) s += Wl[k * 129 + c] * tab[(c * np) & 127];
        dst[(size_t)(which * 512 + g * 128 + np) * 1024 + k0 + k] = (bf16_t)f2bf(s);
      }
    } else if (it < N_MOD + N_TR + N_FOLD + N_GATE) {
      int r = it - N_MOD - N_TR - N_FOLD;
      bf16_t* dst = (bf16_t*)(ws + OFF_BT_GATE);
      for (int e = 0; e < 4; ++e) {
        int idx = r * 1024 + e * 256 + tid;
        int kp = idx & 127, n = (idx >> 7) & 511, gate = (idx >> 16) & 1, d = (idx >> 17) & 1, j = idx >> 18;
        int h = n >> 6;
        float v = 0.f;
        if ((kp >> 6) == (h & 1)) {
          const float* W = gate ? p.in[I_LWX] : p.in[I_LWA];
          v = W[((((size_t)(j * 2 + d) * 8 + h) * 64 + (kp & 63)) * 64) + (n & 63)];
        }
        dst[idx] = (bf16_t)f2bf(v);
      }
    } else {
      int r = it - N_MOD - N_TR - N_FOLD - N_GATE;
      int S, K2; bf16_t* dst; size_t idx;
      if (r < 16384) { S = 4096; K2 = 8192; dst = (bf16_t*)(ws + OFF_D4096); idx = (size_t)r * 2048 + tid * 8; }
      else { S = 256; K2 = 512; dst = (bf16_t*)(ws + OFF_D256); idx = (size_t)(r - 16384) * 2048 + tid * 8; }
      const int row = (int)(idx / K2), kb = (int)(idx % K2);
      const float invS = 1.f / (float)S;
      float v[8];
#pragma unroll
      for (int e = 0; e < 8; ++e) {
        int k = kb + e;
        if (k < S) { int m = (row * k) & (S - 1); v[e] = __builtin_amdgcn_cosf((float)m * invS); }
        else { int m = (row * (k - S)) & (S - 1); v[e] = -__builtin_amdgcn_sinf((float)m * invS); }
      }
      *(uint4*)(dst + idx) = pack8(v);
    }
  }
}

DI void mod_store_h(const Params& p, int t, int lane, int cv, int l, int off_scale, int off_shift, float (&y)[16]) {
  const float* mod = (const float*)(p.ws + OFF_MOD) + (size_t)(l * 5 + cv) * 6144;
  float sc[16], sh[16];
  load_row(mod + off_scale * 1024, lane, sc);
  load_row(mod + off_shift * 1024, lane, sh);
#pragma unroll
  for (int i = 0; i < 16; ++i) y[i] = y[i] * (1.f + sc[i]) + sh[i];
  store_row_bf((bf16_t*)(p.ws + OFF_H) + (size_t)t * 1024, lane, y);
}

DI float pos_embed(int n, int c) {
  int pos = (c < 512) ? (n >> 6) : (n & 63);
  int cc = c & 511, i = cc & 255;
  float om = exp2f(-(float)i * (13.287712379549449f / 256.f));
  float rev = (float)pos * om * 0.15915494309189535f;
  return cc < 256 ? __builtin_amdgcn_sinf(rev) : __builtin_amdgcn_cosf(rev);
}

DI void phase_init(const Params& p, int bid, int nb) {
  const int lane = tidx() & 63, wave = tidx() >> 6;
  for (int t = bid * 4 + wave; t < T; t += nb * 4) {
    int seq, s, S, cv; tok_info(t, seq, s, S, cv);
    float y[16];
    const float* src = (t < 4096) ? p.in[I_XP] + (size_t)t * 1024 : p.in[I_XS] + (size_t)(t - 4096) * 1024;
    load_row(src, lane, y);
    if (t >= 4096) {
#pragma unroll
      for (int i = 0; i < 16; ++i) { int c = (i < 8) ? lane * 8 + i : 512 + lane * 8 + (i - 8); y[i] += pos_embed(s, c); }
    }
    store_row((float*)(p.ws + OFF_X) + (size_t)t * 1024, lane, y);
    ln16(y);
    mod_store_h(p, t, lane, cv, 0, 1, 0, y);
  }
}

DI void convert_tables(const Params& p, int l, int bid, int nb) {
  const size_t n8 = (size_t)16384 * 1024 / 8;
  for (int tb = 0; tb < 2; ++tb) {
    const float* src = p.in[tb ? I_PV : I_PU] + (size_t)l * 16384 * 1024;
    uint4* dst = (uint4*)(p.ws + (tb ? OFF_TABV : OFF_TABU));
    for (size_t i = (size_t)bid * NTHR + tidx(); i < n8; i += (size_t)nb * NTHR) {
      float v[8]; load8f(src + i * 8, v);
      dst[i] = pack8(v);
    }
  }
}

DI void phase_e1(const Params& p, unsigned char* smem, int l, int bid, int nb) {
  const int j = l >> 1;
  bf16_t* As = (bf16_t*)smem; bf16_t* Bs = As + 128 * LDT;
  const bf16_t* H = (const bf16_t*)(p.ws + OFF_H);
  const bf16_t* Bt = (const bf16_t*)(p.ws + OFF_BT_IN_E) + (size_t)j * 2560 * 1024;
  bf16_t* PQT = (bf16_t*)(p.ws + OFF_Z);
  bf16_t* ZC = (bf16_t*)(p.ws + OFF_Z + 40 * MiB);
  for (int it = bid; it < 160 * 20; it += nb) {
    const int mt = it / 20, nt = it % 20, t0 = mt * 128;
    f32x16 acc[2][2];
    if (nt < 8) {
      gemm_mainloop<true>(H + (size_t)t0 * 1024, 1024, Bt + (size_t)nt * 128 * 1024, 1024, 1024, acc, As, Bs);
      int seq, s0, S, cv; tok_info(t0, seq, s0, S, cv);
      bf16_t* base = PQT + pqt_base(seq);
      const int S2 = 2 * S;
      gemm_epilogue<true>(acc, [&](int m, int n, float v) {
        int ng = nt * 128 + n; int which = ng >> 9, ch = ng & 511;
        base[(size_t)ch * S2 + which * S + s0 + m] = (bf16_t)f2bf(v);
      });
    } else {
      gemm_mainloop<false>(H + (size_t)t0 * 1024, 1024, Bt + (size_t)nt * 128 * 1024, 1024, 1024, acc, As, Bs);
      gemm_epilogue<false>(acc, [&](int m, int n, float v) {
        ZC[(size_t)(t0 + m) * 1536 + (nt - 8) * 128 + n] = (bf16_t)f2bf(v);
      });
    }
  }
  convert_tables(p, l, bid, nb);
}

DI void phase_e2(const Params& p, unsigned char* smem, int l, int bid, int nb) {
  const int j = l >> 1;
  bf16_t* As = (bf16_t*)smem; bf16_t* Bs = As + 128 * LDT;
  const bf16_t* PQT = (const bf16_t*)(p.ws + OFF_Z);
  const bf16_t* ZC = (const bf16_t*)(p.ws + OFF_Z + 40 * MiB);
  bf16_t* YM = (bf16_t*)(p.ws + OFF_YMIX);
  for (int it = bid; it < 640 + 1280; it += nb) {
    if (it < 640) {
      int seq, mt, nt, S, t0; const bf16_t* A;
      if (it < 512) { seq = 16 + it / 128; int r = it % 128; mt = r >> 2; nt = r & 3; S = 4096; A = (const bf16_t*)(p.ws + OFF_D4096) + (size_t)mt * 128 * 8192; t0 = 4096 + (seq - 16) * 4096 + mt * 128; }
      else { int r = it - 512; seq = r >> 3; mt = (r & 7) >> 2; nt = r & 3; S = 256; A = (const bf16_t*)(p.ws + OFF_D256) + (size_t)mt * 128 * 512; t0 = seq * 256 + mt * 128; }
      const bf16_t* B = PQT + pqt_base(seq) + (size_t)nt * 128 * (2 * S);
      f32x16 acc[2][2];
      gemm_mainloop<false>(A, 2 * S, B, 2 * S, 2 * S, acc, As, Bs);
      const float scale = rsqrtf(128.f * (float)S);
      gemm_epilogue<false>(acc, [&](int m, int n, float v) {
        YM[(size_t)(t0 + m) * 1024 + nt * 128 + n] = (bf16_t)f2bf(v * scale);
      });
    } else {
      const int t0 = (it - 640) * 16, c = tidx() * 2;
      int seq, s0, S, cv; tok_info(t0, seq, s0, S, cv);
      const float* cw = p.in[I_SCW] + (size_t)j * 3 * 512;
      const float w0a = cw[c], w0b = cw[c + 1], w1a = cw[512 + c], w1b = cw[512 + c + 1], w2a = cw[1024 + c], w2b = cw[1024 + c + 1];
      const float ba = p.in[I_SCB][j * 512 + c], bb = p.in[I_SCB][j * 512 + c + 1];
      auto uval = [&](int t, float& ua, float& ub) {
        unsigned cg_ = *(const unsigned*)(ZC + (size_t)t * 1536 + 512 + c);
        unsigned xi = *(const unsigned*)(ZC + (size_t)t * 1536 + 1024 + c);
        ua = bflo(cg_) * bflo(xi); ub = bfhi(cg_) * bfhi(xi);
      };
      float pa = 0.f, pb = 0.f, ca, cb, na, nb_;
      if (s0 > 0) uval(t0 - 1, pa, pb);
      uval(t0, ca, cb);
      for (int i = 0; i < 16; ++i) {
        const int t = t0 + i;
        na = 0.f; nb_ = 0.f;
        if (s0 + i + 1 < S) uval(t + 1, na, nb_);
        unsigned bg = *(const unsigned*)(ZC + (size_t)t * 1536 + c);
        float ya = bflo(bg) * (w0a * pa + w1a * ca + w2a * na + ba);
        float yb = bfhi(bg) * (w0b * pb + w1b * cb + w2b * nb_ + bb);
        *(unsigned*)(YM + (size_t)t * 1024 + 512 + c) = pack2(ya, yb);
        pa = ca; pb = cb; ca = na; cb = nb_;
      }
    }
  }
}

DI void phase_outgemm(const Params& p, unsigned char* smem, const bf16_t* Bt, int bid, int nb) {
  bf16_t* As = (bf16_t*)smem; bf16_t* Bs = As + 128 * LDT;
  const bf16_t* YM = (const bf16_t*)(p.ws + OFF_YMIX);
  float* MIX = (float*)(p.ws + OFF_MIX);
  for (int it = bid; it < 160 * 8; it += nb) {
    const int mt = it >> 3, nt = it & 7, t0 = mt * 128;
    f32x16 acc[2][2];
    gemm_mainloop<false>(YM + (size_t)t0 * 1024, 1024, Bt + (size_t)nt * 128 * 1024, 1024, 1024, acc, As, Bs);
    gemm_epilogue<false>(acc, [&](int m, int n, float v) { MIX[(size_t)(t0 + m) * 1024 + nt * 128 + n] = v; });
  }
}

DI void phase_res1(const Params& p, int l, int bid, int nb) {
  const int lane = tidx() & 63, wave = tidx() >> 6;
  float* X = (float*)(p.ws + OFF_X);
  const float* MIX = (const float*)(p.ws + OFF_MIX);
  for (int t = bid * 4 + wave; t < T; t += nb * 4) {
    int seq, s, S, cv; tok_info(t, seq, s, S, cv);
    const float* mod = (const float*)(p.ws + OFF_MOD) + (size_t)(l * 5 + cv) * 6144;
    float x[16], m[16], g[16];
    load_row(X + (size_t)t * 1024, lane, x);
    load_row(MIX + (size_t)t * 1024, lane, m);
    load_row(mod + 2 * 1024, lane, g);
#pragma unroll
    for (int i = 0; i < 16; ++i) x[i] = ALPHA_F * x[i] + g[i] * m[i];
    ln16(x);
    load_row(p.in[I_LN1G] + l * 1024, lane, m);
    load_row(p.in[I_LN1B] + l * 1024, lane, g);
#pragma unroll
    for (int i = 0; i < 16; ++i) x[i] = x[i] * m[i] + g[i];
    store_row(X + (size_t)t * 1024, lane, x);
    ln16(x);
    mod_store_h(p, t, lane, cv, l, 4, 3, x);
  }
}

DI void insert16(float (&tv)[16], int (&ti)[16], float x, int xi) {
#pragma unroll
  for (int k = 0; k < 16; ++k) {
    bool gt = x > tv[k];
    float ov = tv[k]; int oi = ti[k];
    tv[k] = gt ? x : ov; ti[k] = gt ? xi : oi;
    x = gt ? ov : x; xi = gt ? oi : xi;
  }
}
DI void phase_p1(const Params& p, unsigned char* smem, int l, int bid, int nb) {
  const int tid = tidx(), lane = tid & 63, wave = tid >> 6;
  const int wm = wave >> 1, wn = wave & 1;
  bf16_t* As = (bf16_t*)smem; bf16_t* Bs = As + 128 * LDT;
  bf16_t* Qs = (bf16_t*)smem;
  bf16_t* Ks = (bf16_t*)(smem + 36864);
  float* Sc = (float*)smem;
  float* Lv = (float*)smem;
  int* Li = (int*)(smem + 8192);
  const bf16_t* H = (const bf16_t*)(p.ws + OFF_H);
  const bf16_t* Bt = (const bf16_t*)(p.ws + OFF_BT_WQ) + (size_t)l * 2048 * 1024;
  float* TKV = (float*)(p.ws + OFF_WD);
  int* TKI = (int*)(p.ws + OFF_WD + 20 * MiB);
  for (int it = bid; it < 160 * 16; it += nb) {
    const int mt = it >> 4, hp = it & 15, t0 = mt * 128;
    f32x16 acc[2][2];
    gemm_mainloop<false>(H + (size_t)t0 * 1024, 1024, Bt + (size_t)hp * 128 * 1024, 1024, 1024, acc, As, Bs);
    {
      const float* kp = p.in[I_KEYS] + (size_t)(l * 16 + hp) * 16384;
#pragma unroll 4
      for (int i = 0; i < 16; ++i) {
        int idx = i * 256 + tid;
        int row = idx >> 5, c4 = idx & 31;
        float4 v = *(const float4*)(kp + row * 128 + c4 * 4);
        uint2 u; u.x = pack2(v.x, v.y); u.y = pack2(v.z, v.w);
        *(uint2*)(Ks + row * 136 + c4 * 4) = u;
      }
    }
    __syncthreads();
    gemm_epilogue<false>(acc, [&](int m, int n, float v) { Qs[m * 136 + n] = (bf16_t)f2bf(v); });
    __syncthreads();
#pragma unroll
    for (int mi = 0; mi < 2; ++mi)
#pragma unroll
      for (int ni = 0; ni < 2; ++ni)
#pragma unroll
        for (int r = 0; r < 16; ++r) acc[mi][ni][r] = 0.f;
    {
      const int fr = (lane & 31) * 136 + (lane >> 5) * 8;
#pragma unroll
      for (int kk = 0; kk < 8; ++kk) {
        bf16x8 af[2], bfr[2];
#pragma unroll
        for (int mi = 0; mi < 2; ++mi) af[mi] = *(const bf16x8*)(Qs + (wm * 64 + mi * 32) * 136 + fr + kk * 16);
#pragma unroll
        for (int ni = 0; ni < 2; ++ni) bfr[ni] = *(const bf16x8*)(Ks + (wn * 64 + ni * 32) * 136 + fr + kk * 16);
#pragma unroll
        for (int mi = 0; mi < 2; ++mi)
#pragma unroll
          for (int ni = 0; ni < 2; ++ni) acc[mi][ni] = MFMA(af[mi], bfr[ni], acc[mi][ni]);
      }
    }
    __syncthreads();
    gemm_epilogue<false>(acc, [&](int m, int n, float v) { Sc[m * 129 + n] = v; });
    __syncthreads();
    const int row = tid & 127, half = tid >> 7;
    float tv[16]; int ti[16];
#pragma unroll
    for (int k = 0; k < 16; ++k) { tv[k] = -3.0e38f; ti[k] = 0; }
    for (int e = 0; e < 64; ++e) insert16(tv, ti, Sc[row * 129 + half * 64 + e], half * 64 + e);
    __syncthreads();
    if (half == 1) {
#pragma unroll
      for (int k = 0; k < 16; ++k) { Lv[k * 128 + row] = tv[k]; Li[k * 128 + row] = ti[k]; }
    }
    __syncthreads();
    if (half == 0) {
#pragma unroll
      for (int k = 0; k < 16; ++k) insert16(tv, ti, Lv[k * 128 + row], Li[k * 128 + row]);
      float* ov = TKV + ((size_t)(t0 + row) * 16 + hp) * 16;
      int* oi = TKI + ((size_t)(t0 + row) * 16 + hp) * 16;
#pragma unroll
      for (int k = 0; k < 16; k += 4) {
        *(float4*)(ov + k) = make_float4(tv[k], tv[k + 1], tv[k + 2], tv[k + 3]);
        *(int4*)(oi + k) = make_int4(ti[k], ti[k + 1], ti[k + 2], ti[k + 3]);
      }
    }
  }
}

DI void phase_p2(const Params& p, unsigned char* smem, int l, int bid, int nb) {
  const int lane = tidx() & 63, wave = tidx() >> 6;
  int* sIdx = (int*)(smem + wave * 1024);
  float* sSc = (float*)(smem + wave * 1024 + 512);
  const bf16_t* H = (const bf16_t*)(p.ws + OFF_H);
  const float* TKV = (const float*)(p.ws + OFF_WD);
  const int* TKI = (const int*)(p.ws + OFF_WD + 20 * MiB);
  const bf16_t* TU = (const bf16_t*)(p.ws + OFF_TABU);
  const bf16_t* TV = (const bf16_t*)(p.ws + OFF_TABV);
  float* X = (float*)(p.ws + OFF_X);
  int ci = 0, cj = 0;
  {
    int q = lane;
    if (q < 16) { ci = 0; cj = q; } else if (q < 24) { ci = 1; cj = q - 16; } else if (q < 29) { ci = 2; cj = q - 24; }
    else if (q < 33) { ci = 3; cj = q - 29; } else if (q < 36) { ci = 4; cj = q - 33; }
    else if (q < 42) { ci = 5 + ((q - 36) >> 1); cj = (q - 36) & 1; } else if (q < 50) { ci = 8 + (q - 42); cj = 0; }
  }
  for (int t = bid * 4 + wave; t < T; t += nb * 4) {
    int seq, s, S, cv; tok_info(t, seq, s, S, cv);
    float hreg[16];
    {
      const bf16_t* hp_ = H + (size_t)t * 1024;
      uint4 a = *(const uint4*)(hp_ + lane * 8), b = *(const uint4*)(hp_ + 512 + lane * 8);
      float v0[8], v1[8]; unpack8(a, v0); unpack8(b, v1);
#pragma unroll
      for (int i = 0; i < 8; ++i) { hreg[i] = v0[i]; hreg[8 + i] = v1[i]; }
    }
    __builtin_amdgcn_wave_barrier();
    for (int h = 0; h < 8; ++h) {
      const float* v1p = TKV + ((size_t)t * 16 + h * 2) * 16;
      const int* i1p = TKI + ((size_t)t * 16 + h * 2) * 16;
      float c = -3.0e38f; int eidx = 0;
      if (lane < 50) { c = v1p[ci] + v1p[16 + cj]; eidx = i1p[ci] * 128 + i1p[16 + cj]; }
      int rank = 0;
#pragma unroll 5
      for (int m = 0; m < 50; ++m) {
        float cm = __int_as_float(__builtin_amdgcn_readlane(__float_as_int(c), m));
        rank += (cm > c || (cm == c && m < lane)) ? 1 : 0;
      }
      if (lane < 50 && rank < 16) { sIdx[h * 16 + rank] = eidx; sSc[h * 16 + rank] = c; }
    }
    __builtin_amdgcn_wave_barrier();
    {
      float s0 = sSc[lane], s1 = sSc[64 + lane];
      float m0 = max16(s0), m1 = max16(s1);
      float e0 = __expf(s0 - m0), e1 = __expf(s1 - m1);
      float d0 = sum16(e0), d1 = sum16(e1);
      __builtin_amdgcn_wave_barrier();
      sSc[lane] = e0 / d0; sSc[64 + lane] = e1 / d1;
    }
    __builtin_amdgcn_wave_barrier();
    float out[16];
#pragma unroll
    for (int i = 0; i < 16; ++i) out[i] = 0.f;
    for (int sb = 0; sb < 128; sb += 4) {
      uint4 u0[4], u1[4], w0[4], w1[4]; float gt[4];
#pragma unroll
      for (int k = 0; k < 4; ++k) {
        int e = __builtin_amdgcn_readfirstlane(sIdx[sb + k]);
        gt[k] = sSc[sb + k];
        const uint4* up = (const uint4*)(TU + (size_t)e * 1024);
        const uint4* vp = (const uint4*)(TV + (size_t)e * 1024);
        u0[k] = up[lane]; u1[k] = up[64 + lane]; w0[k] = vp[lane]; w1[k] = vp[64 + lane];
      }
      float dot[4];
#pragma unroll
      for (int k = 0; k < 4; ++k) {
        float a[8], b[8]; unpack8(u0[k], a); unpack8(u1[k], b);
        float d = 0.f;
#pragma unroll
        for (int i = 0; i < 8; ++i) d += hreg[i] * a[i] + hreg[8 + i] * b[i];
        dot[k] = d;
      }
#pragma unroll
      for (int k = 0; k < 4; ++k) dot[k] = wave_sum(dot[k]);
#pragma unroll
      for (int k = 0; k < 4; ++k) {
        float w = gt[k] * gelu_t(dot[k]);
        float a[8], b[8]; unpack8(w0[k], a); unpack8(w1[k], b);
#pragma unroll
        for (int i = 0; i < 8; ++i) { out[i] += w * a[i]; out[8 + i] += w * b[i]; }
      }
    }
    const float* mod = (const float*)(p.ws + OFF_MOD) + (size_t)(l * 5 + cv) * 6144;
    float x[16], g[16], b2[16];
    load_row(X + (size_t)t * 1024, lane, x);
    load_row(mod + 5 * 1024, lane, g);
#pragma unroll
    for (int i = 0; i < 16; ++i) x[i] = ALPHA_F * x[i] + g[i] * out[i];
    ln16(x);
    load_row(p.in[I_LN2G] + l * 1024, lane, g);
    load_row(p.in[I_LN2B] + l * 1024, lane, b2);
#pragma unroll
    for (int i = 0; i < 16; ++i) x[i] = x[i] * g[i] + b2[i];
    if (l == 3) {
      store_row(p.out + (size_t)t * 1024, lane, x);
    } else {
      store_row(X + (size_t)t * 1024, lane, x);
      ln16(x);
      mod_store_h(p, t, lane, cv, l + 1, 1, 0, x);
    }
  }
}

DI void phase_o1(const Params& p, unsigned char* smem, int l, int bid, int nb) {
  const int j = l >> 1;
  bf16_t* As = (bf16_t*)smem; bf16_t* Bs = As + 128 * LDT;
  const bf16_t* H = (const bf16_t*)(p.ws + OFF_H);
  const bf16_t* Bt = (const bf16_t*)(p.ws + OFF_BT_IN_O) + (size_t)j * 2944 * 1024;
  bf16_t* Z = (bf16_t*)(p.ws + OFF_Z);
  for (int it = bid; it < 160 * 23; it += nb) {
    const int mt = it / 23, nt = it % 23, t0 = mt * 128;
    f32x16 acc[2][2];
    gemm_mainloop<false>(H + (size_t)t0 * 1024, 1024, Bt + (size_t)nt * 128 * 1024, 1024, 1024, acc, As, Bs);
    gemm_epilogue<false>(acc, [&](int m, int n, float v) { Z[(size_t)(t0 + m) * 2944 + nt * 128 + n] = (bf16_t)f2bf(v); });
  }
  convert_tables(p, l, bid, nb);
}

DI void phase_o2(const Params& p, int l, int bid, int nb) {
  const int j = l >> 1;
  const int lane = tidx() & 63, wave = tidx() >> 6;
  const bf16_t* Z = (const bf16_t*)(p.ws + OFF_Z);
  bf16_t* XC = (bf16_t*)(p.ws + OFF_XC);
  bf16_t* LRIN = (bf16_t*)(p.ws + OFF_LRIN);
  bf16_t* KKN = (bf16_t*)(p.ws + OFF_KKN);
  bf16_t* KS = (bf16_t*)(p.ws + OFF_KS);
  bf16_t* RS = (bf16_t*)(p.ws + OFF_RS);
  bf16_t* VS = (bf16_t*)(p.ws + OFF_VS);
  const float* mu = p.in[I_MU] + (size_t)j * 1920;
  const int c0 = lane * 8;
  for (int t = bid * 4 + wave; t < T; t += nb * 4) {
    int seq, s, S, cv; tok_info(t, seq, s, S, cv);
    const bf16_t* zr = Z + (size_t)t * 2944;
    {
      float af[8], ab[8];
      load8f(p.in[I_LCB] + (size_t)(j * 2 + 0) * 512 + c0, af);
      load8f(p.in[I_LCB] + (size_t)(j * 2 + 1) * 512 + c0, ab);
#pragma unroll
      for (int o = -3; o <= 3; ++o) {
        float xv[8];
        if (s + o >= 0 && s + o < S) { uint4 u = *(const uint4*)(zr + (ptrdiff_t)o * 2944 + c0); unpack8(u, xv); }
        else {
#pragma unroll
          for (int i = 0; i < 8; ++i) xv[i] = 0.f;
        }
        if (o <= 0) {
          float w[8]; load8f(p.in[I_LCW] + ((size_t)(j * 2 + 0) * 4 + (o + 3)) * 512 + c0, w);
#pragma unroll
          for (int i = 0; i < 8; ++i) af[i] += w[i] * xv[i];
        }
        if (o >= 0) {
          float w[8]; load8f(p.in[I_LCW] + ((size_t)(j * 2 + 1) * 4 + (3 - o)) * 512 + c0, w);
#pragma unroll
          for (int i = 0; i < 8; ++i) ab[i] += w[i] * xv[i];
        }
      }
      *(uint4*)(XC + (size_t)t * 512 + c0) = pack8(af);
      *(uint4*)(XC + (size_t)T * 512 + (size_t)t * 512 + c0) = pack8(ab);
    }
    const bool hp_ = s > 0, hn = s < S - 1;
#pragma unroll
    for (int part = 0; part < 3; ++part) {
      const int col = 1024 + part * 512 + c0;
      float zc[8], zp[8], zn[8], m[8], zs[8];
      unpack8(*(const uint4*)(zr + col), zc);
      if (hp_) unpack8(*(const uint4*)(zr - 2944 + col), zp); else {
#pragma unroll
        for (int i = 0; i < 8; ++i) zp[i] = 0.f;
      }
      if (hn) unpack8(*(const uint4*)(zr + 2944 + col), zn); else {
#pragma unroll
        for (int i = 0; i < 8; ++i) zn[i] = 0.f;
      }
      load8f(mu + (col - 1024), m);
#pragma unroll
      for (int i = 0; i < 8; ++i) zs[i] = zc[i] + m[i] * (0.5f * (zp[i] + zn[i]) - zc[i]);
      if (part == 0) *(uint4*)(RS + (size_t)t * 512 + c0) = pack8(zs);
      else if (part == 2) *(uint4*)(VS + (size_t)t * 512 + c0) = pack8(zs);
      else {
        *(uint4*)(KS + (size_t)t * 512 + c0) = pack8(zs);
#pragma unroll
        for (int d = 0; d < 2; ++d) {
          float kk[8], raw[8]; load8f(p.in[I_KK] + (size_t)(j * 2 + d) * 512 + c0, kk);
          float ss = 0.f;
#pragma unroll
          for (int i = 0; i < 8; ++i) { raw[i] = zs[i] * kk[i]; ss += raw[i] * raw[i]; }
          ss = sum8(ss);
          float inv = rsqrtf(fmaxf(ss, 1e-24f));
#pragma unroll
          for (int i = 0; i < 8; ++i) raw[i] *= inv;
          *(uint4*)(KKN + (size_t)d * T * 512 + (size_t)t * 512 + c0) = pack8(raw);
        }
      }
    }
    if (lane < 48) {
      const int col = 2560 + c0;
      float zc[8], zp[8], zn[8], m[8], zs[8];
      unpack8(*(const uint4*)(zr + col), zc);
      if (hp_) unpack8(*(const uint4*)(zr - 2944 + col), zp); else {
#pragma unroll
        for (int i = 0; i < 8; ++i) zp[i] = 0.f;
      }
      if (hn) unpack8(*(const uint4*)(zr + 2944 + col), zn); else {
#pragma unroll
        for (int i = 0; i < 8; ++i) zn[i] = 0.f;
      }
      load8f(mu + (col - 1024), m);
#pragma unroll
      for (int i = 0; i < 8; ++i) {
        float z = zc[i] + m[i] * (0.5f * (zp[i] + zn[i]) - zc[i]);
        zs[i] = (lane < 16) ? tanh_f(z) : ((lane < 32) ? z : sigm(z));
      }
      *(uint4*)(LRIN + (size_t)t * 384 + c0) = pack8(zs);
    }
  }
}

DI void phase_o3(const Params& p, unsigned char* smem, int l, int bid, int nb) {
  const int j = l >> 1;
  bf16_t* As = (bf16_t*)smem; bf16_t* Bs = As + 128 * LDT;
  const bf16_t* XC = (const bf16_t*)(p.ws + OFF_XC);
  const bf16_t* LRIN = (const bf16_t*)(p.ws + OFF_LRIN);
  const bf16_t* KKN = (const bf16_t*)(p.ws + OFF_KKN);
  const bf16_t* KS = (const bf16_t*)(p.ws + OFF_KS);
  float* LA = (float*)(p.ws + OFF_MIX);
  bf16_t* LB = (bf16_t*)(p.ws + OFF_LB);
  float* WD = (float*)(p.ws + OFF_WD);
  bf16_t* KKA = (bf16_t*)(p.ws + OFF_KKA);
  bf16_t* KM = (bf16_t*)(p.ws + OFF_KM);
  bf16_t* G = (bf16_t*)(p.ws + OFF_G);
  for (int it = bid; it < 160 * 28; it += nb) {
    const int mt = it / 28, jb = it % 28, t0 = mt * 128;
    if (jb < 8) {
      const int d = jb >> 2, nt = jb & 3;
      const bf16_t* A = XC + (size_t)d * T * 512 + (size_t)t0 * 512 + nt * 128;
      const bf16_t* Br = (const bf16_t*)(p.ws + OFF_BT_GATE) + ((size_t)((j * 2 + d) * 2 + 0) * 512 + nt * 128) * 128;
      const bf16_t* Bi = (const bf16_t*)(p.ws + OFF_BT_GATE) + ((size_t)((j * 2 + d) * 2 + 1) * 512 + nt * 128) * 128;
      const float* ba = p.in[I_LBA] + (size_t)(j * 2 + d) * 512;
      const float* bx = p.in[I_LBX] + (size_t)(j * 2 + d) * 512;
      const float* lam = p.in[I_LLAM] + (size_t)(j * 2 + d) * 512;
      {
        f32x16 acc[2][2];
        gemm_mainloop<false>(A, 512, Br, 128, 128, acc, As, Bs);
        gemm_epilogue<false>(acc, [&](int m, int n, float vr) {
          const int ng = nt * 128 + n; const size_t o = ((size_t)d * T + t0 + m) * 512 + ng;
          float gr = sigm(vr + ba[ng]);
          float nl = -lam[ng];
          float sp = nl > 20.f ? nl : log1pf(__expf(nl));
          LA[o] = __expf(-8.f * gr * sp);
        });
      }
      {
        f32x16 acc[2][2];
        gemm_mainloop<false>(A, 512, Bi, 128, 128, acc, As, Bs);
        gemm_epilogue<false>(acc, [&](int m, int n, float vi) {
          const int ng = nt * 128 + n; const size_t o = ((size_t)d * T + t0 + m) * 512 + ng;
          float gi = sigm(vi + bx[ng]);
          float a = LA[o];
          float bb = sqrtf(fmaxf(1.f - a * a, 0.f)) * gi * bf2f(XC[o]);
          LB[o] = (bf16_t)f2bf(bb);
        });
      }
    } else if (jb < 16) {
      const int d = (jb - 8) >> 2, nt = (jb - 8) & 3;
      f32x16 acc[2][2];
      gemm_mainloop<false>(LRIN + (size_t)t0 * 384 + d * 64, 384, (const bf16_t*)(p.ws + OFF_BT_W2) + ((size_t)(j * 2 + d) * 512 + nt * 128) * 64, 64, 64, acc, As, Bs);
      const float* w0 = p.in[I_W0] + (size_t)(j * 2 + d) * 512;
      gemm_epilogue<false>(acc, [&](int m, int n, float v) {
        const int ng = nt * 128 + n;
        WD[((size_t)d * T + t0 + m) * 512 + ng] = __expf(-0.6065306597126334f * sigm(w0[ng] + v));
      });
    } else if (jb < 24) {
      const int d = (jb - 16) >> 2, nt = (jb - 16) & 3;
      f32x16 acc[2][2];
      gemm_mainloop<false>(LRIN + (size_t)t0 * 384 + 128 + d * 64, 384, (const bf16_t*)(p.ws + OFF_BT_A2) + ((size_t)(j * 2 + d) * 512 + nt * 128) * 64, 64, 64, acc, As, Bs);
      const float* a0 = p.in[I_A0] + (size_t)(j * 2 + d) * 512;
      const float* ka = p.in[I_KA] + (size_t)(j * 2 + d) * 512;
      gemm_epilogue<false>(acc, [&](int m, int n, float v) {
        const int ng = nt * 128 + n; const size_t o = ((size_t)d * T + t0 + m) * 512 + ng;
        float ic = sigm(a0[ng] + v);
        KKA[o] = (bf16_t)f2bf(bf2f(KKN[o]) * ic);
        KM[o] = (bf16_t)f2bf(bf2f(KS[(size_t)(t0 + m) * 512 + ng]) * (1.f + (ic - 1.f) * ka[ng]));
      });
    } else {
      const int nt = jb - 24;
      f32x16 acc[2][2];
      gemm_mainloop<false>(LRIN + (size_t)t0 * 384 + 256, 384, (const bf16_t*)(p.ws + OFF_BT_G2) + ((size_t)j * 512 + nt * 128) * 128, 128, 128, acc, As, Bs);
      gemm_epilogue<false>(acc, [&](int m, int n, float v) { G[(size_t)(t0 + m) * 512 + nt * 128 + n] = (bf16_t)f2bf(v); });
    }
  }
}

struct StepIn { float4 w; uint2 kk, kka, km, r; unsigned short v; };

DI void wkv_scan_item(const Params& p, int j, int b, int d, int h, int rg, bool ctx) {
  const int lane = tidx() & 63, wave = tidx() >> 6;
  const int row = rg * 16 + wave * 4 + (lane >> 4), q = lane & 15;
  const int S = ctx ? 256 : 4096, t0 = ctx ? b * 256 : 4096 + b * 4096;
  const int cb = h * 64 + q * 4;
  const float* WD = (const float*)(p.ws + OFF_WD) + (size_t)d * T * 512;
  const bf16_t* KKN = (const bf16_t*)(p.ws + OFF_KKN) + (size_t)d * T * 512;
  const bf16_t* KKA = (const bf16_t*)(p.ws + OFF_KKA) + (size_t)d * T * 512;
  const bf16_t* KM = (const bf16_t*)(p.ws + OFF_KM) + (size_t)d * T * 512;
  const bf16_t* RS = (const bf16_t*)(p.ws + OFF_RS);
  const bf16_t* VS = (const bf16_t*)(p.ws + OFF_VS);
  float* Y = (float*)(p.ws + (d ? OFF_XC : OFF_H));
  float st[4];
  if (ctx) { st[0] = st[1] = st[2] = st[3] = 0.f; }
  else {
    float4 s4 = *(const float4*)(p.in[I_SWKV] + ((((size_t)(b * 2 + j) * 2 + d) * 8 + h) * 64 + row) * 64 + q * 4);
    st[0] = s4.x; st[1] = s4.y; st[2] = s4.z; st[3] = s4.w;
  }
  auto ld = [&](int step) -> StepIn {
    const int pos = d ? (S - 1 - step) : step;
    const size_t o = (size_t)(t0 + pos) * 512;
    StepIn x;
    x.w = *(const float4*)(WD + o + cb);
    x.kk = *(const uint2*)(KKN + o + cb);
    x.kka = *(const uint2*)(KKA + o + cb);
    x.km = *(const uint2*)(KM + o + cb);
    x.r = *(const uint2*)(RS + o + cb);
    x.v = VS[o + h * 64 + row];
    return x;
  };
  StepIn buf[8];
#pragma unroll
  for (int i = 0; i < 8; ++i) buf[i] = ld(i);
  for (int s0 = 0; s0 < S; s0 += 8) {
#pragma unroll
    for (int i = 0; i < 8; ++i) {
      const StepIn x = buf[i];
      int nst = s0 + 8 + i; nst = nst < S ? nst : S - 1;
      buf[i] = ld(nst);
      const float kk0 = bflo(x.kk.x), kk1 = bfhi(x.kk.x), kk2 = bflo(x.kk.y), kk3 = bfhi(x.kk.y);
      float sk = st[0] * kk0 + st[1] * kk1 + st[2] * kk2 + st[3] * kk3;
      sk = sum16(sk);
      const float v = bf2f(x.v);
      st[0] = st[0] * x.w.x - sk * bflo(x.kka.x) + v * bflo(x.km.x);
      st[1] = st[1] * x.w.y - sk * bfhi(x.kka.x) + v * bfhi(x.km.x);
      st[2] = st[2] * x.w.z - sk * bflo(x.kka.y) + v * bflo(x.km.y);
      st[3] = st[3] * x.w.w - sk * bfhi(x.kka.y) + v * bfhi(x.km.y);
      float y = st[0] * bflo(x.r.x) + st[1] * bfhi(x.r.x) + st[2] * bflo(x.r.y) + st[3] * bfhi(x.r.y);
      y = sum16(y);
      const int step = s0 + i;
      const int pos = d ? (S - 1 - step) : step;
      if (q == 0) Y[(size_t)(t0 + pos) * 512 + h * 64 + row] = y;
    }
  }
  if (ctx) {
    float* o = p.out + 21004288 + ((((size_t)(b * 2 + j) * 2 + d) * 8 + h) * 64 + row) * 64 + q * 4;
    *(float4*)o = make_float4(st[0], st[1], st[2], st[3]);
  }
}

DI void lru_scan_item(const Params& p, unsigned char* smem, int j, int b, int cgp, bool ctx) {
  const int tid = tidx(), c = tid & 31, sg = tid >> 5;
  const int ch = cgp * 32 + c;
  const int S = ctx ? 256 : 4096, t0 = ctx ? b * 256 : 4096 + b * 4096;
  const int L = S / 8;
  float* sA = (float*)smem; float* sB = sA + 256;
  bf16_t* YM = (bf16_t*)(p.ws + OFF_YMIX);
  const bf16_t* Z = (const bf16_t*)(p.ws + OFF_Z);
  for (int d = 0; d < 2; ++d) {
    const float* la = (const float*)(p.ws + OFF_MIX) + (size_t)d * T * 512;
    const bf16_t* lb = (const bf16_t*)(p.ws + OFF_LB) + (size_t)d * T * 512;
    float A = 1.f, Bv = 0.f;
#pragma unroll 8
    for (int st = sg * L; st < (sg + 1) * L; ++st) {
      const int pos = d ? (S - 1 - st) : st;
      const size_t o = (size_t)(t0 + pos) * 512 + ch;
      float a = la[o], bb = bf2f(lb[o]);
      A *= a; Bv = a * Bv + bb;
    }
    __syncthreads();
    sA[sg * 32 + c] = A; sB[sg * 32 + c] = Bv;
    __syncthreads();
    float h = ctx ? 0.f : p.in[I_SLRU][((size_t)(b * 2 + j) * 2 + d) * 512 + ch];
    for (int s2 = 0; s2 < sg; ++s2) h = sA[s2 * 32 + c] * h + sB[s2 * 32 + c];
#pragma unroll 8
    for (int st = sg * L; st < (sg + 1) * L; ++st) {
      const int pos = d ? (S - 1 - st) : st;
      const size_t tt = (size_t)(t0 + pos);
      float a = la[tt * 512 + ch], bb = bf2f(lb[tt * 512 + ch]);
      h = a * h + bb;
      if (d == 0) YM[tt * 1024 + ch] = (bf16_t)f2bf(h);
      else {
        float hs = h + bf2f(YM[tt * 1024 + ch]);
        float gb = bf2f(Z[tt * 2944 + 512 + ch]);
        YM[tt * 1024 + ch] = (bf16_t)f2bf(hs * gelu_t(gb));
      }
    }
    if (ctx && sg == 7) p.out[20971520 + ((size_t)(b * 2 + j) * 2 + d) * 512 + ch] = h;
    __syncthreads();
  }
}

DI void phase_o4(const Params& p, unsigned char* smem, int l, int bid, int nb) {
  const int j = l >> 1;
  for (int it = bid; it < 1600; it += nb) {
    if (it < 256) { int sid = it >> 2, rg = it & 3; wkv_scan_item(p, j, sid >> 4, (sid >> 3) & 1, sid & 7, rg, false); }
    else if (it < 320) { int r = it - 256; lru_scan_item(p, smem, j, r >> 4, r & 15, false); }
    else if (it < 1344) { int r = it - 320; int sid = r >> 2, rg = r & 3; wkv_scan_item(p, j, sid >> 4, (sid >> 3) & 1, sid & 7, rg, true); }
    else { int r = it - 1344; lru_scan_item(p, smem, j, r >> 4, r & 15, true); }
  }
}

DI void phase_o5(const Params& p, int l, int bid, int nb) {
  const int j = l >> 1;
  const int lane = tidx() & 63, wave = tidx() >> 6;
  const float* YF = (const float*)(p.ws + OFF_H);
  const float* YB = (const float*)(p.ws + OFF_XC);
  const bf16_t* RS = (const bf16_t*)(p.ws + OFF_RS);
  const bf16_t* VS = (const bf16_t*)(p.ws + OFF_VS);
  const bf16_t* KM = (const bf16_t*)(p.ws + OFF_KM);
  const bf16_t* G = (const bf16_t*)(p.ws + OFF_G);
  bf16_t* YM = (bf16_t*)(p.ws + OFF_YMIX);
  const int c0 = lane * 8;
  float gng[8], gnb[8], rk[8];
  load8f(p.in[I_GNG] + j * 512 + c0, gng);
  load8f(p.in[I_GNB] + j * 512 + c0, gnb);
  load8f(p.in[I_RK] + j * 512 + c0, rk);
  for (int t = bid * 4 + wave; t < T; t += nb * 4) {
    const size_t o = (size_t)t * 512 + c0;
    float yf[8], yb[8], ys[8];
    load8f(YF + o, yf); load8f(YB + o, yb);
    float s = 0.f;
#pragma unroll
    for (int i = 0; i < 8; ++i) { ys[i] = yf[i] + yb[i]; s += ys[i]; }
    const float mean = sum8(s) * (1.f / 64.f);
    float v = 0.f;
#pragma unroll
    for (int i = 0; i < 8; ++i) { float dd = ys[i] - mean; v += dd * dd; }
    const float rstd = rsqrtf(sum8(v) * (1.f / 64.f) + 64e-5f);
    float r[8], vv[8], kf[8], kb[8], g[8];
    unpack8(*(const uint4*)(RS + o), r);
    unpack8(*(const uint4*)(VS + o), vv);
    unpack8(*(const uint4*)(KM + o), kf);
    unpack8(*(const uint4*)(KM + (size_t)T * 512 + o), kb);
    unpack8(*(const uint4*)(G + o), g);
    float sf = 0.f;
#pragma unroll
    for (int i = 0; i < 8; ++i) sf += r[i] * rk[i] * (kf[i] + kb[i]);
    sf = sum8(sf);
    float outv[8];
#pragma unroll
    for (int i = 0; i < 8; ++i) outv[i] = ((ys[i] - mean) * rstd * gng[i] + gnb[i] + sf * vv[i]) * g[i];
    *(uint4*)(YM + (size_t)t * 1024 + 512 + c0) = pack8(outv);
  }
}

enum { PH_PREP = 0, PH_INIT, PH_E1, PH_E2, PH_EOUT, PH_RES, PH_P1, PH_P2, PH_O1, PH_O2, PH_O3, PH_O4, PH_O5, PH_OOUT };

DI void run_phase(const Params& p, unsigned char* smem, int ph, int l, int bid, int nb) {
  switch (ph) {
    case PH_PREP: phase_prep(p, smem, bid, nb); break;
    case PH_INIT: phase_init(p, bid, nb); break;
    case PH_E1: phase_e1(p, smem, l, bid, nb); break;
    case PH_E2: phase_e2(p, smem, l, bid, nb); break;
    case PH_EOUT: phase_outgemm(p, smem, (const bf16_t*)(p.ws + OFF_BT_OUT_E) + (size_t)(l >> 1) * 1024 * 1024, bid, nb); break;
    case PH_RES: phase_res1(p, l, bid, nb); break;
    case PH_P1: phase_p1(p, smem, l, bid, nb); break;
    case PH_P2: phase_p2(p, smem, l, bid, nb); break;
    case PH_O1: phase_o1(p, smem, l, bid, nb); break;
    case PH_O2: phase_o2(p, l, bid, nb); break;
    case PH_O3: phase_o3(p, smem, l, bid, nb); break;
    case PH_O4: phase_o4(p, smem, l, bid, nb); break;
    case PH_O5: phase_o5(p, l, bid, nb); break;
    case PH_OOUT: phase_outgemm(p, smem, (const bf16_t*)(p.ws + OFF_BT_OUT_O) + (size_t)(l >> 1) * 1024 * 1024, bid, nb); break;
  }
}

#if MULTI
__global__ void __launch_bounds__(NTHR, 2) phase_kernel(Params p, int ph, int l) {
  extern __shared__ __attribute__((aligned(16))) unsigned char smem[];
  run_phase(p, smem, ph, l, blockIdx.x, gridDim.x);
}
#else
__global__ void __launch_bounds__(NTHR, 2) mega_kernel(Params p) {
  extern __shared__ __attribute__((aligned(16))) unsigned char smem[];
  cg::grid_group grid = cg::this_grid();
  const int bid = blockIdx.x, nb = gridDim.x;
  for (int step = 0; step < 32; ++step) {
    int ph, l;
    if (step < 2) { ph = step; l = 0; }
    else {
      int s = step - 2, k;
      if (s < 6) { l = 0; k = s; } else if (s < 15) { l = 1; k = s - 6; } else if (s < 21) { l = 2; k = s - 15; } else { l = 3; k = s - 21; }
      if ((l & 1) == 0) ph = PH_E1 + k;
      else ph = (k < 6) ? PH_O1 + k : PH_RES + (k - 6);
    }
#if defined(__HIP_DEVICE_COMPILE__)
    const __attribute__((address_space(4))) Params* kp = (const __attribute__((address_space(4))) Params*)__builtin_amdgcn_kernarg_segment_ptr();
    asm volatile("" : "+s"(kp), "+s"(l), "+s"(ph));
    const Params q = *kp;
#else
    const Params q = p;
#endif
    run_phase(q, smem, ph, l, bid, nb);
    if (step < 31) {
      __threadfence();
      grid.sync();
    }
  }
}
#endif

extern "C" void kernel_launch(void* const* d_in, const int* in_sizes, int n_in, void* d_out, int out_size, void* d_ws, size_t ws_size,
                              hipStream_t stream) {
  static int grid_blocks = 0;
  if (grid_blocks == 0) {
    if (n_in != 40 || ws_size < WS_END) { fprintf(stderr, "kernel_launch: unexpected n_in %d or ws_size %zu (need %zu)\n", n_in, ws_size, (size_t)WS_END); grid_blocks = -1; return; }
    int dev = 0, cus = 0, per_cu = 0;
    hipGetDevice(&dev);
    hipDeviceGetAttribute(&cus, hipDeviceAttributeMultiprocessorCount, dev);
#if MULTI
    hipFuncSetAttribute((const void*)phase_kernel, hipFuncAttributeMaxDynamicSharedMemorySize, LDS_BYTES);
    hipOccupancyMaxActiveBlocksPerMultiprocessor(&per_cu, (const void*)phase_kernel, NTHR, LDS_BYTES);
#else
    hipFuncSetAttribute((const void*)mega_kernel, hipFuncAttributeMaxDynamicSharedMemorySize, LDS_BYTES);
    hipOccupancyMaxActiveBlocksPerMultiprocessor(&per_cu, (const void*)mega_kernel, NTHR, LDS_BYTES);
#endif
    if (per_cu < 1) per_cu = 1;
    if (per_cu > 2) per_cu = 2;
    if (cus < 1) cus = 256;
    grid_blocks = cus * per_cu;
  }
  if (grid_blocks < 0) return;
  Params p{};
  for (int i = 0; i < 40; ++i) p.in[i] = (const float*)d_in[i];
  p.out = (float*)d_out;
  p.ws = (unsigned char*)d_ws;
#if MULTI
  auto L = [&](int ph, int l) { hipLaunchKernelGGL(phase_kernel, dim3(grid_blocks), dim3(NTHR), LDS_BYTES, stream, p, ph, l); };
  L(PH_PREP, 0); L(PH_INIT, 0);
  for (int l = 0; l < 4; ++l) {
    if ((l & 1) == 0) { L(PH_E1, l); L(PH_E2, l); L(PH_EOUT, l); }
    else { L(PH_O1, l); L(PH_O2, l); L(PH_O3, l); L(PH_O4, l); L(PH_O5, l); L(PH_OOUT, l); }
    L(PH_RES, l); L(PH_P1, l); L(PH_P2, l);
  }
#else
  void* args[] = {&p};
  hipError_t e = hipLaunchCooperativeKernel((const void*)mega_kernel, dim3(grid_blocks), dim3(NTHR), args, LDS_BYTES, stream);
  if (e != hipSuccess) fprintf(stderr, "cooperative launch failed: %s (grid %d)\n", hipGetErrorString(e), grid_blocks);
#endif
}
```

```cpp
#include <hip/hip_runtime.h>
#include <hip/hip_cooperative_groups.h>
#include <cstdio>
#include <cstdint>
namespace cg = cooperative_groups;

#ifndef MULTI
#define MULTI 0
#endif

typedef unsigned short bf16_t;
using bf16x8 = __attribute__((ext_vector_type(8))) short;
using f32x16 = __attribute__((ext_vector_type(16))) float;
#define DI __device__ __forceinline__
#define MFMA(a, b, c) __builtin_amdgcn_mfma_f32_32x32x16_bf16((a), (b), (c), 0, 0, 0)

constexpr int T = 20480;
constexpr int NTHR = 256;
constexpr int LDS_BYTES = 73728;
constexpr float ALPHA_F = 1.681792830507429f;

constexpr size_t MiB = 1u << 20;
constexpr size_t OFF_TABU = 0;
constexpr size_t OFF_TABV = OFF_TABU + 32 * MiB;
constexpr size_t OFF_BT_IN_E = OFF_TABV + 32 * MiB;
constexpr size_t OFF_BT_OUT_E = OFF_BT_IN_E + 10 * MiB;
constexpr size_t OFF_BT_IN_O = OFF_BT_OUT_E + 4 * MiB;
constexpr size_t OFF_BT_OUT_O = OFF_BT_IN_O + 12 * MiB;
constexpr size_t OFF_BT_WQ = OFF_BT_OUT_O + 4 * MiB;
constexpr size_t OFF_BT_W2 = OFF_BT_WQ + 16 * MiB;
constexpr size_t OFF_BT_A2 = OFF_BT_W2 + 256 * 1024;
constexpr size_t OFF_BT_G2 = OFF_BT_A2 + 256 * 1024;
constexpr size_t OFF_BT_GATE = OFF_BT_G2 + 256 * 1024;
constexpr size_t OFF_D256 = OFF_BT_GATE + 2 * MiB;
constexpr size_t OFF_MOD = OFF_D256 + 256 * 1024;
constexpr size_t OFF_D4096 = OFF_MOD + 512 * 1024;
constexpr size_t OFF_X = OFF_D4096 + 64 * MiB;
constexpr size_t OFF_Z = OFF_X + 80 * MiB;
constexpr size_t OFF_YMIX = OFF_Z + 115 * MiB;
constexpr size_t OFF_MIX = OFF_YMIX + 40 * MiB;
constexpr size_t OFF_H = OFF_MIX + 80 * MiB;
constexpr size_t OFF_XC = OFF_H + 40 * MiB;
constexpr size_t OFF_LRIN = OFF_XC + 40 * MiB;
constexpr size_t OFF_KKN = OFF_LRIN + 15 * MiB;
constexpr size_t OFF_KS = OFF_KKN + 40 * MiB;
constexpr size_t OFF_RS = OFF_KS + 20 * MiB;
constexpr size_t OFF_VS = OFF_RS + 20 * MiB;
constexpr size_t OFF_LB = OFF_VS + 20 * MiB;
constexpr size_t OFF_WD = OFF_LB + 40 * MiB;
constexpr size_t OFF_KKA = OFF_WD + 80 * MiB;
constexpr size_t OFF_KM = OFF_KKA + 40 * MiB;
constexpr size_t OFF_G = OFF_KM + 40 * MiB;
constexpr size_t WS_END = OFF_G + 20 * MiB;

struct Params {
  const float* in[40];
  float* out;
  unsigned char* ws;
};

enum {
  I_XP = 0, I_XS, I_SLRU, I_SWKV, I_C, I_CCTX, I_WMOD, I_BMOD, I_LN1G, I_LN1B, I_LN2G, I_LN2B, I_WINE, I_WOUTE, I_SCW, I_SCB,
  I_WINO, I_WOUTO, I_LCW, I_LCB, I_LWA, I_LBA, I_LWX, I_LBX, I_LLAM, I_MU, I_W0, I_W2, I_A0, I_A2, I_KK, I_KA, I_RK, I_G2, I_GNG,
  I_GNB, I_WQ, I_KEYS, I_PU, I_PV
};

DI int tidx() { int t = __builtin_amdgcn_workitem_id_x(); asm volatile("" : "+v"(t)); return t; }
DI unsigned f2bf(float x) { unsigned u = __float_as_uint(x); u += 0x7fffu + ((u >> 16) & 1u); return u >> 16; }
DI unsigned pack2(float a, float b) { return f2bf(a) | (f2bf(b) << 16); }
DI float bflo(unsigned u) { return __uint_as_float(u << 16); }
DI float bfhi(unsigned u) { return __uint_as_float(u & 0xffff0000u); }
DI float bf2f(bf16_t h) { return __uint_as_float(((unsigned)h) << 16); }
DI float sigm(float x) { return 1.f / (1.f + __expf(-x)); }
DI float gelu_t(float x) { float u = 0.7978845608028654f * (x + 0.044715f * x * x * x); return x * sigm(2.f * u); }
DI float tanh_f(float x) { return 2.f * sigm(2.f * x) - 1.f; }

template <int CTRL> DI float dpp_mov(float x) {
  return __int_as_float(__builtin_amdgcn_update_dpp(0, __float_as_int(x), CTRL, 0xF, 0xF, true));
}
DI float sum8(float x) { x += dpp_mov<0xB1>(x); x += dpp_mov<0x4E>(x); x += dpp_mov<0x141>(x); return x; }
DI float sum16(float x) { x = sum8(x); x += dpp_mov<0x140>(x); return x; }
DI float max16(float x) {
  x = fmaxf(x, dpp_mov<0xB1>(x)); x = fmaxf(x, dpp_mov<0x4E>(x)); x = fmaxf(x, dpp_mov<0x141>(x)); x = fmaxf(x, dpp_mov<0x140>(x));
  return x;
}
DI float wave_sum(float x) { x = sum16(x); x += __shfl_xor(x, 16); x += __shfl_xor(x, 32); return x; }

DI void tok_info(int t, int& seq, int& s, int& S, int& cv) {
  if (t < 4096) { seq = t >> 8; s = t & 255; S = 256; cv = 0; }
  else { int u = t - 4096; seq = 16 + (u >> 12); s = u & 4095; S = 4096; cv = 1 + (u >> 12); }
}
DI size_t pqt_base(int seq) { return seq < 16 ? (size_t)seq * 512 * 512 : (size_t)16 * 512 * 512 + (size_t)(seq - 16) * 512 * 8192; }

DI void load_row(const float* p, int lane, float (&v)[16]) {
  const float4* q = (const float4*)(p + lane * 8);
  float4 a = q[0], b = q[1];
  const float4* q2 = (const float4*)(p + 512 + lane * 8);
  float4 c = q2[0], d = q2[1];
  v[0] = a.x; v[1] = a.y; v[2] = a.z; v[3] = a.w; v[4] = b.x; v[5] = b.y; v[6] = b.z; v[7] = b.w;
  v[8] = c.x; v[9] = c.y; v[10] = c.z; v[11] = c.w; v[12] = d.x; v[13] = d.y; v[14] = d.z; v[15] = d.w;
}
DI void store_row(float* p, int lane, const float (&v)[16]) {
  float4* q = (float4*)(p + lane * 8);
  q[0] = make_float4(v[0], v[1], v[2], v[3]); q[1] = make_float4(v[4], v[5], v[6], v[7]);
  float4* q2 = (float4*)(p + 512 + lane * 8);
  q2[0] = make_float4(v[8], v[9], v[10], v[11]); q2[1] = make_float4(v[12], v[13], v[14], v[15]);
}
DI void store_row_bf(bf16_t* p, int lane, const float (&v)[16]) {
  uint4 a, b;
  a.x = pack2(v[0], v[1]); a.y = pack2(v[2], v[3]); a.z = pack2(v[4], v[5]); a.w = pack2(v[6], v[7]);
  b.x = pack2(v[8], v[9]); b.y = pack2(v[10], v[11]); b.z = pack2(v[12], v[13]); b.w = pack2(v[14], v[15]);
  *(uint4*)(p + lane * 8) = a;
  *(uint4*)(p + 512 + lane * 8) = b;
}
DI void unpack8(uint4 u, float (&v)[8]) {
  v[0] = bflo(u.x); v[1] = bfhi(u.x); v[2] = bflo(u.y); v[3] = bfhi(u.y); v[4] = bflo(u.z); v[5] = bfhi(u.z); v[6] = bflo(u.w); v[7] = bfhi(u.w);
}
DI uint4 pack8(const float (&v)[8]) {
  uint4 a; a.x = pack2(v[0], v[1]); a.y = pack2(v[2], v[3]); a.z = pack2(v[4], v[5]); a.w = pack2(v[6], v[7]); return a;
}
DI void load8f(const float* p, float (&v)[8]) {
  float4 a = ((const float4*)p)[0], b = ((const float4*)p)[1];
  v[0] = a.x; v[1] = a.y; v[2] = a.z; v[3] = a.w; v[4] = b.x; v[5] = b.y; v[6] = b.z; v[7] = b.w;
}

DI void load_row16(const float* p, int lane, float (&v)[16]) {
  const float4* q = (const float4*)(p + lane * 16);
  float4 a = q[0], b = q[1], c = q[2], d = q[3];
  v[0] = a.x; v[1] = a.y; v[2] = a.z; v[3] = a.w; v[4] = b.x; v[5] = b.y; v[6] = b.z; v[7] = b.w;
  v[8] = c.x; v[9] = c.y; v[10] = c.z; v[11] = c.w; v[12] = d.x; v[13] = d.y; v[14] = d.z; v[15] = d.w;
}
DI void store_row16(float* p, int lane, const float (&v)[16]) {
  float4* q = (float4*)(p + lane * 16);
  q[0] = make_float4(v[0], v[1], v[2], v[3]); q[1] = make_float4(v[4], v[5], v[6], v[7]);
  q[2] = make_float4(v[8], v[9], v[10], v[11]); q[3] = make_float4(v[12], v[13], v[14], v[15]);
}
DI void store_row16_bf(bf16_t* p, int lane, const float (&v)[16]) {
  uint4 a, b;
  a.x = pack2(v[0], v[1]); a.y = pack2(v[2], v[3]); a.z = pack2(v[4], v[5]); a.w = pack2(v[6], v[7]);
  b.x = pack2(v[8], v[9]); b.y = pack2(v[10], v[11]); b.z = pack2(v[12], v[13]); b.w = pack2(v[14], v[15]);
  uint4* q = (uint4*)(p + lane * 16);
  q[0] = a; q[1] = b;
}
typedef float v2f_t __attribute__((ext_vector_type(2)));
DI unsigned pk_fp8x4(float a, float b, float c, float d) {
  int w = 0;
  w = __builtin_amdgcn_cvt_pk_fp8_f32(a, b, w, false);
  w = __builtin_amdgcn_cvt_pk_fp8_f32(c, d, w, true);
  return (unsigned)w;
}
DI void unpack_fp8x16(uint4 u, float (&v)[16]) {
  v2f_t t;
  t = __builtin_amdgcn_cvt_pk_f32_fp8((int)u.x, false); v[0] = t.x; v[1] = t.y;
  t = __builtin_amdgcn_cvt_pk_f32_fp8((int)u.x, true); v[2] = t.x; v[3] = t.y;
  t = __builtin_amdgcn_cvt_pk_f32_fp8((int)u.y, false); v[4] = t.x; v[5] = t.y;
  t = __builtin_amdgcn_cvt_pk_f32_fp8((int)u.y, true); v[6] = t.x; v[7] = t.y;
  t = __builtin_amdgcn_cvt_pk_f32_fp8((int)u.z, false); v[8] = t.x; v[9] = t.y;
  t = __builtin_amdgcn_cvt_pk_f32_fp8((int)u.z, true); v[10] = t.x; v[11] = t.y;
  t = __builtin_amdgcn_cvt_pk_f32_fp8((int)u.w, false); v[12] = t.x; v[13] = t.y;
  t = __builtin_amdgcn_cvt_pk_f32_fp8((int)u.w, true); v[14] = t.x; v[15] = t.y;
}
DI void ln16(float (&y)[16]) {
  float s = 0.f;
#pragma unroll
  for (int i = 0; i < 16; ++i) s += y[i];
  float mu = wave_sum(s) * (1.f / 1024.f);
  float v = 0.f;
#pragma unroll
  for (int i = 0; i < 16; ++i) { float d = y[i] - mu; v += d * d; }
  v = wave_sum(v) * (1.f / 1024.f);
  float rs = rsqrtf(v + 1e-6f);
#pragma unroll
  for (int i = 0; i < 16; ++i) y[i] = (y[i] - mu) * rs;
}

DI int swz8(int i, int n) { return (i & 7) * (n >> 3) + (i >> 3); }

constexpr int LDT = 72;

constexpr int STAGE_ELEMS = 2 * 128 * LDT;
template <bool SWAP>
DI void gemm_mainloop(const bf16_t* __restrict__ A, int lda, const bf16_t* __restrict__ B, int ldb, int K,
                      f32x16 (&acc)[2][2], bf16_t* As, bf16_t*  ) {
  const int tid = tidx(), lane = tid & 63, wave = tid >> 6;
  const int wm = wave >> 1, wn = wave & 1;
  const int lrow = tid >> 3, lck = tid & 7;
  const bf16_t* ap = A + (size_t)lrow * lda + lck * 8;
  const bf16_t* bp = B + (size_t)lrow * ldb + lck * 8;
  const size_t sa = (size_t)32 * lda, sb = (size_t)32 * ldb;
  uint4 ra0, ra1, ra2, ra3, rb0, rb1, rb2, rb3;
  ra0 = *(const uint4*)(ap); ra1 = *(const uint4*)(ap + sa); ra2 = *(const uint4*)(ap + 2 * sa); ra3 = *(const uint4*)(ap + 3 * sa);
  rb0 = *(const uint4*)(bp); rb1 = *(const uint4*)(bp + sb); rb2 = *(const uint4*)(bp + 2 * sb); rb3 = *(const uint4*)(bp + 3 * sb);
#pragma unroll
  for (int mi = 0; mi < 2; ++mi)
#pragma unroll
    for (int ni = 0; ni < 2; ++ni)
#pragma unroll
      for (int r = 0; r < 16; ++r) acc[mi][ni][r] = 0.f;
  const int KT = K / 64;
  const int fr = (lane & 31) * LDT + (lane >> 5) * 8;
  const int wofs = lrow * LDT + lck * 8;
  __syncthreads();
  {
    bf16_t* asw = As + wofs; bf16_t* bsw = As + 128 * LDT + wofs;
    *(uint4*)(asw) = ra0; *(uint4*)(asw + 32 * LDT) = ra1; *(uint4*)(asw + 64 * LDT) = ra2; *(uint4*)(asw + 96 * LDT) = ra3;
    *(uint4*)(bsw) = rb0; *(uint4*)(bsw + 32 * LDT) = rb1; *(uint4*)(bsw + 64 * LDT) = rb2; *(uint4*)(bsw + 96 * LDT) = rb3;
  }
  if (KT > 1) {
    const bf16_t* a2 = ap + 64; const bf16_t* b2 = bp + 64;
    ra0 = *(const uint4*)(a2); ra1 = *(const uint4*)(a2 + sa); ra2 = *(const uint4*)(a2 + 2 * sa); ra3 = *(const uint4*)(a2 + 3 * sa);
    rb0 = *(const uint4*)(b2); rb1 = *(const uint4*)(b2 + sb); rb2 = *(const uint4*)(b2 + 2 * sb); rb3 = *(const uint4*)(b2 + 3 * sb);
  }
  __syncthreads();
#pragma unroll 1
  for (int kt = 0; kt < KT; ++kt) {
    const bf16_t* Ac = As + (kt & 1) * STAGE_ELEMS;
    const bf16_t* Bc = Ac + 128 * LDT;
#pragma unroll
    for (int kk = 0; kk < 4; ++kk) {
      const bf16x8 af0 = *(const bf16x8*)(Ac + (wm * 64) * LDT + fr + kk * 16);
      const bf16x8 af1 = *(const bf16x8*)(Ac + (wm * 64 + 32) * LDT + fr + kk * 16);
      const bf16x8 bf0 = *(const bf16x8*)(Bc + (wn * 64) * LDT + fr + kk * 16);
      const bf16x8 bf1 = *(const bf16x8*)(Bc + (wn * 64 + 32) * LDT + fr + kk * 16);
      if (SWAP) {
        acc[0][0] = MFMA(bf0, af0, acc[0][0]); acc[0][1] = MFMA(bf1, af0, acc[0][1]);
        acc[1][0] = MFMA(bf0, af1, acc[1][0]); acc[1][1] = MFMA(bf1, af1, acc[1][1]);
      } else {
        acc[0][0] = MFMA(af0, bf0, acc[0][0]); acc[0][1] = MFMA(af0, bf1, acc[0][1]);
        acc[1][0] = MFMA(af1, bf0, acc[1][0]); acc[1][1] = MFMA(af1, bf1, acc[1][1]);
      }
    }
    if (kt + 1 < KT) {
      bf16_t* asw = As + ((kt + 1) & 1) * STAGE_ELEMS + wofs; bf16_t* bsw = asw + 128 * LDT;
      *(uint4*)(asw) = ra0; *(uint4*)(asw + 32 * LDT) = ra1; *(uint4*)(asw + 64 * LDT) = ra2; *(uint4*)(asw + 96 * LDT) = ra3;
      *(uint4*)(bsw) = rb0; *(uint4*)(bsw + 32 * LDT) = rb1; *(uint4*)(bsw + 64 * LDT) = rb2; *(uint4*)(bsw + 96 * LDT) = rb3;
      if (kt + 2 < KT) {
        const bf16_t* a2 = ap + (kt + 2) * 64; const bf16_t* b2 = bp + (kt + 2) * 64;
        ra0 = *(const uint4*)(a2); ra1 = *(const uint4*)(a2 + sa); ra2 = *(const uint4*)(a2 + 2 * sa); ra3 = *(const uint4*)(a2 + 3 * sa);
        rb0 = *(const uint4*)(b2); rb1 = *(const uint4*)(b2 + sb); rb2 = *(const uint4*)(b2 + 2 * sb); rb3 = *(const uint4*)(b2 + 3 * sb);
      }
      __syncthreads();
    }
  }
}

template <bool SWAP, bool SB = true, class F>
DI void gemm_epilogue(const f32x16 (&acc)[2][2], F f) {
  const int lane = tidx() & 63, wave = tidx() >> 6;
  const int wm = wave >> 1, wn = wave & 1;
#pragma unroll
  for (int mi = 0; mi < 2; ++mi)
#pragma unroll
    for (int ni = 0; ni < 2; ++ni)
#pragma unroll
      for (int r = 0; r < 16; ++r) {
        const int i = (r & 3) + 8 * (r >> 2) + 4 * (lane >> 5);
        const int j = lane & 31;
        int m, n;
        if (!SWAP) { m = wm * 64 + mi * 32 + i; n = wn * 64 + ni * 32 + j; }
        else { n = wn * 64 + ni * 32 + i; m = wm * 64 + mi * 32 + j; }
        f(m, n, acc[mi][ni][r]);
        if (SB && (r & 3) == 3) __builtin_amdgcn_sched_barrier(0);
      }
}
template <class F>
DI void gemm_epilogue2(const f32x16 (&a0)[2][2], const f32x16 (&a1)[2][2], F f) {
  const int lane = tidx() & 63, wave = tidx() >> 6;
  const int wm = wave >> 1, wn = wave & 1;
#pragma unroll
  for (int mi = 0; mi < 2; ++mi)
#pragma unroll
    for (int ni = 0; ni < 2; ++ni)
#pragma unroll
      for (int r = 0; r < 16; ++r) {
        const int i = (r & 3) + 8 * (r >> 2) + 4 * (lane >> 5);
        const int j = lane & 31;
        f(wm * 64 + mi * 32 + i, wn * 64 + ni * 32 + j, a0[mi][ni][r], a1[mi][ni][r]);
      }
}

DI int tr_tiles(int job) {
  if (job < 2) return 384; if (job < 4) return 256; if (job < 6) return 736; if (job < 8) return 256;
  if (job < 12) return 512; if (job < 20) return 8; return 16;
}
DI void phase_prep(const Params& p, unsigned char* smem, int bid, int nb) {
  const int tid = tidx();
  constexpr int N_MOD = 384, N_TR = 768 + 512 + 1472 + 512 + 2048 + 32 + 32 + 32, N_FOLD = 256, N_GATE = 512, N_DFT = 16384 + 64;
  constexpr int TOTAL = N_MOD + N_TR + N_FOLD + N_GATE + N_DFT;
  unsigned char* ws = p.ws;
  for (int it = bid; it < TOTAL; it += nb) {
    if (it < N_MOD) {
      const int l = it / 96, cchunk = it % 96;
      float* sil = (float*)smem;
      float* red = sil + 5 * 1024;
      __syncthreads();
      for (int i = tid; i < 5120; i += NTHR) {
        int cv = i >> 10, k = i & 1023;
        float c = (cv == 0) ? p.in[I_CCTX][k] : p.in[I_C][(cv - 1) * 1024 + k];
        sil[i] = c * sigm(c);
      }
      __syncthreads();
      const int col = cchunk * 64 + (tid & 63), kg = tid >> 6;
      const float* w = p.in[I_WMOD] + (size_t)l * 1024 * 6144 + col;
      float a0 = 0.f, a1 = 0.f, a2 = 0.f, a3 = 0.f, a4 = 0.f;
#pragma unroll 8
      for (int k = kg * 256; k < kg * 256 + 256; ++k) {
        float wv = w[(size_t)k * 6144];
        a0 += sil[k] * wv; a1 += sil[1024 + k] * wv; a2 += sil[2048 + k] * wv; a3 += sil[3072 + k] * wv; a4 += sil[4096 + k] * wv;
      }
      const int c = tid & 63;
      red[(kg * 5 + 0) * 64 + c] = a0; red[(kg * 5 + 1) * 64 + c] = a1; red[(kg * 5 + 2) * 64 + c] = a2;
      red[(kg * 5 + 3) * 64 + c] = a3; red[(kg * 5 + 4) * 64 + c] = a4;
      __syncthreads();
      for (int i = tid; i < 320; i += NTHR) {
        int cv = i >> 6, cc = i & 63;
        float s = red[(0 * 5 + cv) * 64 + cc] + red[(1 * 5 + cv) * 64 + cc] + red[(2 * 5 + cv) * 64 + cc] + red[(3 * 5 + cv) * 64 + cc];
        s += p.in[I_BMOD][l * 6144 + cchunk * 64 + cc];
        ((float*)(ws + OFF_MOD))[(l * 5 + cv) * 6144 + cchunk * 64 + cc] = s;
      }
    } else if (it < N_MOD + N_TR) {
      int r = it - N_MOD, job = 0;
      for (job = 0; job < 22; ++job) { int nt = tr_tiles(job); if (r < nt) break; r -= nt; }
      const float* src; bf16_t* dst; int lds, ldd, N;
      if (job < 2) { src = p.in[I_WINE] + (size_t)job * 1024 * 2048 + 512; lds = 2048; N = 1536; dst = (bf16_t*)(ws + OFF_BT_IN_E) + (size_t)job * 2560 * 1024 + (size_t)1024 * 1024; ldd = 1024; }
      else if (job < 4) { int j = job - 2; src = p.in[I_WOUTE] + (size_t)j * 1024 * 1024; lds = 1024; N = 1024; dst = (bf16_t*)(ws + OFF_BT_OUT_E) + (size_t)j * 1024 * 1024; ldd = 1024; }
      else if (job < 6) { int j = job - 4; src = p.in[I_WINO] + (size_t)j * 1024 * 2944; lds = 2944; N = 2944; dst = (bf16_t*)(ws + OFF_BT_IN_O) + (size_t)j * 2944 * 1024; ldd = 1024; }
      else if (job < 8) { int j = job - 6; src = p.in[I_WOUTO] + (size_t)j * 1024 * 1024; lds = 1024; N = 1024; dst = (bf16_t*)(ws + OFF_BT_OUT_O) + (size_t)j * 1024 * 1024; ldd = 1024; }
      else if (job < 12) { int j = job - 8; src = p.in[I_WQ] + (size_t)j * 1024 * 2048; lds = 2048; N = 2048; dst = (bf16_t*)(ws + OFF_BT_WQ) + (size_t)j * 2048 * 1024; ldd = 1024; }
      else if (job < 16) { int j = job - 12; src = p.in[I_W2] + (size_t)j * 64 * 512; lds = 512; N = 512; dst = (bf16_t*)(ws + OFF_BT_W2) + (size_t)j * 512 * 64; ldd = 64; }
      else if (job < 20) { int j = job - 16; src = p.in[I_A2] + (size_t)j * 64 * 512; lds = 512; N = 512; dst = (bf16_t*)(ws + OFF_BT_A2) + (size_t)j * 512 * 64; ldd = 64; }
      else { int j = job - 20; src = p.in[I_G2] + (size_t)j * 128 * 512; lds = 512; N = 512; dst = (bf16_t*)(ws + OFF_BT_G2) + (size_t)j * 512 * 128; ldd = 128; }
      const int ntn = N / 64;
      const int k0 = (r / ntn) * 64, n0 = (r % ntn) * 64;
      float* tl = (float*)smem;
      __syncthreads();
#pragma unroll 4
      for (int ps = 0; ps < 16; ++ps) {
        int kr = ps * 4 + (tid >> 6), n = tid & 63;
        tl[kr * 65 + n] = src[(size_t)(k0 + kr) * lds + n0 + n];
      }
      __syncthreads();
#pragma unroll 4
      for (int ps = 0; ps < 8; ++ps) {
        int nr = ps * 8 + (tid >> 5), k2 = tid & 31;
        unsigned v = pack2(tl[(2 * k2) * 65 + nr], tl[(2 * k2 + 1) * 65 + nr]);
        *(unsigned*)(dst + (size_t)(n0 + nr) * ldd + k0 + 2 * k2) = v;
      }
    } else if (it < N_MOD + N_TR + N_FOLD) {
      int r = it - N_MOD - N_TR;
      const int j = r >> 7, rr = r & 127, which = rr >> 6, g = (rr >> 4) & 3, kt = rr & 15;
      const int k0 = kt * 64;
      float* Wl = (float*)smem;
      float* tab = Wl + 64 * 129;
      __syncthreads();
      if (tid < 128) { float fr = (float)tid * (1.f / 128.f); tab[tid] = which ? __builtin_amdgcn_sinf(fr) : __builtin_amdgcn_cosf(fr); }
      for (int ps = 0; ps < 32; ++ps) {
        int kr = ps * 2 + (tid >> 7), c = tid & 127;
        Wl[kr * 129 + c] = p.in[I_WINE][(size_t)j * 1024 * 2048 + (size_t)(k0 + kr) * 2048 + g * 128 + c];
      }
      __syncthreads();
      const int k = tid & 63, nq = tid >> 6;
      bf16_t* dst = (bf16_t*)(ws + OFF_BT_IN_E) + (size_t)j * 2560 * 1024;
      for (int i = 0; i < 32; ++i) {
        const int np = nq * 32 + i;
        float s = 0.f;
#pragma unroll 8
        for (int c = 0; c < 128; ++c) s += Wl[k * 129 + c] * tab[(c * np) & 127];
        dst[(size_t)(which * 512 + g * 128 + np) * 1024 + k0 + k] = (bf16_t)f2bf(s);
      }
    } else if (it < N_MOD + N_TR + N_FOLD + N_GATE) {
      int r = it - N_MOD - N_TR - N_FOLD;
      bf16_t* dst = (bf16_t*)(ws + OFF_BT_GATE);
      for (int e = 0; e < 4; ++e) {
        int idx = r * 1024 + e * 256 + tid;
        int kp = idx & 127, n = (idx >> 7) & 511, gate = (idx >> 16) & 1, d = (idx >> 17) & 1, j = idx >> 18;
        int h = n >> 6;
        float v = 0.f;
        if ((kp >> 6) == (h & 1)) {
          const float* W = gate ? p.in[I_LWX] : p.in[I_LWA];
          v = W[((((size_t)(j * 2 + d) * 8 + h) * 64 + (kp & 63)) * 64) + (n & 63)];
        }
        dst[idx] = (bf16_t)f2bf(v);
      }
    } else {
      int r = it - N_MOD - N_TR - N_FOLD - N_GATE;
      int S, K2; bf16_t* dst; size_t idx;
      if (r < 16384) { S = 4096; K2 = 8192; dst = (bf16_t*)(ws + OFF_D4096); idx = (size_t)r * 2048 + tid * 8; }
      else { S = 256; K2 = 512; dst = (bf16_t*)(ws + OFF_D256); idx = (size_t)(r - 16384) * 2048 + tid * 8; }
      const int row = (int)(idx / K2), kb = (int)(idx % K2);
      const float invS = 1.f / (float)S;
      float v[8];
#pragma unroll
      for (int e = 0; e < 8; ++e) {
        int k = kb + e;
        if (k < S) { int m = (row * k) & (S - 1); v[e] = __builtin_amdgcn_cosf((float)m * invS); }
        else { int m = (row * (k - S)) & (S - 1); v[e] = -__builtin_amdgcn_sinf((float)m * invS); }
      }
      *(uint4*)(dst + idx) = pack8(v);
    }
  }
}

DI void mod_store_h(const Params& p, int t, int lane, int cv, int l, int off_scale, int off_shift, float (&y)[16]) {
  const float* mod = (const float*)(p.ws + OFF_MOD) + (size_t)(l * 5 + cv) * 6144;
  float sc[16], sh[16];
  load_row(mod + off_scale * 1024, lane, sc);
  load_row(mod + off_shift * 1024, lane, sh);
#pragma unroll
  for (int i = 0; i < 16; ++i) y[i] = y[i] * (1.f + sc[i]) + sh[i];
  store_row_bf((bf16_t*)(p.ws + OFF_H) + (size_t)t * 1024, lane, y);
}

DI float pos_embed(int n, int c) {
  int pos = (c < 512) ? (n >> 6) : (n & 63);
  int cc = c & 511, i = cc & 255;
  float om = exp2f(-(float)i * (13.287712379549449f / 256.f));
  float rev = (float)pos * om * 0.15915494309189535f;
  return cc < 256 ? __builtin_amdgcn_sinf(rev) : __builtin_amdgcn_cosf(rev);
}

DI void phase_init(const Params& p, int bid, int nb) {
  const int lane = tidx() & 63, wave = tidx() >> 6;
  for (int t = bid * 4 + wave; t < T; t += nb * 4) {
    int seq, s, S, cv; tok_info(t, seq, s, S, cv);
    float y[16];
    const float* src = (t < 4096) ? p.in[I_XP] + (size_t)t * 1024 : p.in[I_XS] + (size_t)(t - 4096) * 1024;
    load_row(src, lane, y);
    if (t >= 4096) {
#pragma unroll
      for (int i = 0; i < 16; ++i) { int c = (i < 8) ? lane * 8 + i : 512 + lane * 8 + (i - 8); y[i] += pos_embed(s, c); }
    }
    store_row((float*)(p.ws + OFF_X) + (size_t)t * 1024, lane, y);
    ln16(y);
    mod_store_h(p, t, lane, cv, 0, 1, 0, y);
  }
}

constexpr float U_SCALE = 32.f;
DI void convert_tables(const Params& p, int l, int bid, int nb) {
  const size_t n16 = (size_t)16384 * 1024 / 16;
  for (int tb = 0; tb < 2; ++tb) {
    const float* src = p.in[tb ? I_PV : I_PU] + (size_t)l * 16384 * 1024;
    uint4* dst = (uint4*)(p.ws + (tb ? OFF_TABV : OFF_TABU));
    const float sc = tb ? 1.f : U_SCALE;
    for (size_t i = (size_t)bid * NTHR + tidx(); i < n16; i += (size_t)nb * NTHR) {
      const float4* s4 = (const float4*)(src + i * 16);
      float4 a = s4[0], b = s4[1], c = s4[2], d = s4[3];
      uint4 o;
      o.x = pk_fp8x4(a.x * sc, a.y * sc, a.z * sc, a.w * sc); o.y = pk_fp8x4(b.x * sc, b.y * sc, b.z * sc, b.w * sc);
      o.z = pk_fp8x4(c.x * sc, c.y * sc, c.z * sc, c.w * sc); o.w = pk_fp8x4(d.x * sc, d.y * sc, d.z * sc, d.w * sc);
      dst[i] = o;
    }
  }
}

DI void phase_e1(const Params& p, unsigned char* smem, int l, int bid, int nb) {
  const int j = l >> 1;
  bf16_t* As = (bf16_t*)smem; bf16_t* Bs = As + 128 * LDT;
  const bf16_t* H = (const bf16_t*)(p.ws + OFF_H);
  const bf16_t* Bt = (const bf16_t*)(p.ws + OFF_BT_IN_E) + (size_t)j * 2560 * 1024;
  bf16_t* PQT = (bf16_t*)(p.ws + OFF_Z);
  bf16_t* ZC = (bf16_t*)(p.ws + OFF_Z + 40 * MiB);
  for (int i_ = bid; i_ < 160 * 20; i_ += nb) {
    const int it = swz8(i_, 160 * 20);
    const int mt = it / 20, nt = it % 20, t0 = mt * 128;
    f32x16 acc[2][2];
    if (nt < 8) {
      gemm_mainloop<true>(H + (size_t)t0 * 1024, 1024, Bt + (size_t)nt * 128 * 1024, 1024, 1024, acc, As, Bs);
      int seq, s0, S, cv; tok_info(t0, seq, s0, S, cv);
      bf16_t* base = PQT + pqt_base(seq);
      const int S2 = 2 * S;
      gemm_epilogue<true>(acc, [&](int m, int n, float v) {
        int ng = nt * 128 + n; int which = ng >> 9, ch = ng & 511;
        base[(size_t)ch * S2 + which * S + s0 + m] = (bf16_t)f2bf(v);
      });
    } else {
      gemm_mainloop<false>(H + (size_t)t0 * 1024, 1024, Bt + (size_t)nt * 128 * 1024, 1024, 1024, acc, As, Bs);
      gemm_epilogue<false>(acc, [&](int m, int n, float v) {
        ZC[(size_t)(t0 + m) * 1536 + (nt - 8) * 128 + n] = (bf16_t)f2bf(v);
      });
    }
  }
  convert_tables(p, l, bid, nb);
}

DI void phase_e2(const Params& p, unsigned char* smem, int l, int bid, int nb) {
  const int j = l >> 1;
  bf16_t* As = (bf16_t*)smem; bf16_t* Bs = As + 128 * LDT;
  const bf16_t* PQT = (const bf16_t*)(p.ws + OFF_Z);
  const bf16_t* ZC = (const bf16_t*)(p.ws + OFF_Z + 40 * MiB);
  bf16_t* YM = (bf16_t*)(p.ws + OFF_YMIX);
  for (int it = bid; it < 640 + 1280; it += nb) {
    if (it < 640) {
      int seq, mt, nt, S, t0; const bf16_t* A;
      if (it < 512) { seq = 16 + it / 128; int r = it % 128; mt = r >> 2; nt = r & 3; S = 4096; A = (const bf16_t*)(p.ws + OFF_D4096) + (size_t)mt * 128 * 8192; t0 = 4096 + (seq - 16) * 4096 + mt * 128; }
      else { int r = it - 512; seq = r >> 3; mt = (r & 7) >> 2; nt = r & 3; S = 256; A = (const bf16_t*)(p.ws + OFF_D256) + (size_t)mt * 128 * 512; t0 = seq * 256 + mt * 128; }
      const bf16_t* B = PQT + pqt_base(seq) + (size_t)nt * 128 * (2 * S);
      f32x16 acc[2][2];
      gemm_mainloop<false>(A, 2 * S, B, 2 * S, 2 * S, acc, As, Bs);
      const float scale = rsqrtf(128.f * (float)S);
      gemm_epilogue<false>(acc, [&](int m, int n, float v) {
        YM[(size_t)(t0 + m) * 1024 + nt * 128 + n] = (bf16_t)f2bf(v * scale);
      });
    } else {
      const int t0 = (it - 640) * 16, c = tidx() * 2;
      int seq, s0, S, cv; tok_info(t0, seq, s0, S, cv);
      const float* cw = p.in[I_SCW] + (size_t)j * 3 * 512;
      const float w0a = cw[c], w0b = cw[c + 1], w1a = cw[512 + c], w1b = cw[512 + c + 1], w2a = cw[1024 + c], w2b = cw[1024 + c + 1];
      const float ba = p.in[I_SCB][j * 512 + c], bb = p.in[I_SCB][j * 512 + c + 1];
      auto uval = [&](int t, float& ua, float& ub) {
        unsigned cg_ = *(const unsigned*)(ZC + (size_t)t * 1536 + 512 + c);
        unsigned xi = *(const unsigned*)(ZC + (size_t)t * 1536 + 1024 + c);
        ua = bflo(cg_) * bflo(xi); ub = bfhi(cg_) * bfhi(xi);
      };
      float pa = 0.f, pb = 0.f, ca, cb, na, nb_;
      if (s0 > 0) uval(t0 - 1, pa, pb);
      uval(t0, ca, cb);
      for (int i = 0; i < 16; ++i) {
        const int t = t0 + i;
        na = 0.f; nb_ = 0.f;
        if (s0 + i + 1 < S) uval(t + 1, na, nb_);
        unsigned bg = *(const unsigned*)(ZC + (size_t)t * 1536 + c);
        float ya = bflo(bg) * (w0a * pa + w1a * ca + w2a * na + ba);
        float yb = bfhi(bg) * (w0b * pb + w1b * cb + w2b * nb_ + bb);
        *(unsigned*)(YM + (size_t)t * 1024 + 512 + c) = pack2(ya, yb);
        pa = ca; pb = cb; ca = na; cb = nb_;
      }
    }
  }
}

DI void phase_outgemm(const Params& p, unsigned char* smem, const bf16_t* Bt, int bid, int nb) {
  bf16_t* As = (bf16_t*)smem; bf16_t* Bs = As + 128 * LDT;
  const bf16_t* YM = (const bf16_t*)(p.ws + OFF_YMIX);
  float* MIX = (float*)(p.ws + OFF_MIX);
  for (int i_ = bid; i_ < 160 * 8; i_ += nb) {
    const int it = swz8(i_, 160 * 8);
    const int mt = it >> 3, nt = it & 7, t0 = mt * 128;
    f32x16 acc[2][2];
    gemm_mainloop<false>(YM + (size_t)t0 * 1024, 1024, Bt + (size_t)nt * 128 * 1024, 1024, 1024, acc, As, Bs);
    gemm_epilogue<false>(acc, [&](int m, int n, float v) { MIX[(size_t)(t0 + m) * 1024 + nt * 128 + n] = v; });
  }
}

DI void phase_res1(const Params& p, int l, int bid, int nb) {
  const int lane = tidx() & 63, wave = tidx() >> 6;
  float* X = (float*)(p.ws + OFF_X);
  const float* MIX = (const float*)(p.ws + OFF_MIX);
  for (int t = bid * 4 + wave; t < T; t += nb * 4) {
    int seq, s, S, cv; tok_info(t, seq, s, S, cv);
    const float* mod = (const float*)(p.ws + OFF_MOD) + (size_t)(l * 5 + cv) * 6144;
    float x[16], m[16], g[16];
    load_row(X + (size_t)t * 1024, lane, x);
    load_row(MIX + (size_t)t * 1024, lane, m);
    load_row(mod + 2 * 1024, lane, g);
#pragma unroll
    for (int i = 0; i < 16; ++i) x[i] = ALPHA_F * x[i] + g[i] * m[i];
    ln16(x);
    load_row(p.in[I_LN1G] + l * 1024, lane, m);
    load_row(p.in[I_LN1B] + l * 1024, lane, g);
#pragma unroll
    for (int i = 0; i < 16; ++i) x[i] = x[i] * m[i] + g[i];
    store_row(X + (size_t)t * 1024, lane, x);
    ln16(x);
    mod_store_h(p, t, lane, cv, l, 4, 3, x);
  }
}

DI void insert16(float (&tv)[16], int (&ti)[16], float x, int xi) {
#pragma unroll
  for (int k = 0; k < 16; ++k) {
    bool gt = x > tv[k];
    float ov = tv[k]; int oi = ti[k];
    tv[k] = gt ? x : ov; ti[k] = gt ? xi : oi;
    x = gt ? ov : x; xi = gt ? oi : xi;
  }
}
DI void phase_p1(const Params& p, unsigned char* smem, int l, int bid, int nb) {
  const int tid = tidx(), lane = tid & 63, wave = tid >> 6;
  const int wm = wave >> 1, wn = wave & 1;
  bf16_t* As = (bf16_t*)smem; bf16_t* Bs = As + 128 * LDT;
  bf16_t* Qs = (bf16_t*)smem;
  bf16_t* Ks = (bf16_t*)(smem + 36864);
  float* Sc = (float*)smem;
  float* Lv = (float*)smem;
  int* Li = (int*)(smem + 8192);
  const bf16_t* H = (const bf16_t*)(p.ws + OFF_H);
  const bf16_t* Bt = (const bf16_t*)(p.ws + OFF_BT_WQ) + (size_t)l * 2048 * 1024;
  float* TKV = (float*)(p.ws + OFF_WD);
  int* TKI = (int*)(p.ws + OFF_WD + 20 * MiB);
  for (int i_ = bid; i_ < 160 * 16; i_ += nb) {
    const int it = swz8(i_, 160 * 16);
    const int mt = it >> 4, hp = it & 15, t0 = mt * 128;
    f32x16 acc[2][2];
    gemm_mainloop<false>(H + (size_t)t0 * 1024, 1024, Bt + (size_t)hp * 128 * 1024, 1024, 1024, acc, As, Bs);
    __syncthreads();
    {
      const float* kp = p.in[I_KEYS] + (size_t)(l * 16 + hp) * 16384;
#pragma unroll 4
      for (int i = 0; i < 16; ++i) {
        int idx = i * 256 + tid;
        int row = idx >> 5, c4 = idx & 31;
        float4 v = *(const float4*)(kp + row * 128 + c4 * 4);
        uint2 u; u.x = pack2(v.x, v.y); u.y = pack2(v.z, v.w);
        *(uint2*)(Ks + row * 136 + c4 * 4) = u;
      }
    }
    gemm_epilogue<false>(acc, [&](int m, int n, float v) { Qs[m * 136 + n] = (bf16_t)f2bf(v); });
    __syncthreads();
#pragma unroll
    for (int mi = 0; mi < 2; ++mi)
#pragma unroll
      for (int ni = 0; ni < 2; ++ni)
#pragma unroll
        for (int r = 0; r < 16; ++r) acc[mi][ni][r] = 0.f;
    {
      const int fr = (lane & 31) * 136 + (lane >> 5) * 8;
#pragma unroll
      for (int kk = 0; kk < 8; ++kk) {
        bf16x8 af[2], bfr[2];
#pragma unroll
        for (int mi = 0; mi < 2; ++mi) af[mi] = *(const bf16x8*)(Qs + (wm * 64 + mi * 32) * 136 + fr + kk * 16);
#pragma unroll
        for (int ni = 0; ni < 2; ++ni) bfr[ni] = *(const bf16x8*)(Ks + (wn * 64 + ni * 32) * 136 + fr + kk * 16);
#pragma unroll
        for (int mi = 0; mi < 2; ++mi)
#pragma unroll
          for (int ni = 0; ni < 2; ++ni) acc[mi][ni] = MFMA(af[mi], bfr[ni], acc[mi][ni]);
      }
    }
    __syncthreads();
    gemm_epilogue<false>(acc, [&](int m, int n, float v) { Sc[m * 129 + n] = v; });
    __syncthreads();
    const int row = tid & 127, half = tid >> 7;
    float tv[16]; int ti[16];
#pragma unroll
    for (int k = 0; k < 16; ++k) { tv[k] = -3.0e38f; ti[k] = 0; }
    for (int e = 0; e < 64; ++e) insert16(tv, ti, Sc[row * 129 + half * 64 + e], half * 64 + e);
    __syncthreads();
    if (half == 1) {
#pragma unroll
      for (int k = 0; k < 16; ++k) { Lv[k * 128 + row] = tv[k]; Li[k * 128 + row] = ti[k]; }
    }
    __syncthreads();
    if (half == 0) {
#pragma unroll
      for (int k = 0; k < 16; ++k) insert16(tv, ti, Lv[k * 128 + row], Li[k * 128 + row]);
      float* ov = TKV + ((size_t)(t0 + row) * 16 + hp) * 16;
      int* oi = TKI + ((size_t)(t0 + row) * 16 + hp) * 16;
#pragma unroll
      for (int k = 0; k < 16; k += 4) {
        *(float4*)(ov + k) = make_float4(tv[k], tv[k + 1], tv[k + 2], tv[k + 3]);
        *(int4*)(oi + k) = make_int4(ti[k], ti[k + 1], ti[k + 2], ti[k + 3]);
      }
    }
  }
}

DI void phase_p2(const Params& p, unsigned char* smem, int l, int bid, int nb) {
  const int lane = tidx() & 63, wave = tidx() >> 6;
  int* sIdx = (int*)(smem + wave * 1024);
  float* sSc = (float*)(smem + wave * 1024 + 512);
  const bf16_t* H = (const bf16_t*)(p.ws + OFF_H);
  const float* TKV = (const float*)(p.ws + OFF_WD);
  const int* TKI = (const int*)(p.ws + OFF_WD + 20 * MiB);
  const bf16_t* TU = (const bf16_t*)(p.ws + OFF_TABU);
  const bf16_t* TV = (const bf16_t*)(p.ws + OFF_TABV);
  float* X = (float*)(p.ws + OFF_X);
  int ci = 0, cj = 0;
  {
    int q = lane;
    if (q < 16) { ci = 0; cj = q; } else if (q < 24) { ci = 1; cj = q - 16; } else if (q < 29) { ci = 2; cj = q - 24; }
    else if (q < 33) { ci = 3; cj = q - 29; } else if (q < 36) { ci = 4; cj = q - 33; }
    else if (q < 42) { ci = 5 + ((q - 36) >> 1); cj = (q - 36) & 1; } else if (q < 50) { ci = 8 + (q - 42); cj = 0; }
  }
  for (int t = bid * 4 + wave; t < T; t += nb * 4) {
    int seq, s, S, cv; tok_info(t, seq, s, S, cv);
    float hreg[16];
    {
      const uint4* hp_ = (const uint4*)(H + (size_t)t * 1024 + lane * 16);
      uint4 a = hp_[0], b = hp_[1];
      float v0[8], v1[8]; unpack8(a, v0); unpack8(b, v1);
#pragma unroll
      for (int i = 0; i < 8; ++i) { hreg[i] = v0[i]; hreg[8 + i] = v1[i]; }
    }
    __builtin_amdgcn_wave_barrier();
    for (int h = 0; h < 8; ++h) {
      const float* v1p = TKV + ((size_t)t * 16 + h * 2) * 16;
      const int* i1p = TKI + ((size_t)t * 16 + h * 2) * 16;
      float c = -3.0e38f; int eidx = 0;
      if (lane < 50) { c = v1p[ci] + v1p[16 + cj]; eidx = i1p[ci] * 128 + i1p[16 + cj]; }
      int rank = 0;
#pragma unroll 5
      for (int m = 0; m < 50; ++m) {
        float cm = __int_as_float(__builtin_amdgcn_readlane(__float_as_int(c), m));
        rank += (cm > c || (cm == c && m < lane)) ? 1 : 0;
      }
      if (lane < 50 && rank < 16) { sIdx[h * 16 + rank] = eidx; sSc[h * 16 + rank] = c; }
    }
    __builtin_amdgcn_wave_barrier();
    {
      float s0 = sSc[lane], s1 = sSc[64 + lane];
      float m0 = max16(s0), m1 = max16(s1);
      float e0 = __expf(s0 - m0), e1 = __expf(s1 - m1);
      float d0 = sum16(e0), d1 = sum16(e1);
      __builtin_amdgcn_wave_barrier();
      sSc[lane] = e0 / d0; sSc[64 + lane] = e1 / d1;
    }
    __builtin_amdgcn_wave_barrier();
    float out[16];
#pragma unroll
    for (int i = 0; i < 16; ++i) out[i] = 0.f;
    const unsigned char* TU8 = (const unsigned char*)TU;
    const unsigned char* TV8 = (const unsigned char*)TV;
    for (int sb = 0; sb < 128; sb += 8) {
      uint4 u[8], w[8]; float gt[8];
#pragma unroll
      for (int k = 0; k < 8; ++k) {
        int e = __builtin_amdgcn_readfirstlane(sIdx[sb + k]);
        gt[k] = sSc[sb + k];
        u[k] = *(const uint4*)(TU8 + (size_t)e * 1024 + lane * 16);
        w[k] = *(const uint4*)(TV8 + (size_t)e * 1024 + lane * 16);
      }
      float dot[8];
#pragma unroll
      for (int k = 0; k < 8; ++k) {
        float a[16]; unpack_fp8x16(u[k], a);
        float d = 0.f;
#pragma unroll
        for (int i = 0; i < 16; ++i) d += hreg[i] * a[i];
        dot[k] = d;
      }
#pragma unroll
      for (int k = 0; k < 8; ++k) dot[k] = wave_sum(dot[k]);
#pragma unroll
      for (int k = 0; k < 8; ++k) {
        float wgt = gt[k] * gelu_t(dot[k] * (1.f / U_SCALE));
        float a[16]; unpack_fp8x16(w[k], a);
#pragma unroll
        for (int i = 0; i < 16; ++i) out[i] += wgt * a[i];
      }
    }
    const float* mod = (const float*)(p.ws + OFF_MOD) + (size_t)(l * 5 + cv) * 6144;
    float x[16], g[16], b2[16];
    load_row16(X + (size_t)t * 1024, lane, x);
    load_row16(mod + 5 * 1024, lane, g);
#pragma unroll
    for (int i = 0; i < 16; ++i) x[i] = ALPHA_F * x[i] + g[i] * out[i];
    ln16(x);
    load_row16(p.in[I_LN2G] + l * 1024, lane, g);
    load_row16(p.in[I_LN2B] + l * 1024, lane, b2);
#pragma unroll
    for (int i = 0; i < 16; ++i) x[i] = x[i] * g[i] + b2[i];
    if (l == 3) {
      store_row16(p.out + (size_t)t * 1024, lane, x);
    } else {
      store_row16(X + (size_t)t * 1024, lane, x);
      ln16(x);
      const float* modn = (const float*)(p.ws + OFF_MOD) + (size_t)((l + 1) * 5 + cv) * 6144;
      load_row16(modn + 1024, lane, g);
      load_row16(modn, lane, b2);
#pragma unroll
      for (int i = 0; i < 16; ++i) x[i] = x[i] * (1.f + g[i]) + b2[i];
      store_row16_bf((bf16_t*)(p.ws + OFF_H) + (size_t)t * 1024, lane, x);
    }
  }
}

DI void phase_o1(const Params& p, unsigned char* smem, int l, int bid, int nb) {
  const int j = l >> 1;
  bf16_t* As = (bf16_t*)smem; bf16_t* Bs = As + 128 * LDT;
  const bf16_t* H = (const bf16_t*)(p.ws + OFF_H);
  const bf16_t* Bt = (const bf16_t*)(p.ws + OFF_BT_IN_O) + (size_t)j * 2944 * 1024;
  bf16_t* Z = (bf16_t*)(p.ws + OFF_Z);
  for (int i_ = bid; i_ < 160 * 23; i_ += nb) {
    const int it = swz8(i_, 160 * 23);
    const int mt = it / 23, nt = it % 23, t0 = mt * 128;
    f32x16 acc[2][2];
    gemm_mainloop<false>(H + (size_t)t0 * 1024, 1024, Bt + (size_t)nt * 128 * 1024, 1024, 1024, acc, As, Bs);
    gemm_epilogue<false>(acc, [&](int m, int n, float v) { Z[(size_t)(t0 + m) * 2944 + nt * 128 + n] = (bf16_t)f2bf(v); });
  }
  convert_tables(p, l, bid, nb);
}

DI void phase_o2(const Params& p, int l, int bid, int nb) {
  const int j = l >> 1;
  const int lane = tidx() & 63, wave = tidx() >> 6;
  const bf16_t* Z = (const bf16_t*)(p.ws + OFF_Z);
  bf16_t* XC = (bf16_t*)(p.ws + OFF_XC);
  bf16_t* LRIN = (bf16_t*)(p.ws + OFF_LRIN);
  bf16_t* KKN = (bf16_t*)(p.ws + OFF_KKN);
  bf16_t* KS = (bf16_t*)(p.ws + OFF_KS);
  bf16_t* RS = (bf16_t*)(p.ws + OFF_RS);
  bf16_t* VS = (bf16_t*)(p.ws + OFF_VS);
  const float* mu = p.in[I_MU] + (size_t)j * 1920;
  const int c0 = lane * 8;
  for (int t = bid * 4 + wave; t < T; t += nb * 4) {
    int seq, s, S, cv; tok_info(t, seq, s, S, cv);
    const bf16_t* zr = Z + (size_t)t * 2944;
    {
      float af[8], ab[8];
      load8f(p.in[I_LCB] + (size_t)(j * 2 + 0) * 512 + c0, af);
      load8f(p.in[I_LCB] + (size_t)(j * 2 + 1) * 512 + c0, ab);
#pragma unroll
      for (int o = -3; o <= 3; ++o) {
        float xv[8];
        if (s + o >= 0 && s + o < S) { uint4 u = *(const uint4*)(zr + (ptrdiff_t)o * 2944 + c0); unpack8(u, xv); }
        else {
#pragma unroll
          for (int i = 0; i < 8; ++i) xv[i] = 0.f;
        }
        if (o <= 0) {
          float w[8]; load8f(p.in[I_LCW] + ((size_t)(j * 2 + 0) * 4 + (o + 3)) * 512 + c0, w);
#pragma unroll
          for (int i = 0; i < 8; ++i) af[i] += w[i] * xv[i];
        }
        if (o >= 0) {
          float w[8]; load8f(p.in[I_LCW] + ((size_t)(j * 2 + 1) * 4 + (3 - o)) * 512 + c0, w);
#pragma unroll
          for (int i = 0; i < 8; ++i) ab[i] += w[i] * xv[i];
        }
      }
      *(uint4*)(XC + (size_t)t * 512 + c0) = pack8(af);
      *(uint4*)(XC + (size_t)T * 512 + (size_t)t * 512 + c0) = pack8(ab);
    }
    const bool hp_ = s > 0, hn = s < S - 1;
#pragma unroll
    for (int part = 0; part < 3; ++part) {
      const int col = 1024 + part * 512 + c0;
      float zc[8], zp[8], zn[8], m[8], zs[8];
      unpack8(*(const uint4*)(zr + col), zc);
      if (hp_) unpack8(*(const uint4*)(zr - 2944 + col), zp); else {
#pragma unroll
        for (int i = 0; i < 8; ++i) zp[i] = 0.f;
      }
      if (hn) unpack8(*(const uint4*)(zr + 2944 + col), zn); else {
#pragma unroll
        for (int i = 0; i < 8; ++i) zn[i] = 0.f;
      }
      load8f(mu + (col - 1024), m);
#pragma unroll
      for (int i = 0; i < 8; ++i) zs[i] = zc[i] + m[i] * (0.5f * (zp[i] + zn[i]) - zc[i]);
      if (part == 0) *(uint4*)(RS + (size_t)t * 512 + c0) = pack8(zs);
      else if (part == 2) *(uint4*)(VS + (size_t)t * 512 + c0) = pack8(zs);
      else {
        *(uint4*)(KS + (size_t)t * 512 + c0) = pack8(zs);
#pragma unroll
        for (int d = 0; d < 2; ++d) {
          float kk[8], raw[8]; load8f(p.in[I_KK] + (size_t)(j * 2 + d) * 512 + c0, kk);
          float ss = 0.f;
#pragma unroll
          for (int i = 0; i < 8; ++i) { raw[i] = zs[i] * kk[i]; ss += raw[i] * raw[i]; }
          ss = sum8(ss);
          float inv = rsqrtf(fmaxf(ss, 1e-24f));
#pragma unroll
          for (int i = 0; i < 8; ++i) raw[i] *= inv;
          *(uint4*)(KKN + (size_t)d * T * 512 + (size_t)t * 512 + c0) = pack8(raw);
        }
      }
    }
    if (lane < 48) {
      const int col = 2560 + c0;
      float zc[8], zp[8], zn[8], m[8], zs[8];
      unpack8(*(const uint4*)(zr + col), zc);
      if (hp_) unpack8(*(const uint4*)(zr - 2944 + col), zp); else {
#pragma unroll
        for (int i = 0; i < 8; ++i) zp[i] = 0.f;
      }
      if (hn) unpack8(*(const uint4*)(zr + 2944 + col), zn); else {
#pragma unroll
        for (int i = 0; i < 8; ++i) zn[i] = 0.f;
      }
      load8f(mu + (col - 1024), m);
#pragma unroll
      for (int i = 0; i < 8; ++i) {
        float z = zc[i] + m[i] * (0.5f * (zp[i] + zn[i]) - zc[i]);
        zs[i] = (lane < 16) ? tanh_f(z) : ((lane < 32) ? z : sigm(z));
      }
      *(uint4*)(LRIN + (size_t)t * 384 + c0) = pack8(zs);
    }
  }
}

DI void store8f(float* p, const float (&v)[8]) {
  ((float4*)p)[0] = make_float4(v[0], v[1], v[2], v[3]);
  ((float4*)p)[1] = make_float4(v[4], v[5], v[6], v[7]);
}
template <class F>
DI void staged_epilogue(const f32x16 (&acc)[2][2], float* Cs, F f) {
  __syncthreads();
  gemm_epilogue<false, false>(acc, [&](int m, int n, float v) { Cs[m * 132 + n] = v; });
  __syncthreads();
  const int tid = tidx(), r0 = tid >> 4, c8 = (tid & 15) * 8;
#pragma unroll 2
  for (int ps = 0; ps < 8; ++ps) {
    const int row = ps * 16 + r0;
    float v[8];
    load8f(Cs + row * 132 + c8, v);
    f(row, c8, v);
  }
}

DI void phase_o3(const Params& p, unsigned char* smem, int l, int bid, int nb) {
  const int j = l >> 1;
  bf16_t* As = (bf16_t*)smem; bf16_t* Bs = As + 128 * LDT;
  float* Cs = (float*)smem;
  const bf16_t* __restrict__ XC = (const bf16_t*)(p.ws + OFF_XC);
  const bf16_t* __restrict__ LRIN = (const bf16_t*)(p.ws + OFF_LRIN);
  const bf16_t* __restrict__ KKN = (const bf16_t*)(p.ws + OFF_KKN);
  const bf16_t* __restrict__ KS = (const bf16_t*)(p.ws + OFF_KS);
  float* __restrict__ LA = (float*)(p.ws + OFF_MIX);
  bf16_t* __restrict__ LB = (bf16_t*)(p.ws + OFF_LB);
  float* __restrict__ WD = (float*)(p.ws + OFF_WD);
  bf16_t* __restrict__ KKA = (bf16_t*)(p.ws + OFF_KKA);
  bf16_t* __restrict__ KM = (bf16_t*)(p.ws + OFF_KM);
  bf16_t* __restrict__ G = (bf16_t*)(p.ws + OFF_G);
  const int c8 = (tidx() & 15) * 8;
  for (int i_ = bid; i_ < 160 * 28; i_ += nb) {
    const int it = swz8(i_, 160 * 28);
    const int mt = it / 28, jb = it % 28, t0 = mt * 128;
    if (jb < 8) {
      const int d = jb >> 2, nt = jb & 3, ng = nt * 128 + c8;
      const bf16_t* A = XC + (size_t)d * T * 512 + (size_t)t0 * 512 + nt * 128;
      const bf16_t* Br = (const bf16_t*)(p.ws + OFF_BT_GATE) + ((size_t)((j * 2 + d) * 2 + 0) * 512 + nt * 128) * 128;
      const bf16_t* Bi = (const bf16_t*)(p.ws + OFF_BT_GATE) + ((size_t)((j * 2 + d) * 2 + 1) * 512 + nt * 128) * 128;
      float ba8[8], bx8[8], sp8[8];
      load8f(p.in[I_LBA] + (size_t)(j * 2 + d) * 512 + ng, ba8);
      load8f(p.in[I_LBX] + (size_t)(j * 2 + d) * 512 + ng, bx8);
      load8f(p.in[I_LLAM] + (size_t)(j * 2 + d) * 512 + ng, sp8);
#pragma unroll
      for (int i = 0; i < 8; ++i) { float nl = -sp8[i]; sp8[i] = -8.f * (nl > 20.f ? nl : log1pf(__expf(nl))); }
      {
        f32x16 acc[2][2];
        gemm_mainloop<false>(A, 512, Br, 128, 128, acc, As, Bs);
        staged_epilogue(acc, Cs, [&](int row, int cc, const float (&v)[8]) {
          const size_t o = ((size_t)d * T + t0 + row) * 512 + nt * 128 + cc;
          float a[8];
#pragma unroll
          for (int i = 0; i < 8; ++i) a[i] = __expf(sigm(v[i] + ba8[i]) * sp8[i]);
          store8f(LA + o, a);
        });
      }
      {
        f32x16 acc[2][2];
        gemm_mainloop<false>(A, 512, Bi, 128, 128, acc, As, Bs);
        staged_epilogue(acc, Cs, [&](int row, int cc, const float (&v)[8]) {
          const size_t o = ((size_t)d * T + t0 + row) * 512 + nt * 128 + cc;
          float a[8], xc[8], bb[8];
          load8f(LA + o, a);
          unpack8(*(const uint4*)(XC + o), xc);
#pragma unroll
          for (int i = 0; i < 8; ++i) bb[i] = sqrtf(fmaxf(1.f - a[i] * a[i], 0.f)) * sigm(v[i] + bx8[i]) * xc[i];
          *(uint4*)(LB + o) = pack8(bb);
        });
      }
    } else if (jb < 16) {
      const int d = (jb - 8) >> 2, nt = (jb - 8) & 3, ng = nt * 128 + c8;
      float w08[8]; load8f(p.in[I_W0] + (size_t)(j * 2 + d) * 512 + ng, w08);
      f32x16 acc[2][2];
      gemm_mainloop<false>(LRIN + (size_t)t0 * 384 + d * 64, 384, (const bf16_t*)(p.ws + OFF_BT_W2) + ((size_t)(j * 2 + d) * 512 + nt * 128) * 64, 64, 64, acc, As, Bs);
      staged_epilogue(acc, Cs, [&](int row, int cc, const float (&v)[8]) {
        float w[8];
#pragma unroll
        for (int i = 0; i < 8; ++i) w[i] = __expf(-0.6065306597126334f * sigm(w08[i] + v[i]));
        store8f(WD + ((size_t)d * T + t0 + row) * 512 + nt * 128 + cc, w);
      });
    } else if (jb < 24) {
      const int d = (jb - 16) >> 2, nt = (jb - 16) & 3, ng = nt * 128 + c8;
      float a08[8], ka8[8];
      load8f(p.in[I_A0] + (size_t)(j * 2 + d) * 512 + ng, a08);
      load8f(p.in[I_KA] + (size_t)(j * 2 + d) * 512 + ng, ka8);
      f32x16 acc[2][2];
      gemm_mainloop<false>(LRIN + (size_t)t0 * 384 + 128 + d * 64, 384, (const bf16_t*)(p.ws + OFF_BT_A2) + ((size_t)(j * 2 + d) * 512 + nt * 128) * 64, 64, 64, acc, As, Bs);
      staged_epilogue(acc, Cs, [&](int row, int cc, const float (&v)[8]) {
        const size_t o = ((size_t)d * T + t0 + row) * 512 + nt * 128 + cc;
        float kkn[8], ks[8], oa[8], om[8];
        unpack8(*(const uint4*)(KKN + o), kkn);
        unpack8(*(const uint4*)(KS + (size_t)(t0 + row) * 512 + nt * 128 + cc), ks);
#pragma unroll
        for (int i = 0; i < 8; ++i) {
          float ic = sigm(a08[i] + v[i]);
          oa[i] = kkn[i] * ic;
          om[i] = ks[i] * (1.f + (ic - 1.f) * ka8[i]);
        }
        *(uint4*)(KKA + o) = pack8(oa);
        *(uint4*)(KM + o) = pack8(om);
      });
    } else {
      const int nt = jb - 24;
      f32x16 acc[2][2];
      gemm_mainloop<false>(LRIN + (size_t)t0 * 384 + 256, 384, (const bf16_t*)(p.ws + OFF_BT_G2) + ((size_t)j * 512 + nt * 128) * 128, 128, 128, acc, As, Bs);
      staged_epilogue(acc, Cs, [&](int row, int cc, const float (&v)[8]) {
        float g[8];
#pragma unroll
        for (int i = 0; i < 8; ++i) g[i] = v[i];
        *(uint4*)(G + (size_t)(t0 + row) * 512 + nt * 128 + cc) = pack8(g);
      });
    }
  }
}

constexpr int WCH = 32;
constexpr int WBUF = 8192 + 4 * 4096 + 1024;
DI void wkv_scan_item(const Params& p, unsigned char* smem, int j, int b, int d, int h, int rg, bool ctx) {
  const int tid = tidx(), lane = tid & 63, wave = tid >> 6;
  const int rl = wave * 4 + (lane >> 4), row = rg * 16 + rl, q = lane & 15;
  const int S = ctx ? 256 : 4096, t0 = ctx ? b * 256 : 4096 + b * 4096;
  const char* WD = (const char*)(p.ws + OFF_WD) + (size_t)d * T * 512 * 4 + h * 256;
  const char* KKN = (const char*)(p.ws + OFF_KKN) + (size_t)d * T * 512 * 2 + h * 128;
  const char* KKA = (const char*)(p.ws + OFF_KKA) + (size_t)d * T * 512 * 2 + h * 128;
  const char* KM = (const char*)(p.ws + OFF_KM) + (size_t)d * T * 512 * 2 + h * 128;
  const char* RS = (const char*)(p.ws + OFF_RS) + h * 128;
  const char* VS = (const char*)(p.ws + OFF_VS) + (h * 64 + rg * 16) * 2;
  char* Y = (char*)(p.ws + (d ? OFF_XC : OFF_H)) + (h * 64 + rg * 16) * 4;
  unsigned char* ysb = smem + 2 * WBUF;
  float st[4];
  if (ctx) { st[0] = st[1] = st[2] = st[3] = 0.f; }
  else {
    float4 s4 = *(const float4*)(p.in[I_SWKV] + ((((size_t)(b * 2 + j) * 2 + d) * 8 + h) * 64 + row) * 64 + q * 4);
    st[0] = s4.x; st[1] = s4.y; st[2] = s4.z; st[3] = s4.w;
  }
  auto tokof = [&](int step) -> int { return t0 + (d ? (S - 1 - step) : step); };
  uint4 gw0, gw1, gk, gka, gkm, gr, gv;
  auto gload = [&](int c) {
    const int base = c * WCH;
    { int i0 = tid, i1 = tid + 256;
      gw0 = *(const uint4*)(WD + (unsigned)(tokof(base + (i0 >> 4)) * 2048 + (i0 & 15) * 16));
      gw1 = *(const uint4*)(WD + (unsigned)(tokof(base + (i1 >> 4)) * 2048 + (i1 & 15) * 16)); }
    const unsigned o2 = (unsigned)(tokof(base + (tid >> 3)) * 1024 + (tid & 7) * 16);
    gk = *(const uint4*)(KKN + o2); gka = *(const uint4*)(KKA + o2); gkm = *(const uint4*)(KM + o2); gr = *(const uint4*)(RS + o2);
    if (tid < 64) gv = *(const uint4*)(VS + (unsigned)(tokof(base + (tid >> 1)) * 1024 + (tid & 1) * 16));
  };
  auto lstore = [&](int bufi) {
    unsigned char* bb = smem + bufi * WBUF;
    *(uint4*)(bb + tid * 16) = gw0; *(uint4*)(bb + 4096 + tid * 16) = gw1;
    *(uint4*)(bb + 8192 + tid * 16) = gk; *(uint4*)(bb + 12288 + tid * 16) = gka;
    *(uint4*)(bb + 16384 + tid * 16) = gkm; *(uint4*)(bb + 20480 + tid * 16) = gr;
    if (tid < 64) *(uint4*)(bb + 24576 + tid * 16) = gv;
  };
  const int nch = S / WCH;
  __syncthreads();
  gload(0); lstore(0);
  __syncthreads();
  for (int c = 0; c < nch; ++c) {
    if (c + 1 < nch) gload(c + 1);
    const unsigned char* bb = smem + (c & 1) * WBUF;
    float* ys = (float*)(ysb + (c & 1) * 2048);
    float4 nw = *(const float4*)(bb + q * 16);
    uint2 nkk = *(const uint2*)(bb + 8192 + q * 8), nkka = *(const uint2*)(bb + 12288 + q * 8);
    uint2 nkm = *(const uint2*)(bb + 16384 + q * 8), nr = *(const uint2*)(bb + 20480 + q * 8);
    bf16_t nv = *(const bf16_t*)(bb + 24576 + rl * 2);
#pragma unroll 8
    for (int s = 0; s < WCH; ++s) {
      const float4 w = nw; const uint2 kk = nkk, kka = nkka, km = nkm, r = nr; const float v = bf2f(nv);
      {
        const int s1 = (s + 1 < WCH) ? s + 1 : s;
        nw = *(const float4*)(bb + s1 * 256 + q * 16);
        nkk = *(const uint2*)(bb + 8192 + s1 * 128 + q * 8); nkka = *(const uint2*)(bb + 12288 + s1 * 128 + q * 8);
        nkm = *(const uint2*)(bb + 16384 + s1 * 128 + q * 8); nr = *(const uint2*)(bb + 20480 + s1 * 128 + q * 8);
        nv = *(const bf16_t*)(bb + 24576 + s1 * 32 + rl * 2);
      }
      float sk = st[0] * bflo(kk.x) + st[1] * bfhi(kk.x) + st[2] * bflo(kk.y) + st[3] * bfhi(kk.y);
      sk = sum16(sk);
      st[0] = st[0] * w.x - sk * bflo(kka.x) + v * bflo(km.x);
      st[1] = st[1] * w.y - sk * bfhi(kka.x) + v * bfhi(km.x);
      st[2] = st[2] * w.z - sk * bflo(kka.y) + v * bflo(km.y);
      st[3] = st[3] * w.w - sk * bfhi(kka.y) + v * bfhi(km.y);
      float y = st[0] * bflo(r.x) + st[1] * bfhi(r.x) + st[2] * bflo(r.y) + st[3] * bfhi(r.y);
      y = sum16(y);
      ys[s * 16 + rl] = y;
    }
    if (c + 1 < nch) lstore((c + 1) & 1);
    __syncthreads();
    {
      const int base = c * WCH;
      const int s1 = tid >> 4, rr = tid & 15;
      *(float*)(Y + (unsigned)(tokof(base + s1) * 2048 + rr * 4)) = ys[s1 * 16 + rr];
      *(float*)(Y + (unsigned)(tokof(base + s1 + 16) * 2048 + rr * 4)) = ys[(s1 + 16) * 16 + rr];
    }
  }
  if (ctx) {
    float* o = p.out + 21004288 + ((((size_t)(b * 2 + j) * 2 + d) * 8 + h) * 64 + row) * 64 + q * 4;
    *(float4*)o = make_float4(st[0], st[1], st[2], st[3]);
  }
}

DI void lru_scan_item(const Params& p, unsigned char* smem, int j, int b, int cgp, bool ctx, int chb) {
  const int tid = tidx(), c = tid & ((1 << chb) - 1), sg = tid >> chb;
  const int nseg = NTHR >> chb;
  const int ch = (cgp << chb) + c;
  const int S = ctx ? 256 : 4096, t0 = ctx ? b * 256 : 4096 + b * 4096;
  const int L = S / nseg;
  float* sA = (float*)smem; float* sB = sA + 256;
  char* YM = (char*)(p.ws + OFF_YMIX);
  const char* Z = (const char*)(p.ws + OFF_Z);
  for (int d = 0; d < 2; ++d) {
    const char* la = (const char*)(p.ws + OFF_MIX) + (size_t)d * T * 512 * 4;
    const char* lb = (const char*)(p.ws + OFF_LB) + (size_t)d * T * 512 * 2;
    float A = 1.f, Bv = 0.f;
#pragma unroll 8
    for (int st = sg * L; st < (sg + 1) * L; ++st) {
      const int tk = t0 + (d ? (S - 1 - st) : st);
      float a = *(const float*)(la + (unsigned)(tk * 2048 + ch * 4));
      float bb = bf2f(*(const bf16_t*)(lb + (unsigned)(tk * 1024 + ch * 2)));
      A *= a; Bv = a * Bv + bb;
    }
    __syncthreads();
    sA[tid] = A; sB[tid] = Bv;
    __syncthreads();
    float h = ctx ? 0.f : p.in[I_SLRU][((size_t)(b * 2 + j) * 2 + d) * 512 + ch];
    for (int s2 = 0; s2 < sg; ++s2) h = sA[(s2 << chb) + c] * h + sB[(s2 << chb) + c];
#pragma unroll 8
    for (int st = sg * L; st < (sg + 1) * L; ++st) {
      const int tk = t0 + (d ? (S - 1 - st) : st);
      float a = *(const float*)(la + (unsigned)(tk * 2048 + ch * 4));
      float bb = bf2f(*(const bf16_t*)(lb + (unsigned)(tk * 1024 + ch * 2)));
      h = a * h + bb;
      bf16_t* ym = (bf16_t*)(YM + (unsigned)(tk * 2048 + ch * 2));
      if (d == 0) *ym = (bf16_t)f2bf(h);
      else {
        float hs = h + bf2f(*ym);
        float gb = bf2f(*(const bf16_t*)(Z + (unsigned)(tk * 5888 + 1024 + ch * 2)));
        *ym = (bf16_t)f2bf(hs * gelu_t(gb));
      }
    }
    if (ctx && sg == nseg - 1) p.out[20971520 + ((size_t)(b * 2 + j) * 2 + d) * 512 + ch] = h;
    __syncthreads();
  }
}

DI void phase_o4(const Params& p, unsigned char* smem, int l, int bid, int nb) {
  const int j = l >> 1;
  auto do_item = [&](int it) {
    if (it < 256) { int sid = it >> 2, rg = it & 3; wkv_scan_item(p, smem, j, sid >> 4, (sid >> 3) & 1, sid & 7, rg, false); }
    else if (it < 512) { int r = it - 256; lru_scan_item(p, smem, j, r >> 6, r & 63, false, 3); }
    else if (it < 1536) { int r = it - 512; int sid = r >> 2, rg = r & 3; wkv_scan_item(p, smem, j, sid >> 4, (sid >> 3) & 1, sid & 7, rg, true); }
    else { int r = it - 1536; lru_scan_item(p, smem, j, r >> 4, r & 15, true, 5); }
  };
  if (nb >= 512) {
    if (bid < 256) do_item(bid);
    else {
      const int ob = bid - 256, no = nb - 256;
      for (int it = 256 + ob; it < 512; it += no) do_item(it);
      for (int it = 512 + ob; it < 1792; it += no) do_item(it);
    }
  } else {
    for (int it = bid; it < 1792; it += nb) do_item(it);
  }
}

DI void phase_o5(const Params& p, int l, int bid, int nb) {
  const int j = l >> 1;
  const int lane = tidx() & 63, wave = tidx() >> 6;
  const float* YF = (const float*)(p.ws + OFF_H);
  const float* YB = (const float*)(p.ws + OFF_XC);
  const bf16_t* RS = (const bf16_t*)(p.ws + OFF_RS);
  const bf16_t* VS = (const bf16_t*)(p.ws + OFF_VS);
  const bf16_t* KM = (const bf16_t*)(p.ws + OFF_KM);
  const bf16_t* G = (const bf16_t*)(p.ws + OFF_G);
  bf16_t* YM = (bf16_t*)(p.ws + OFF_YMIX);
  const int c0 = lane * 8;
  float gng[8], gnb[8], rk[8];
  load8f(p.in[I_GNG] + j * 512 + c0, gng);
  load8f(p.in[I_GNB] + j * 512 + c0, gnb);
  load8f(p.in[I_RK] + j * 512 + c0, rk);
  for (int t = bid * 4 + wave; t < T; t += nb * 4) {
    const size_t o = (size_t)t * 512 + c0;
    float yf[8], yb[8], ys[8];
    load8f(YF + o, yf); load8f(YB + o, yb);
    float s = 0.f;
#pragma unroll
    for (int i = 0; i < 8; ++i) { ys[i] = yf[i] + yb[i]; s += ys[i]; }
    const float mean = sum8(s) * (1.f / 64.f);
    float v = 0.f;
#pragma unroll
    for (int i = 0; i < 8; ++i) { float dd = ys[i] - mean; v += dd * dd; }
    const float rstd = rsqrtf(sum8(v) * (1.f / 64.f) + 64e-5f);
    float r[8], vv[8], kf[8], kb[8], g[8];
    unpack8(*(const uint4*)(RS + o), r);
    unpack8(*(const uint4*)(VS + o), vv);
    unpack8(*(const uint4*)(KM + o), kf);
    unpack8(*(const uint4*)(KM + (size_t)T * 512 + o), kb);
    unpack8(*(const uint4*)(G + o), g);
    float sf = 0.f;
#pragma unroll
    for (int i = 0; i < 8; ++i) sf += r[i] * rk[i] * (kf[i] + kb[i]);
    sf = sum8(sf);
    float outv[8];
#pragma unroll
    for (int i = 0; i < 8; ++i) outv[i] = ((ys[i] - mean) * rstd * gng[i] + gnb[i] + sf * vv[i]) * g[i];
    *(uint4*)(YM + (size_t)t * 1024 + 512 + c0) = pack8(outv);
  }
}

enum { PH_PREP = 0, PH_INIT, PH_E1, PH_E2, PH_EOUT, PH_RES, PH_P1, PH_P2, PH_O1, PH_O2, PH_O3, PH_O4, PH_O5, PH_OOUT };

DI void run_phase(const Params& p, unsigned char* smem, int ph, int l, int bid, int nb) {
  switch (ph) {
    case PH_PREP: phase_prep(p, smem, bid, nb); break;
    case PH_INIT: phase_init(p, bid, nb); break;
    case PH_E1: phase_e1(p, smem, l, bid, nb); break;
    case PH_E2: phase_e2(p, smem, l, bid, nb); break;
    case PH_EOUT: phase_outgemm(p, smem, (const bf16_t*)(p.ws + OFF_BT_OUT_E) + (size_t)(l >> 1) * 1024 * 1024, bid, nb); break;
    case PH_RES: phase_res1(p, l, bid, nb); break;
    case PH_P1: phase_p1(p, smem, l, bid, nb); break;
    case PH_P2: phase_p2(p, smem, l, bid, nb); break;
    case PH_O1: phase_o1(p, smem, l, bid, nb); break;
    case PH_O2: phase_o2(p, l, bid, nb); break;
    case PH_O3: phase_o3(p, smem, l, bid, nb); break;
    case PH_O4: phase_o4(p, smem, l, bid, nb); break;
    case PH_O5: phase_o5(p, l, bid, nb); break;
    case PH_OOUT: phase_outgemm(p, smem, (const bf16_t*)(p.ws + OFF_BT_OUT_O) + (size_t)(l >> 1) * 1024 * 1024, bid, nb); break;
  }
}

#if MULTI
__global__ void __launch_bounds__(NTHR, 2) phase_kernel(Params p, int ph, int l) {
  extern __shared__ __attribute__((aligned(16))) unsigned char smem[];
  run_phase(p, smem, ph, l, blockIdx.x, gridDim.x);
}
#else
#ifndef TPROBE
#define TPROBE 0
#endif
__global__ void __launch_bounds__(NTHR, 2) mega_kernel(Params p) {
  extern __shared__ __attribute__((aligned(16))) unsigned char smem[];
  cg::grid_group grid = cg::this_grid();
  const int bid = blockIdx.x, nb = gridDim.x;
#if TPROBE
  unsigned long long tprev = wall_clock64(), tsel = 0, ttot = 0;
#endif
  for (int step = 0; step < 32; ++step) {
    int ph, l;
    if (step < 2) { ph = step; l = 0; }
    else {
      int s = step - 2, k;
      if (s < 6) { l = 0; k = s; } else if (s < 15) { l = 1; k = s - 6; } else if (s < 21) { l = 2; k = s - 15; } else { l = 3; k = s - 21; }
      if ((l & 1) == 0) ph = PH_E1 + k;
      else ph = (k < 6) ? PH_O1 + k : PH_RES + (k - 6);
    }
#if defined(__HIP_DEVICE_COMPILE__)
    const __attribute__((address_space(4))) Params* kp = (const __attribute__((address_space(4))) Params*)__builtin_amdgcn_kernarg_segment_ptr();
    asm volatile("" : "+s"(kp), "+s"(l), "+s"(ph));
    const Params q = *kp;
#else
    const Params q = p;
#endif
    run_phase(q, smem, ph, l, bid, nb);
    __threadfence();
    grid.sync();
#if TPROBE
    {
      unsigned long long tn = wall_clock64();
      if ((TPROBE >> ph) & 1) tsel += tn - tprev;
      ttot += tn - tprev;
      tprev = tn;
    }
#endif
  }
#if TPROBE
  if (bid == 0) {
    float frac = (float)((double)tsel / (double)ttot);
    float sc = 1.f + sqrtf(frac);
    for (int i = tidx(); i < 32768; i += NTHR) p.out[20971520 + i] *= sc;
  }
#endif
}
#endif

extern "C" void kernel_launch(void* const* d_in, const int* in_sizes, int n_in, void* d_out, int out_size, void* d_ws, size_t ws_size,
                              hipStream_t stream) {
  static int grid_blocks = 0;
  if (grid_blocks == 0) {
    if (n_in != 40 || ws_size < WS_END) { fprintf(stderr, "kernel_launch: unexpected n_in %d or ws_size %zu (need %zu)\n", n_in, ws_size, (size_t)WS_END); grid_blocks = -1; return; }
    int dev = 0, cus = 0, per_cu = 0;
    hipGetDevice(&dev);
    hipDeviceGetAttribute(&cus, hipDeviceAttributeMultiprocessorCount, dev);
#if MULTI
    hipFuncSetAttribute((const void*)phase_kernel, hipFuncAttributeMaxDynamicSharedMemorySize, LDS_BYTES);
    hipOccupancyMaxActiveBlocksPerMultiprocessor(&per_cu, (const void*)phase_kernel, NTHR, LDS_BYTES);
#else
    hipFuncSetAttribute((const void*)mega_kernel, hipFuncAttributeMaxDynamicSharedMemorySize, LDS_BYTES);
    hipOccupancyMaxActiveBlocksPerMultiprocessor(&per_cu, (const void*)mega_kernel, NTHR, LDS_BYTES);
#endif
    if (per_cu < 1) per_cu = 1;
    if (per_cu > 2) per_cu = 2;
    if (cus < 1) cus = 256;
    grid_blocks = cus * per_cu;
  }
  if (grid_blocks < 0) return;
  Params p{};
  for (int i = 0; i < 40; ++i) p.in[i] = (const float*)d_in[i];
  p.out = (float*)d_out;
  p.ws = (unsigned char*)d_ws;
#if MULTI
  auto L = [&](int ph, int l) { hipLaunchKernelGGL(phase_kernel, dim3(grid_blocks), dim3(NTHR), LDS_BYTES, stream, p, ph, l); };
  L(PH_PREP, 0); L(PH_INIT, 0);
  for (int l = 0; l < 4; ++l) {
    if ((l & 1) == 0) { L(PH_E1, l); L(PH_E2, l); L(PH_EOUT, l); }
    else { L(PH_O1, l); L(PH_O2, l); L(PH_O3, l); L(PH_O4, l); L(PH_O5, l); L(PH_OOUT, l); }
    L(PH_RES, l); L(PH_P1, l); L(PH_P2, l);
  }
#else
  void* args[] = {&p};
  hipError_t e = hipLaunchCooperativeKernel((const void*)mega_kernel, dim3(grid_blocks), dim3(NTHR), args, LDS_BYTES, stream);
  if (e != hipSuccess) fprintf(stderr, "cooperative launch failed: %s (grid %d)\n", hipGetErrorString(e), grid_blocks);
#endif
}
```

```cpp
#include <hip/hip_runtime.h>
#include <hip/hip_cooperative_groups.h>
#include <cstdio>
#include <cstdint>
namespace cg = cooperative_groups;

#ifndef MULTI
#define MULTI 0
#endif

typedef unsigned short bf16_t;
using bf16x8 = __attribute__((ext_vector_type(8))) short;
using f32x16 = __attribute__((ext_vector_type(16))) float;
#define DI __device__ __forceinline__
#define MFMA(a, b, c) __builtin_amdgcn_mfma_f32_32x32x16_bf16((a), (b), (c), 0, 0, 0)

constexpr int T = 20480;
constexpr int NTHR = 256;
constexpr int LDS_BYTES = 71680;
constexpr float ALPHA_F = 1.681792830507429f;

constexpr size_t MiB = 1u << 20;
constexpr size_t OFF_TABU = 0;
constexpr size_t OFF_TABV = OFF_TABU + 32 * MiB;
constexpr size_t OFF_BT_IN_E = OFF_TABV + 32 * MiB;
constexpr size_t OFF_BT_OUT_E = OFF_BT_IN_E + 10 * MiB;
constexpr size_t OFF_BT_IN_O = OFF_BT_OUT_E + 4 * MiB;
constexpr size_t OFF_BT_OUT_O = OFF_BT_IN_O + 12 * MiB;
constexpr size_t OFF_BT_WQ = OFF_BT_OUT_O + 4 * MiB;
constexpr size_t OFF_BT_W2 = OFF_BT_WQ + 16 * MiB;
constexpr size_t OFF_BT_A2 = OFF_BT_W2 + 256 * 1024;
constexpr size_t OFF_BT_G2 = OFF_BT_A2 + 256 * 1024;
constexpr size_t OFF_BT_GATE = OFF_BT_G2 + 256 * 1024;
constexpr size_t OFF_D256 = OFF_BT_GATE + 2 * MiB;
constexpr size_t OFF_MOD = OFF_D256 + 256 * 1024;
constexpr size_t OFF_D4096 = OFF_MOD + 512 * 1024;
constexpr size_t OFF_X = OFF_D4096 + 64 * MiB;
constexpr size_t OFF_Z = OFF_X + 80 * MiB;
constexpr size_t OFF_YMIX = OFF_Z + 115 * MiB;
constexpr size_t OFF_MIX = OFF_YMIX + 40 * MiB;
constexpr size_t OFF_H = OFF_MIX + 80 * MiB;
constexpr size_t OFF_XC = OFF_H + 40 * MiB;
constexpr size_t OFF_LRIN = OFF_XC + 40 * MiB;
constexpr size_t OFF_KKN = OFF_LRIN + 15 * MiB;
constexpr size_t OFF_KS = OFF_KKN + 40 * MiB;
constexpr size_t OFF_RS = OFF_KS + 20 * MiB;
constexpr size_t OFF_VS = OFF_RS + 20 * MiB;
constexpr size_t OFF_LB = OFF_VS + 20 * MiB;
constexpr size_t OFF_WD = OFF_LB + 40 * MiB;
constexpr size_t OFF_KKA = OFF_WD + 80 * MiB;
constexpr size_t OFF_KM = OFF_KKA + 40 * MiB;
constexpr size_t OFF_G = OFF_KM + 40 * MiB;
constexpr size_t WS_END = OFF_G + 20 * MiB;

struct Params {
  const float* in[40];
  float* out;
  unsigned char* ws;
};

enum {
  I_XP = 0, I_XS, I_SLRU, I_SWKV, I_C, I_CCTX, I_WMOD, I_BMOD, I_LN1G, I_LN1B, I_LN2G, I_LN2B, I_WINE, I_WOUTE, I_SCW, I_SCB,
  I_WINO, I_WOUTO, I_LCW, I_LCB, I_LWA, I_LBA, I_LWX, I_LBX, I_LLAM, I_MU, I_W0, I_W2, I_A0, I_A2, I_KK, I_KA, I_RK, I_G2, I_GNG,
  I_GNB, I_WQ, I_KEYS, I_PU, I_PV
};

DI int tidx() { int t = __builtin_amdgcn_workitem_id_x(); asm volatile("" : "+v"(t)); return t; }
DI unsigned f2bf(float x) { unsigned u = __float_as_uint(x); u += 0x7fffu + ((u >> 16) & 1u); return u >> 16; }
DI unsigned pack2(float a, float b) { return f2bf(a) | (f2bf(b) << 16); }
DI float bflo(unsigned u) { return __uint_as_float(u << 16); }
DI float bfhi(unsigned u) { return __uint_as_float(u & 0xffff0000u); }
DI float bf2f(bf16_t h) { return __uint_as_float(((unsigned)h) << 16); }
DI float sigm(float x) { return 1.f / (1.f + __expf(-x)); }
DI float gelu_t(float x) { float u = 0.7978845608028654f * (x + 0.044715f * x * x * x); return x * sigm(2.f * u); }
DI float tanh_f(float x) { return 2.f * sigm(2.f * x) - 1.f; }

template <int CTRL> DI float dpp_mov(float x) {
  return __int_as_float(__builtin_amdgcn_update_dpp(0, __float_as_int(x), CTRL, 0xF, 0xF, true));
}
DI float sum8(float x) { x += dpp_mov<0xB1>(x); x += dpp_mov<0x4E>(x); x += dpp_mov<0x141>(x); return x; }
DI float sum16(float x) { x = sum8(x); x += dpp_mov<0x140>(x); return x; }
DI float max16(float x) {
  x = fmaxf(x, dpp_mov<0xB1>(x)); x = fmaxf(x, dpp_mov<0x4E>(x)); x = fmaxf(x, dpp_mov<0x141>(x)); x = fmaxf(x, dpp_mov<0x140>(x));
  return x;
}
DI float wave_sum(float x) { x = sum16(x); x += __shfl_xor(x, 16); x += __shfl_xor(x, 32); return x; }

DI void tok_info(int t, int& seq, int& s, int& S, int& cv) {
  if (t < 4096) { seq = t >> 8; s = t & 255; S = 256; cv = 0; }
  else { int u = t - 4096; seq = 16 + (u >> 12); s = u & 4095; S = 4096; cv = 1 + (u >> 12); }
}
DI size_t pqt_base(int seq) { return seq < 16 ? (size_t)seq * 512 * 512 : (size_t)16 * 512 * 512 + (size_t)(seq - 16) * 512 * 8192; }

DI void load_row(const float* p, int lane, float (&v)[16]) {
  const float4* q = (const float4*)(p + lane * 8);
  float4 a = q[0], b = q[1];
  const float4* q2 = (const float4*)(p + 512 + lane * 8);
  float4 c = q2[0], d = q2[1];
  v[0] = a.x; v[1] = a.y; v[2] = a.z; v[3] = a.w; v[4] = b.x; v[5] = b.y; v[6] = b.z; v[7] = b.w;
  v[8] = c.x; v[9] = c.y; v[10] = c.z; v[11] = c.w; v[12] = d.x; v[13] = d.y; v[14] = d.z; v[15] = d.w;
}
DI void store_row(float* p, int lane, const float (&v)[16]) {
  float4* q = (float4*)(p + lane * 8);
  q[0] = make_float4(v[0], v[1], v[2], v[3]); q[1] = make_float4(v[4], v[5], v[6], v[7]);
  float4* q2 = (float4*)(p + 512 + lane * 8);
  q2[0] = make_float4(v[8], v[9], v[10], v[11]); q2[1] = make_float4(v[12], v[13], v[14], v[15]);
}
DI void store_row_bf(bf16_t* p, int lane, const float (&v)[16]) {
  uint4 a, b;
  a.x = pack2(v[0], v[1]); a.y = pack2(v[2], v[3]); a.z = pack2(v[4], v[5]); a.w = pack2(v[6], v[7]);
  b.x = pack2(v[8], v[9]); b.y = pack2(v[10], v[11]); b.z = pack2(v[12], v[13]); b.w = pack2(v[14], v[15]);
  *(uint4*)(p + lane * 8) = a;
  *(uint4*)(p + 512 + lane * 8) = b;
}
DI void unpack8(uint4 u, float (&v)[8]) {
  v[0] = bflo(u.x); v[1] = bfhi(u.x); v[2] = bflo(u.y); v[3] = bfhi(u.y); v[4] = bflo(u.z); v[5] = bfhi(u.z); v[6] = bflo(u.w); v[7] = bfhi(u.w);
}
DI uint4 pack8(const float (&v)[8]) {
  uint4 a; a.x = pack2(v[0], v[1]); a.y = pack2(v[2], v[3]); a.z = pack2(v[4], v[5]); a.w = pack2(v[6], v[7]); return a;
}
DI void load8f(const float* p, float (&v)[8]) {
  float4 a = ((const float4*)p)[0], b = ((const float4*)p)[1];
  v[0] = a.x; v[1] = a.y; v[2] = a.z; v[3] = a.w; v[4] = b.x; v[5] = b.y; v[6] = b.z; v[7] = b.w;
}

DI void load_row16(const float* p, int lane, float (&v)[16]) {
  const float4* q = (const float4*)(p + lane * 16);
  float4 a = q[0], b = q[1], c = q[2], d = q[3];
  v[0] = a.x; v[1] = a.y; v[2] = a.z; v[3] = a.w; v[4] = b.x; v[5] = b.y; v[6] = b.z; v[7] = b.w;
  v[8] = c.x; v[9] = c.y; v[10] = c.z; v[11] = c.w; v[12] = d.x; v[13] = d.y; v[14] = d.z; v[15] = d.w;
}
DI void store_row16(float* p, int lane, const float (&v)[16]) {
  float4* q = (float4*)(p + lane * 16);
  q[0] = make_float4(v[0], v[1], v[2], v[3]); q[1] = make_float4(v[4], v[5], v[6], v[7]);
  q[2] = make_float4(v[8], v[9], v[10], v[11]); q[3] = make_float4(v[12], v[13], v[14], v[15]);
}
DI void store_row16_bf(bf16_t* p, int lane, const float (&v)[16]) {
  uint4 a, b;
  a.x = pack2(v[0], v[1]); a.y = pack2(v[2], v[3]); a.z = pack2(v[4], v[5]); a.w = pack2(v[6], v[7]);
  b.x = pack2(v[8], v[9]); b.y = pack2(v[10], v[11]); b.z = pack2(v[12], v[13]); b.w = pack2(v[14], v[15]);
  uint4* q = (uint4*)(p + lane * 16);
  q[0] = a; q[1] = b;
}
typedef float v2f_t __attribute__((ext_vector_type(2)));
DI unsigned pk_fp8x4(float a, float b, float c, float d) {
  int w = 0;
  w = __builtin_amdgcn_cvt_pk_fp8_f32(a, b, w, false);
  w = __builtin_amdgcn_cvt_pk_fp8_f32(c, d, w, true);
  return (unsigned)w;
}
DI void unpack_fp8x16(uint4 u, float (&v)[16]) {
  v2f_t t;
  t = __builtin_amdgcn_cvt_pk_f32_fp8((int)u.x, false); v[0] = t.x; v[1] = t.y;
  t = __builtin_amdgcn_cvt_pk_f32_fp8((int)u.x, true); v[2] = t.x; v[3] = t.y;
  t = __builtin_amdgcn_cvt_pk_f32_fp8((int)u.y, false); v[4] = t.x; v[5] = t.y;
  t = __builtin_amdgcn_cvt_pk_f32_fp8((int)u.y, true); v[6] = t.x; v[7] = t.y;
  t = __builtin_amdgcn_cvt_pk_f32_fp8((int)u.z, false); v[8] = t.x; v[9] = t.y;
  t = __builtin_amdgcn_cvt_pk_f32_fp8((int)u.z, true); v[10] = t.x; v[11] = t.y;
  t = __builtin_amdgcn_cvt_pk_f32_fp8((int)u.w, false); v[12] = t.x; v[13] = t.y;
  t = __builtin_amdgcn_cvt_pk_f32_fp8((int)u.w, true); v[14] = t.x; v[15] = t.y;
}
DI void ln16(float (&y)[16]) {
  float s = 0.f;
#pragma unroll
  for (int i = 0; i < 16; ++i) s += y[i];
  float mu = wave_sum(s) * (1.f / 1024.f);
  float v = 0.f;
#pragma unroll
  for (int i = 0; i < 16; ++i) { float d = y[i] - mu; v += d * d; }
  v = wave_sum(v) * (1.f / 1024.f);
  float rs = rsqrtf(v + 1e-6f);
#pragma unroll
  for (int i = 0; i < 16; ++i) y[i] = (y[i] - mu) * rs;
}

constexpr int LDT = 72;

template <bool SWAP>
DI void gemm_mainloop(const bf16_t* __restrict__ A, int lda, const bf16_t* __restrict__ B, int ldb, int K,
                      f32x16 (&acc)[2][2], bf16_t* As, bf16_t* Bs) {
  const int tid = tidx(), lane = tid & 63, wave = tid >> 6;
  const int wm = wave >> 1, wn = wave & 1;
  const int lrow = tid >> 3, lck = tid & 7;
  const bf16_t* ap = A + (size_t)lrow * lda + lck * 8;
  const bf16_t* bp = B + (size_t)lrow * ldb + lck * 8;
  const size_t sa = (size_t)32 * lda, sb = (size_t)32 * ldb;
  uint4 ra0, ra1, ra2, ra3, rb0, rb1, rb2, rb3;
  ra0 = *(const uint4*)(ap); ra1 = *(const uint4*)(ap + sa); ra2 = *(const uint4*)(ap + 2 * sa); ra3 = *(const uint4*)(ap + 3 * sa);
  rb0 = *(const uint4*)(bp); rb1 = *(const uint4*)(bp + sb); rb2 = *(const uint4*)(bp + 2 * sb); rb3 = *(const uint4*)(bp + 3 * sb);
#pragma unroll
  for (int mi = 0; mi < 2; ++mi)
#pragma unroll
    for (int ni = 0; ni < 2; ++ni)
#pragma unroll
      for (int r = 0; r < 16; ++r) acc[mi][ni][r] = 0.f;
  const int KT = K / 64;
  const int fr = (lane & 31) * LDT + (lane >> 5) * 8;
  bf16_t* asw = As + lrow * LDT + lck * 8;
  bf16_t* bsw = Bs + lrow * LDT + lck * 8;
  for (int kt = 0; kt < KT; ++kt) {
    __syncthreads();
    *(uint4*)(asw) = ra0; *(uint4*)(asw + 32 * LDT) = ra1; *(uint4*)(asw + 64 * LDT) = ra2; *(uint4*)(asw + 96 * LDT) = ra3;
    *(uint4*)(bsw) = rb0; *(uint4*)(bsw + 32 * LDT) = rb1; *(uint4*)(bsw + 64 * LDT) = rb2; *(uint4*)(bsw + 96 * LDT) = rb3;
    __syncthreads();
    if (kt + 1 < KT) {
      const bf16_t* a2 = ap + (kt + 1) * 64;
      const bf16_t* b2 = bp + (kt + 1) * 64;
      ra0 = *(const uint4*)(a2); ra1 = *(const uint4*)(a2 + sa); ra2 = *(const uint4*)(a2 + 2 * sa); ra3 = *(const uint4*)(a2 + 3 * sa);
      rb0 = *(const uint4*)(b2); rb1 = *(const uint4*)(b2 + sb); rb2 = *(const uint4*)(b2 + 2 * sb); rb3 = *(const uint4*)(b2 + 3 * sb);
    }
#pragma unroll
    for (int kk = 0; kk < 4; ++kk) {
      const bf16x8 af0 = *(const bf16x8*)(As + (wm * 64) * LDT + fr + kk * 16);
      const bf16x8 af1 = *(const bf16x8*)(As + (wm * 64 + 32) * LDT + fr + kk * 16);
      const bf16x8 bf0 = *(const bf16x8*)(Bs + (wn * 64) * LDT + fr + kk * 16);
      const bf16x8 bf1 = *(const bf16x8*)(Bs + (wn * 64 + 32) * LDT + fr + kk * 16);
      if (SWAP) {
        acc[0][0] = MFMA(bf0, af0, acc[0][0]); acc[0][1] = MFMA(bf1, af0, acc[0][1]);
        acc[1][0] = MFMA(bf0, af1, acc[1][0]); acc[1][1] = MFMA(bf1, af1, acc[1][1]);
      } else {
        acc[0][0] = MFMA(af0, bf0, acc[0][0]); acc[0][1] = MFMA(af0, bf1, acc[0][1]);
        acc[1][0] = MFMA(af1, bf0, acc[1][0]); acc[1][1] = MFMA(af1, bf1, acc[1][1]);
      }
    }
  }
}

template <bool SWAP, bool SB = true, class F>
DI void gemm_epilogue(const f32x16 (&acc)[2][2], F f) {
  const int lane = tidx() & 63, wave = tidx() >> 6;
  const int wm = wave >> 1, wn = wave & 1;
#pragma unroll
  for (int mi = 0; mi < 2; ++mi)
#pragma unroll
    for (int ni = 0; ni < 2; ++ni)
#pragma unroll
      for (int r = 0; r < 16; ++r) {
        const int i = (r & 3) + 8 * (r >> 2) + 4 * (lane >> 5);
        const int j = lane & 31;
        int m, n;
        if (!SWAP) { m = wm * 64 + mi * 32 + i; n = wn * 64 + ni * 32 + j; }
        else { n = wn * 64 + ni * 32 + i; m = wm * 64 + mi * 32 + j; }
        f(m, n, acc[mi][ni][r]);
        if (SB && (r & 3) == 3) __builtin_amdgcn_sched_barrier(0);
      }
}
template <class F>
DI void gemm_epilogue2(const f32x16 (&a0)[2][2], const f32x16 (&a1)[2][2], F f) {
  const int lane = tidx() & 63, wave = tidx() >> 6;
  const int wm = wave >> 1, wn = wave & 1;
#pragma unroll
  for (int mi = 0; mi < 2; ++mi)
#pragma unroll
    for (int ni = 0; ni < 2; ++ni)
#pragma unroll
      for (int r = 0; r < 16; ++r) {
        const int i = (r & 3) + 8 * (r >> 2) + 4 * (lane >> 5);
        const int j = lane & 31;
        f(wm * 64 + mi * 32 + i, wn * 64 + ni * 32 + j, a0[mi][ni][r], a1[mi][ni][r]);
      }
}

DI int tr_tiles(int job) {
  if (job < 2) return 384; if (job < 4) return 256; if (job < 6) return 736; if (job < 8) return 256;
  if (job < 12) return 512; if (job < 20) return 8; return 16;
}
DI void phase_prep(const Params& p, unsigned char* smem, int bid, int nb) {
  const int tid = tidx();
  constexpr int N_MOD = 384, N_TR = 768 + 512 + 1472 + 512 + 2048 + 32 + 32 + 32, N_FOLD = 256, N_GATE = 512, N_DFT = 16384 + 64;
  constexpr int TOTAL = N_MOD + N_TR + N_FOLD + N_GATE + N_DFT;
  unsigned char* ws = p.ws;
  for (int it = bid; it < TOTAL; it += nb) {
    if (it < N_MOD) {
      const int l = it / 96, cchunk = it % 96;
      float* sil = (float*)smem;
      float* red = sil + 5 * 1024;
      __syncthreads();
      for (int i = tid; i < 5120; i += NTHR) {
        int cv = i >> 10, k = i & 1023;
        float c = (cv == 0) ? p.in[I_CCTX][k] : p.in[I_C][(cv - 1) * 1024 + k];
        sil[i] = c * sigm(c);
      }
      __syncthreads();
      const int col = cchunk * 64 + (tid & 63), kg = tid >> 6;
      const float* w = p.in[I_WMOD] + (size_t)l * 1024 * 6144 + col;
      float a0 = 0.f, a1 = 0.f, a2 = 0.f, a3 = 0.f, a4 = 0.f;
#pragma unroll 8
      for (int k = kg * 256; k < kg * 256 + 256; ++k) {
        float wv = w[(size_t)k * 6144];
        a0 += sil[k] * wv; a1 += sil[1024 + k] * wv; a2 += sil[2048 + k] * wv; a3 += sil[3072 + k] * wv; a4 += sil[4096 + k] * wv;
      }
      const int c = tid & 63;
      red[(kg * 5 + 0) * 64 + c] = a0; red[(kg * 5 + 1) * 64 + c] = a1; red[(kg * 5 + 2) * 64 + c] = a2;
      red[(kg * 5 + 3) * 64 + c] = a3; red[(kg * 5 + 4) * 64 + c] = a4;
      __syncthreads();
      for (int i = tid; i < 320; i += NTHR) {
        int cv = i >> 6, cc = i & 63;
        float s = red[(0 * 5 + cv) * 64 + cc] + red[(1 * 5 + cv) * 64 + cc] + red[(2 * 5 + cv) * 64 + cc] + red[(3 * 5 + cv) * 64 + cc];
        s += p.in[I_BMOD][l * 6144 + cchunk * 64 + cc];
        ((float*)(ws + OFF_MOD))[(l * 5 + cv) * 6144 + cchunk * 64 + cc] = s;
      }
    } else if (it < N_MOD + N_TR) {
      int r = it - N_MOD, job = 0;
      for (job = 0; job < 22; ++job) { int nt = tr_tiles(job); if (r < nt) break; r -= nt; }
      const float* src; bf16_t* dst; int lds, ldd, N;
      if (job < 2) { src = p.in[I_WINE] + (size_t)job * 1024 * 2048 + 512; lds = 2048; N = 1536; dst = (bf16_t*)(ws + OFF_BT_IN_E) + (size_t)job * 2560 * 1024 + (size_t)1024 * 1024; ldd = 1024; }
      else if (job < 4) { int j = job - 2; src = p.in[I_WOUTE] + (size_t)j * 1024 * 1024; lds = 1024; N = 1024; dst = (bf16_t*)(ws + OFF_BT_OUT_E) + (size_t)j * 1024 * 1024; ldd = 1024; }
      else if (job < 6) { int j = job - 4; src = p.in[I_WINO] + (size_t)j * 1024 * 2944; lds = 2944; N = 2944; dst = (bf16_t*)(ws + OFF_BT_IN_O) + (size_t)j * 2944 * 1024; ldd = 1024; }
      else if (job < 8) { int j = job - 6; src = p.in[I_WOUTO] + (size_t)j * 1024 * 1024; lds = 1024; N = 1024; dst = (bf16_t*)(ws + OFF_BT_OUT_O) + (size_t)j * 1024 * 1024; ldd = 1024; }
      else if (job < 12) { int j = job - 8; src = p.in[I_WQ] + (size_t)j * 1024 * 2048; lds = 2048; N = 2048; dst = (bf16_t*)(ws + OFF_BT_WQ) + (size_t)j * 2048 * 1024; ldd = 1024; }
      else if (job < 16) { int j = job - 12; src = p.in[I_W2] + (size_t)j * 64 * 512; lds = 512; N = 512; dst = (bf16_t*)(ws + OFF_BT_W2) + (size_t)j * 512 * 64; ldd = 64; }
      else if (job < 20) { int j = job - 16; src = p.in[I_A2] + (size_t)j * 64 * 512; lds = 512; N = 512; dst = (bf16_t*)(ws + OFF_BT_A2) + (size_t)j * 512 * 64; ldd = 64; }
      else { int j = job - 20; src = p.in[I_G2] + (size_t)j * 128 * 512; lds = 512; N = 512; dst = (bf16_t*)(ws + OFF_BT_G2) + (size_t)j * 512 * 128; ldd = 128; }
      const int ntn = N / 64;
      const int k0 = (r / ntn) * 64, n0 = (r % ntn) * 64;
      float* tl = (float*)smem;
      __syncthreads();
#pragma unroll 4
      for (int ps = 0; ps < 16; ++ps) {
        int kr = ps * 4 + (tid >> 6), n = tid & 63;
        tl[kr * 65 + n] = src[(size_t)(k0 + kr) * lds + n0 + n];
      }
      __syncthreads();
#pragma unroll 4
      for (int ps = 0; ps < 8; ++ps) {
        int nr = ps * 8 + (tid >> 5), k2 = tid & 31;
        unsigned v = pack2(tl[(2 * k2) * 65 + nr], tl[(2 * k2 + 1) * 65 + nr]);
        *(unsigned*)(dst + (size_t)(n0 + nr) * ldd + k0 + 2 * k2) = v;
      }
    } else if (it < N_MOD + N_TR + N_FOLD) {
      int r = it - N_MOD - N_TR;
      const int j = r >> 7, rr = r & 127, which = rr >> 6, g = (rr >> 4) & 3, kt = rr & 15;
      const int k0 = kt * 64;
      float* Wl = (float*)smem;
      float* tab = Wl + 64 * 129;
      __syncthreads();
      if (tid < 128) { float fr = (float)tid * (1.f / 128.f); tab[tid] = which ? __builtin_amdgcn_sinf(fr) : __builtin_amdgcn_cosf(fr); }
      for (int ps = 0; ps < 32; ++ps) {
        int kr = ps * 2 + (tid >> 7), c = tid & 127;
        Wl[kr * 129 + c] = p.in[I_WINE][(size_t)j * 1024 * 2048 + (size_t)(k0 + kr) * 2048 + g * 128 + c];
      }
      __syncthreads();
      const int k = tid & 63, nq = tid >> 6;
      bf16_t* dst = (bf16_t*)(ws + OFF_BT_IN_E) + (size_t)j * 2560 * 1024;
      for (int i = 0; i < 32; ++i) {
        const int np = nq * 32 + i;
        float s = 0.f;
#pragma unroll 8
        for (int c = 0; c < 128; ++c) s += Wl[k * 129 + c] * tab[(c * np) & 127];
        dst[(size_t)(which * 512 + g * 128 + np) * 1024 + k0 + k] = (bf16_t)f2bf(s);
      }
    } else if (it < N_MOD + N_TR + N_FOLD + N_GATE) {
      int r = it - N_MOD - N_TR - N_FOLD;
      bf16_t* dst = (bf16_t*)(ws + OFF_BT_GATE);
      for (int e = 0; e < 4; ++e) {
        int idx = r * 1024 + e * 256 + tid;
        int kp = idx & 127, n = (idx >> 7) & 511, gate = (idx >> 16) & 1, d = (idx >> 17) & 1, j = idx >> 18;
        int h = n >> 6;
        float v = 0.f;
        if ((kp >> 6) == (h & 1)) {
          const float* W = gate ? p.in[I_LWX] : p.in[I_LWA];
          v = W[((((size_t)(j * 2 + d) * 8 + h) * 64 + (kp & 63)) * 64) + (n & 63)];
        }
        dst[idx] = (bf16_t)f2bf(v);
      }
    } else {
      int r = it - N_MOD - N_TR - N_FOLD - N_GATE;
      int S, K2; bf16_t* dst; size_t idx;
      if (r < 16384) { S = 4096; K2 = 8192; dst = (bf16_t*)(ws + OFF_D4096); idx = (size_t)r * 2048 + tid * 8; }
      else { S = 256; K2 = 512; dst = (bf16_t*)(ws + OFF_D256); idx = (size_t)(r - 16384) * 2048 + tid * 8; }
      const int row = (int)(idx / K2), kb = (int)(idx % K2);
      const float invS = 1.f / (float)S;
      float v[8];
#pragma unroll
      for (int e = 0; e < 8; ++e) {
        int k = kb + e;
        if (k < S) { int m = (row * k) & (S - 1); v[e] = __builtin_amdgcn_cosf((float)m * invS); }
        else { int m = (row * (k - S)) & (S - 1); v[e] = -__builtin_amdgcn_sinf((float)m * invS); }
      }
      *(uint4*)(dst + idx) = pack8(v);
    }
  }
}

DI void mod_store_h(const Params& p, int t, int lane, int cv, int l, int off_scale, int off_shift, float (&y)[16]) {
  const float* mod = (const float*)(p.ws + OFF_MOD) + (size_t)(l * 5 + cv) * 6144;
  float sc[16], sh[16];
  load_row(mod + off_scale * 1024, lane, sc);
  load_row(mod + off_shift * 1024, lane, sh);
#pragma unroll
  for (int i = 0; i < 16; ++i) y[i] = y[i] * (1.f + sc[i]) + sh[i];
  store_row_bf((bf16_t*)(p.ws + OFF_H) + (size_t)t * 1024, lane, y);
}

DI float pos_embed(int n, int c) {
  int pos = (c < 512) ? (n >> 6) : (n & 63);
  int cc = c & 511, i = cc & 255;
  float om = exp2f(-(float)i * (13.287712379549449f / 256.f));
  float rev = (float)pos * om * 0.15915494309189535f;
  return cc < 256 ? __builtin_amdgcn_sinf(rev) : __builtin_amdgcn_cosf(rev);
}

DI void phase_init(const Params& p, int bid, int nb) {
  const int lane = tidx() & 63, wave = tidx() >> 6;
  for (int t = bid * 4 + wave; t < T; t += nb * 4) {
    int seq, s, S, cv; tok_info(t, seq, s, S, cv);
    float y[16];
    const float* src = (t < 4096) ? p.in[I_XP] + (size_t)t * 1024 : p.in[I_XS] + (size_t)(t - 4096) * 1024;
    load_row(src, lane, y);
    if (t >= 4096) {
#pragma unroll
      for (int i = 0; i < 16; ++i) { int c = (i < 8) ? lane * 8 + i : 512 + lane * 8 + (i - 8); y[i] += pos_embed(s, c); }
    }
    store_row((float*)(p.ws + OFF_X) + (size_t)t * 1024, lane, y);
    ln16(y);
    mod_store_h(p, t, lane, cv, 0, 1, 0, y);
  }
}

constexpr float U_SCALE = 32.f;
DI void convert_tables(const Params& p, int l, int bid, int nb) {
  const size_t n16 = (size_t)16384 * 1024 / 16;
  for (int tb = 0; tb < 2; ++tb) {
    const float* src = p.in[tb ? I_PV : I_PU] + (size_t)l * 16384 * 1024;
    uint4* dst = (uint4*)(p.ws + (tb ? OFF_TABV : OFF_TABU));
    const float sc = tb ? 1.f : U_SCALE;
    for (size_t i = (size_t)bid * NTHR + tidx(); i < n16; i += (size_t)nb * NTHR) {
      const float4* s4 = (const float4*)(src + i * 16);
      float4 a = s4[0], b = s4[1], c = s4[2], d = s4[3];
      uint4 o;
      o.x = pk_fp8x4(a.x * sc, a.y * sc, a.z * sc, a.w * sc); o.y = pk_fp8x4(b.x * sc, b.y * sc, b.z * sc, b.w * sc);
      o.z = pk_fp8x4(c.x * sc, c.y * sc, c.z * sc, c.w * sc); o.w = pk_fp8x4(d.x * sc, d.y * sc, d.z * sc, d.w * sc);
      dst[i] = o;
    }
  }
}

DI void phase_e1(const Params& p, unsigned char* smem, int l, int bid, int nb) {
  const int j = l >> 1;
  bf16_t* As = (bf16_t*)smem; bf16_t* Bs = As + 128 * LDT;
  const bf16_t* H = (const bf16_t*)(p.ws + OFF_H);
  const bf16_t* Bt = (const bf16_t*)(p.ws + OFF_BT_IN_E) + (size_t)j * 2560 * 1024;
  bf16_t* PQT = (bf16_t*)(p.ws + OFF_Z);
  bf16_t* ZC = (bf16_t*)(p.ws + OFF_Z + 40 * MiB);
  for (int it = bid; it < 160 * 20; it += nb) {
    const int mt = it / 20, nt = it % 20, t0 = mt * 128;
    f32x16 acc[2][2];
    if (nt < 8) {
      gemm_mainloop<true>(H + (size_t)t0 * 1024, 1024, Bt + (size_t)nt * 128 * 1024, 1024, 1024, acc, As, Bs);
      int seq, s0, S, cv; tok_info(t0, seq, s0, S, cv);
      bf16_t* base = PQT + pqt_base(seq);
      const int S2 = 2 * S;
      gemm_epilogue<true>(acc, [&](int m, int n, float v) {
        int ng = nt * 128 + n; int which = ng >> 9, ch = ng & 511;
        base[(size_t)ch * S2 + which * S + s0 + m] = (bf16_t)f2bf(v);
      });
    } else {
      gemm_mainloop<false>(H + (size_t)t0 * 1024, 1024, Bt + (size_t)nt * 128 * 1024, 1024, 1024, acc, As, Bs);
      gemm_epilogue<false>(acc, [&](int m, int n, float v) {
        ZC[(size_t)(t0 + m) * 1536 + (nt - 8) * 128 + n] = (bf16_t)f2bf(v);
      });
    }
  }
  convert_tables(p, l, bid, nb);
}

DI void phase_e2(const Params& p, unsigned char* smem, int l, int bid, int nb) {
  const int j = l >> 1;
  bf16_t* As = (bf16_t*)smem; bf16_t* Bs = As + 128 * LDT;
  const bf16_t* PQT = (const bf16_t*)(p.ws + OFF_Z);
  const bf16_t* ZC = (const bf16_t*)(p.ws + OFF_Z + 40 * MiB);
  bf16_t* YM = (bf16_t*)(p.ws + OFF_YMIX);
  for (int it = bid; it < 640 + 1280; it += nb) {
    if (it < 640) {
      int seq, mt, nt, S, t0; const bf16_t* A;
      if (it < 512) { seq = 16 + it / 128; int r = it % 128; mt = r >> 2; nt = r & 3; S = 4096; A = (const bf16_t*)(p.ws + OFF_D4096) + (size_t)mt * 128 * 8192; t0 = 4096 + (seq - 16) * 4096 + mt * 128; }
      else { int r = it - 512; seq = r >> 3; mt = (r & 7) >> 2; nt = r & 3; S = 256; A = (const bf16_t*)(p.ws + OFF_D256) + (size_t)mt * 128 * 512; t0 = seq * 256 + mt * 128; }
      const bf16_t* B = PQT + pqt_base(seq) + (size_t)nt * 128 * (2 * S);
      f32x16 acc[2][2];
      gemm_mainloop<false>(A, 2 * S, B, 2 * S, 2 * S, acc, As, Bs);
      const float scale = rsqrtf(128.f * (float)S);
      gemm_epilogue<false>(acc, [&](int m, int n, float v) {
        YM[(size_t)(t0 + m) * 1024 + nt * 128 + n] = (bf16_t)f2bf(v * scale);
      });
    } else {
      const int t0 = (it - 640) * 16, c = tidx() * 2;
      int seq, s0, S, cv; tok_info(t0, seq, s0, S, cv);
      const float* cw = p.in[I_SCW] + (size_t)j * 3 * 512;
      const float w0a = cw[c], w0b = cw[c + 1], w1a = cw[512 + c], w1b = cw[512 + c + 1], w2a = cw[1024 + c], w2b = cw[1024 + c + 1];
      const float ba = p.in[I_SCB][j * 512 + c], bb = p.in[I_SCB][j * 512 + c + 1];
      auto uval = [&](int t, float& ua, float& ub) {
        unsigned cg_ = *(const unsigned*)(ZC + (size_t)t * 1536 + 512 + c);
        unsigned xi = *(const unsigned*)(ZC + (size_t)t * 1536 + 1024 + c);
        ua = bflo(cg_) * bflo(xi); ub = bfhi(cg_) * bfhi(xi);
      };
      float pa = 0.f, pb = 0.f, ca, cb, na, nb_;
      if (s0 > 0) uval(t0 - 1, pa, pb);
      uval(t0, ca, cb);
      for (int i = 0; i < 16; ++i) {
        const int t = t0 + i;
        na = 0.f; nb_ = 0.f;
        if (s0 + i + 1 < S) uval(t + 1, na, nb_);
        unsigned bg = *(const unsigned*)(ZC + (size_t)t * 1536 + c);
        float ya = bflo(bg) * (w0a * pa + w1a * ca + w2a * na + ba);
        float yb = bfhi(bg) * (w0b * pb + w1b * cb + w2b * nb_ + bb);
        *(unsigned*)(YM + (size_t)t * 1024 + 512 + c) = pack2(ya, yb);
        pa = ca; pb = cb; ca = na; cb = nb_;
      }
    }
  }
}

DI void phase_outgemm(const Params& p, unsigned char* smem, const bf16_t* Bt, int bid, int nb) {
  bf16_t* As = (bf16_t*)smem; bf16_t* Bs = As + 128 * LDT;
  const bf16_t* YM = (const bf16_t*)(p.ws + OFF_YMIX);
  float* MIX = (float*)(p.ws + OFF_MIX);
  for (int it = bid; it < 160 * 8; it += nb) {
    const int mt = it >> 3, nt = it & 7, t0 = mt * 128;
    f32x16 acc[2][2];
    gemm_mainloop<false>(YM + (size_t)t0 * 1024, 1024, Bt + (size_t)nt * 128 * 1024, 1024, 1024, acc, As, Bs);
    gemm_epilogue<false>(acc, [&](int m, int n, float v) { MIX[(size_t)(t0 + m) * 1024 + nt * 128 + n] = v; });
  }
}

DI void phase_res1(const Params& p, int l, int bid, int nb) {
  const int lane = tidx() & 63, wave = tidx() >> 6;
  float* X = (float*)(p.ws + OFF_X);
  const float* MIX = (const float*)(p.ws + OFF_MIX);
  for (int t = bid * 4 + wave; t < T; t += nb * 4) {
    int seq, s, S, cv; tok_info(t, seq, s, S, cv);
    const float* mod = (const float*)(p.ws + OFF_MOD) + (size_t)(l * 5 + cv) * 6144;
    float x[16], m[16], g[16];
    load_row(X + (size_t)t * 1024, lane, x);
    load_row(MIX + (size_t)t * 1024, lane, m);
    load_row(mod + 2 * 1024, lane, g);
#pragma unroll
    for (int i = 0; i < 16; ++i) x[i] = ALPHA_F * x[i] + g[i] * m[i];
    ln16(x);
    load_row(p.in[I_LN1G] + l * 1024, lane, m);
    load_row(p.in[I_LN1B] + l * 1024, lane, g);
#pragma unroll
    for (int i = 0; i < 16; ++i) x[i] = x[i] * m[i] + g[i];
    store_row(X + (size_t)t * 1024, lane, x);
    ln16(x);
    mod_store_h(p, t, lane, cv, l, 4, 3, x);
  }
}

DI void insert16(float (&tv)[16], int (&ti)[16], float x, int xi) {
#pragma unroll
  for (int k = 0; k < 16; ++k) {
    bool gt = x > tv[k];
    float ov = tv[k]; int oi = ti[k];
    tv[k] = gt ? x : ov; ti[k] = gt ? xi : oi;
    x = gt ? ov : x; xi = gt ? oi : xi;
  }
}
DI void phase_p1(const Params& p, unsigned char* smem, int l, int bid, int nb) {
  const int tid = tidx(), lane = tid & 63, wave = tid >> 6;
  const int wm = wave >> 1, wn = wave & 1;
  bf16_t* As = (bf16_t*)smem; bf16_t* Bs = As + 128 * LDT;
  bf16_t* Qs = (bf16_t*)smem;
  bf16_t* Ks = (bf16_t*)(smem + 36864);
  float* Sc = (float*)smem;
  float* Lv = (float*)smem;
  int* Li = (int*)(smem + 8192);
  const bf16_t* H = (const bf16_t*)(p.ws + OFF_H);
  const bf16_t* Bt = (const bf16_t*)(p.ws + OFF_BT_WQ) + (size_t)l * 2048 * 1024;
  float* TKV = (float*)(p.ws + OFF_WD);
  int* TKI = (int*)(p.ws + OFF_WD + 20 * MiB);
  for (int it = bid; it < 160 * 16; it += nb) {
    const int mt = it >> 4, hp = it & 15, t0 = mt * 128;
    f32x16 acc[2][2];
    gemm_mainloop<false>(H + (size_t)t0 * 1024, 1024, Bt + (size_t)hp * 128 * 1024, 1024, 1024, acc, As, Bs);
    {
      const float* kp = p.in[I_KEYS] + (size_t)(l * 16 + hp) * 16384;
#pragma unroll 4
      for (int i = 0; i < 16; ++i) {
        int idx = i * 256 + tid;
        int row = idx >> 5, c4 = idx & 31;
        float4 v = *(const float4*)(kp + row * 128 + c4 * 4);
        uint2 u; u.x = pack2(v.x, v.y); u.y = pack2(v.z, v.w);
        *(uint2*)(Ks + row * 136 + c4 * 4) = u;
      }
    }
    __syncthreads();
    gemm_epilogue<false>(acc, [&](int m, int n, float v) { Qs[m * 136 + n] = (bf16_t)f2bf(v); });
    __syncthreads();
#pragma unroll
    for (int mi = 0; mi < 2; ++mi)
#pragma unroll
      for (int ni = 0; ni < 2; ++ni)
#pragma unroll
        for (int r = 0; r < 16; ++r) acc[mi][ni][r] = 0.f;
    {
      const int fr = (lane & 31) * 136 + (lane >> 5) * 8;
#pragma unroll
      for (int kk = 0; kk < 8; ++kk) {
        bf16x8 af[2], bfr[2];
#pragma unroll
        for (int mi = 0; mi < 2; ++mi) af[mi] = *(const bf16x8*)(Qs + (wm * 64 + mi * 32) * 136 + fr + kk * 16);
#pragma unroll
        for (int ni = 0; ni < 2; ++ni) bfr[ni] = *(const bf16x8*)(Ks + (wn * 64 + ni * 32) * 136 + fr + kk * 16);
#pragma unroll
        for (int mi = 0; mi < 2; ++mi)
#pragma unroll
          for (int ni = 0; ni < 2; ++ni) acc[mi][ni] = MFMA(af[mi], bfr[ni], acc[mi][ni]);
      }
    }
    __syncthreads();
    gemm_epilogue<false>(acc, [&](int m, int n, float v) { Sc[m * 129 + n] = v; });
    __syncthreads();
    const int row = tid & 127, half = tid >> 7;
    float tv[16]; int ti[16];
#pragma unroll
    for (int k = 0; k < 16; ++k) { tv[k] = -3.0e38f; ti[k] = 0; }
    for (int e = 0; e < 64; ++e) insert16(tv, ti, Sc[row * 129 + half * 64 + e], half * 64 + e);
    __syncthreads();
    if (half == 1) {
#pragma unroll
      for (int k = 0; k < 16; ++k) { Lv[k * 128 + row] = tv[k]; Li[k * 128 + row] = ti[k]; }
    }
    __syncthreads();
    if (half == 0) {
#pragma unroll
      for (int k = 0; k < 16; ++k) insert16(tv, ti, Lv[k * 128 + row], Li[k * 128 + row]);
      float* ov = TKV + ((size_t)(t0 + row) * 16 + hp) * 16;
      int* oi = TKI + ((size_t)(t0 + row) * 16 + hp) * 16;
#pragma unroll
      for (int k = 0; k < 16; k += 4) {
        *(float4*)(ov + k) = make_float4(tv[k], tv[k + 1], tv[k + 2], tv[k + 3]);
        *(int4*)(oi + k) = make_int4(ti[k], ti[k + 1], ti[k + 2], ti[k + 3]);
      }
    }
  }
}

DI void phase_p2(const Params& p, unsigned char* smem, int l, int bid, int nb) {
  const int lane = tidx() & 63, wave = tidx() >> 6;
  int* sIdx = (int*)(smem + wave * 1024);
  float* sSc = (float*)(smem + wave * 1024 + 512);
  const bf16_t* H = (const bf16_t*)(p.ws + OFF_H);
  const float* TKV = (const float*)(p.ws + OFF_WD);
  const int* TKI = (const int*)(p.ws + OFF_WD + 20 * MiB);
  const bf16_t* TU = (const bf16_t*)(p.ws + OFF_TABU);
  const bf16_t* TV = (const bf16_t*)(p.ws + OFF_TABV);
  float* X = (float*)(p.ws + OFF_X);
  int ci = 0, cj = 0;
  {
    int q = lane;
    if (q < 16) { ci = 0; cj = q; } else if (q < 24) { ci = 1; cj = q - 16; } else if (q < 29) { ci = 2; cj = q - 24; }
    else if (q < 33) { ci = 3; cj = q - 29; } else if (q < 36) { ci = 4; cj = q - 33; }
    else if (q < 42) { ci = 5 + ((q - 36) >> 1); cj = (q - 36) & 1; } else if (q < 50) { ci = 8 + (q - 42); cj = 0; }
  }
  for (int t = bid * 4 + wave; t < T; t += nb * 4) {
    int seq, s, S, cv; tok_info(t, seq, s, S, cv);
    float hreg[16];
    {
      const uint4* hp_ = (const uint4*)(H + (size_t)t * 1024 + lane * 16);
      uint4 a = hp_[0], b = hp_[1];
      float v0[8], v1[8]; unpack8(a, v0); unpack8(b, v1);
#pragma unroll
      for (int i = 0; i < 8; ++i) { hreg[i] = v0[i]; hreg[8 + i] = v1[i]; }
    }
    __builtin_amdgcn_wave_barrier();
    for (int h = 0; h < 8; ++h) {
      const float* v1p = TKV + ((size_t)t * 16 + h * 2) * 16;
      const int* i1p = TKI + ((size_t)t * 16 + h * 2) * 16;
      float c = -3.0e38f; int eidx = 0;
      if (lane < 50) { c = v1p[ci] + v1p[16 + cj]; eidx = i1p[ci] * 128 + i1p[16 + cj]; }
      int rank = 0;
#pragma unroll 5
      for (int m = 0; m < 50; ++m) {
        float cm = __int_as_float(__builtin_amdgcn_readlane(__float_as_int(c), m));
        rank += (cm > c || (cm == c && m < lane)) ? 1 : 0;
      }
      if (lane < 50 && rank < 16) { sIdx[h * 16 + rank] = eidx; sSc[h * 16 + rank] = c; }
    }
    __builtin_amdgcn_wave_barrier();
    {
      float s0 = sSc[lane], s1 = sSc[64 + lane];
      float m0 = max16(s0), m1 = max16(s1);
      float e0 = __expf(s0 - m0), e1 = __expf(s1 - m1);
      float d0 = sum16(e0), d1 = sum16(e1);
      __builtin_amdgcn_wave_barrier();
      sSc[lane] = e0 / d0; sSc[64 + lane] = e1 / d1;
    }
    __builtin_amdgcn_wave_barrier();
    float out[16];
#pragma unroll
    for (int i = 0; i < 16; ++i) out[i] = 0.f;
    const unsigned char* TU8 = (const unsigned char*)TU;
    const unsigned char* TV8 = (const unsigned char*)TV;
    for (int sb = 0; sb < 128; sb += 8) {
      uint4 u[8], w[8]; float gt[8];
#pragma unroll
      for (int k = 0; k < 8; ++k) {
        int e = __builtin_amdgcn_readfirstlane(sIdx[sb + k]);
        gt[k] = sSc[sb + k];
        u[k] = *(const uint4*)(TU8 + (size_t)e * 1024 + lane * 16);
        w[k] = *(const uint4*)(TV8 + (size_t)e * 1024 + lane * 16);
      }
      float dot[8];
#pragma unroll
      for (int k = 0; k < 8; ++k) {
        float a[16]; unpack_fp8x16(u[k], a);
        float d = 0.f;
#pragma unroll
        for (int i = 0; i < 16; ++i) d += hreg[i] * a[i];
        dot[k] = d;
      }
#pragma unroll
      for (int k = 0; k < 8; ++k) dot[k] = wave_sum(dot[k]);
#pragma unroll
      for (int k = 0; k < 8; ++k) {
        float wgt = gt[k] * gelu_t(dot[k] * (1.f / U_SCALE));
        float a[16]; unpack_fp8x16(w[k], a);
#pragma unroll
        for (int i = 0; i < 16; ++i) out[i] += wgt * a[i];
      }
    }
    const float* mod = (const float*)(p.ws + OFF_MOD) + (size_t)(l * 5 + cv) * 6144;
    float x[16], g[16], b2[16];
    load_row16(X + (size_t)t * 1024, lane, x);
    load_row16(mod + 5 * 1024, lane, g);
#pragma unroll
    for (int i = 0; i < 16; ++i) x[i] = ALPHA_F * x[i] + g[i] * out[i];
    ln16(x);
    load_row16(p.in[I_LN2G] + l * 1024, lane, g);
    load_row16(p.in[I_LN2B] + l * 1024, lane, b2);
#pragma unroll
    for (int i = 0; i < 16; ++i) x[i] = x[i] * g[i] + b2[i];
    if (l == 3) {
      store_row16(p.out + (size_t)t * 1024, lane, x);
    } else {
      store_row16(X + (size_t)t * 1024, lane, x);
      ln16(x);
      const float* modn = (const float*)(p.ws + OFF_MOD) + (size_t)((l + 1) * 5 + cv) * 6144;
      load_row16(modn + 1024, lane, g);
      load_row16(modn, lane, b2);
#pragma unroll
      for (int i = 0; i < 16; ++i) x[i] = x[i] * (1.f + g[i]) + b2[i];
      store_row16_bf((bf16_t*)(p.ws + OFF_H) + (size_t)t * 1024, lane, x);
    }
  }
}

DI void phase_o1(const Params& p, unsigned char* smem, int l, int bid, int nb) {
  const int j = l >> 1;
  bf16_t* As = (bf16_t*)smem; bf16_t* Bs = As + 128 * LDT;
  const bf16_t* H = (const bf16_t*)(p.ws + OFF_H);
  const bf16_t* Bt = (const bf16_t*)(p.ws + OFF_BT_IN_O) + (size_t)j * 2944 * 1024;
  bf16_t* Z = (bf16_t*)(p.ws + OFF_Z);
  for (int it = bid; it < 160 * 23; it += nb) {
    const int mt = it / 23, nt = it % 23, t0 = mt * 128;
    f32x16 acc[2][2];
    gemm_mainloop<false>(H + (size_t)t0 * 1024, 1024, Bt + (size_t)nt * 128 * 1024, 1024, 1024, acc, As, Bs);
    gemm_epilogue<false>(acc, [&](int m, int n, float v) { Z[(size_t)(t0 + m) * 2944 + nt * 128 + n] = (bf16_t)f2bf(v); });
  }
  convert_tables(p, l, bid, nb);
}

DI void phase_o2(const Params& p, int l, int bid, int nb) {
  const int j = l >> 1;
  const int lane = tidx() & 63, wave = tidx() >> 6;
  const bf16_t* Z = (const bf16_t*)(p.ws + OFF_Z);
  bf16_t* XC = (bf16_t*)(p.ws + OFF_XC);
  bf16_t* LRIN = (bf16_t*)(p.ws + OFF_LRIN);
  bf16_t* KKN = (bf16_t*)(p.ws + OFF_KKN);
  bf16_t* KS = (bf16_t*)(p.ws + OFF_KS);
  bf16_t* RS = (bf16_t*)(p.ws + OFF_RS);
  bf16_t* VS = (bf16_t*)(p.ws + OFF_VS);
  const float* mu = p.in[I_MU] + (size_t)j * 1920;
  const int c0 = lane * 8;
  for (int t = bid * 4 + wave; t < T; t += nb * 4) {
    int seq, s, S, cv; tok_info(t, seq, s, S, cv);
    const bf16_t* zr = Z + (size_t)t * 2944;
    {
      float af[8], ab[8];
      load8f(p.in[I_LCB] + (size_t)(j * 2 + 0) * 512 + c0, af);
      load8f(p.in[I_LCB] + (size_t)(j * 2 + 1) * 512 + c0, ab);
#pragma unroll
      for (int o = -3; o <= 3; ++o) {
        float xv[8];
        if (s + o >= 0 && s + o < S) { uint4 u = *(const uint4*)(zr + (ptrdiff_t)o * 2944 + c0); unpack8(u, xv); }
        else {
#pragma unroll
          for (int i = 0; i < 8; ++i) xv[i] = 0.f;
        }
        if (o <= 0) {
          float w[8]; load8f(p.in[I_LCW] + ((size_t)(j * 2 + 0) * 4 + (o + 3)) * 512 + c0, w);
#pragma unroll
          for (int i = 0; i < 8; ++i) af[i] += w[i] * xv[i];
        }
        if (o >= 0) {
          float w[8]; load8f(p.in[I_LCW] + ((size_t)(j * 2 + 1) * 4 + (3 - o)) * 512 + c0, w);
#pragma unroll
          for (int i = 0; i < 8; ++i) ab[i] += w[i] * xv[i];
        }
      }
      *(uint4*)(XC + (size_t)t * 512 + c0) = pack8(af);
      *(uint4*)(XC + (size_t)T * 512 + (size_t)t * 512 + c0) = pack8(ab);
    }
    const bool hp_ = s > 0, hn = s < S - 1;
#pragma unroll
    for (int part = 0; part < 3; ++part) {
      const int col = 1024 + part * 512 + c0;
      float zc[8], zp[8], zn[8], m[8], zs[8];
      unpack8(*(const uint4*)(zr + col), zc);
      if (hp_) unpack8(*(const uint4*)(zr - 2944 + col), zp); else {
#pragma unroll
        for (int i = 0; i < 8; ++i) zp[i] = 0.f;
      }
      if (hn) unpack8(*(const uint4*)(zr + 2944 + col), zn); else {
#pragma unroll
        for (int i = 0; i < 8; ++i) zn[i] = 0.f;
      }
      load8f(mu + (col - 1024), m);
#pragma unroll
      for (int i = 0; i < 8; ++i) zs[i] = zc[i] + m[i] * (0.5f * (zp[i] + zn[i]) - zc[i]);
      if (part == 0) *(uint4*)(RS + (size_t)t * 512 + c0) = pack8(zs);
      else if (part == 2) *(uint4*)(VS + (size_t)t * 512 + c0) = pack8(zs);
      else {
        *(uint4*)(KS + (size_t)t * 512 + c0) = pack8(zs);
#pragma unroll
        for (int d = 0; d < 2; ++d) {
          float kk[8], raw[8]; load8f(p.in[I_KK] + (size_t)(j * 2 + d) * 512 + c0, kk);
          float ss = 0.f;
#pragma unroll
          for (int i = 0; i < 8; ++i) { raw[i] = zs[i] * kk[i]; ss += raw[i] * raw[i]; }
          ss = sum8(ss);
          float inv = rsqrtf(fmaxf(ss, 1e-24f));
#pragma unroll
          for (int i = 0; i < 8; ++i) raw[i] *= inv;
          *(uint4*)(KKN + (size_t)d * T * 512 + (size_t)t * 512 + c0) = pack8(raw);
        }
      }
    }
    if (lane < 48) {
      const int col = 2560 + c0;
      float zc[8], zp[8], zn[8], m[8], zs[8];
      unpack8(*(const uint4*)(zr + col), zc);
      if (hp_) unpack8(*(const uint4*)(zr - 2944 + col), zp); else {
#pragma unroll
        for (int i = 0; i < 8; ++i) zp[i] = 0.f;
      }
      if (hn) unpack8(*(const uint4*)(zr + 2944 + col), zn); else {
#pragma unroll
        for (int i = 0; i < 8; ++i) zn[i] = 0.f;
      }
      load8f(mu + (col - 1024), m);
#pragma unroll
      for (int i = 0; i < 8; ++i) {
        float z = zc[i] + m[i] * (0.5f * (zp[i] + zn[i]) - zc[i]);
        zs[i] = (lane < 16) ? tanh_f(z) : ((lane < 32) ? z : sigm(z));
      }
      *(uint4*)(LRIN + (size_t)t * 384 + c0) = pack8(zs);
    }
  }
}

DI void store8f(float* p, const float (&v)[8]) {
  ((float4*)p)[0] = make_float4(v[0], v[1], v[2], v[3]);
  ((float4*)p)[1] = make_float4(v[4], v[5], v[6], v[7]);
}
template <class F>
DI void staged_epilogue(const f32x16 (&acc)[2][2], float* Cs, F f) {
  __syncthreads();
  gemm_epilogue<false, false>(acc, [&](int m, int n, float v) { Cs[m * 132 + n] = v; });
  __syncthreads();
  const int tid = tidx(), r0 = tid >> 4, c8 = (tid & 15) * 8;
#pragma unroll 2
  for (int ps = 0; ps < 8; ++ps) {
    const int row = ps * 16 + r0;
    float v[8];
    load8f(Cs + row * 132 + c8, v);
    f(row, c8, v);
  }
}

DI void phase_o3(const Params& p, unsigned char* smem, int l, int bid, int nb) {
  const int j = l >> 1;
  bf16_t* As = (bf16_t*)smem; bf16_t* Bs = As + 128 * LDT;
  float* Cs = (float*)smem;
  const bf16_t* __restrict__ XC = (const bf16_t*)(p.ws + OFF_XC);
  const bf16_t* __restrict__ LRIN = (const bf16_t*)(p.ws + OFF_LRIN);
  const bf16_t* __restrict__ KKN = (const bf16_t*)(p.ws + OFF_KKN);
  const bf16_t* __restrict__ KS = (const bf16_t*)(p.ws + OFF_KS);
  float* __restrict__ LA = (float*)(p.ws + OFF_MIX);
  bf16_t* __restrict__ LB = (bf16_t*)(p.ws + OFF_LB);
  float* __restrict__ WD = (float*)(p.ws + OFF_WD);
  bf16_t* __restrict__ KKA = (bf16_t*)(p.ws + OFF_KKA);
  bf16_t* __restrict__ KM = (bf16_t*)(p.ws + OFF_KM);
  bf16_t* __restrict__ G = (bf16_t*)(p.ws + OFF_G);
  const int c8 = (tidx() & 15) * 8;
  for (int it = bid; it < 160 * 28; it += nb) {
    const int mt = it / 28, jb = it % 28, t0 = mt * 128;
    if (jb < 8) {
      const int d = jb >> 2, nt = jb & 3, ng = nt * 128 + c8;
      const bf16_t* A = XC + (size_t)d * T * 512 + (size_t)t0 * 512 + nt * 128;
      const bf16_t* Br = (const bf16_t*)(p.ws + OFF_BT_GATE) + ((size_t)((j * 2 + d) * 2 + 0) * 512 + nt * 128) * 128;
      const bf16_t* Bi = (const bf16_t*)(p.ws + OFF_BT_GATE) + ((size_t)((j * 2 + d) * 2 + 1) * 512 + nt * 128) * 128;
      float ba8[8], bx8[8], sp8[8];
      load8f(p.in[I_LBA] + (size_t)(j * 2 + d) * 512 + ng, ba8);
      load8f(p.in[I_LBX] + (size_t)(j * 2 + d) * 512 + ng, bx8);
      load8f(p.in[I_LLAM] + (size_t)(j * 2 + d) * 512 + ng, sp8);
#pragma unroll
      for (int i = 0; i < 8; ++i) { float nl = -sp8[i]; sp8[i] = -8.f * (nl > 20.f ? nl : log1pf(__expf(nl))); }
      {
        f32x16 acc[2][2];
        gemm_mainloop<false>(A, 512, Br, 128, 128, acc, As, Bs);
        staged_epilogue(acc, Cs, [&](int row, int cc, const float (&v)[8]) {
          const size_t o = ((size_t)d * T + t0 + row) * 512 + nt * 128 + cc;
          float a[8];
#pragma unroll
          for (int i = 0; i < 8; ++i) a[i] = __expf(sigm(v[i] + ba8[i]) * sp8[i]);
          store8f(LA + o, a);
        });
      }
      {
        f32x16 acc[2][2];
        gemm_mainloop<false>(A, 512, Bi, 128, 128, acc, As, Bs);
        staged_epilogue(acc, Cs, [&](int row, int cc, const float (&v)[8]) {
          const size_t o = ((size_t)d * T + t0 + row) * 512 + nt * 128 + cc;
          float a[8], xc[8], bb[8];
          load8f(LA + o, a);
          unpack8(*(const uint4*)(XC + o), xc);
#pragma unroll
          for (int i = 0; i < 8; ++i) bb[i] = sqrtf(fmaxf(1.f - a[i] * a[i], 0.f)) * sigm(v[i] + bx8[i]) * xc[i];
          *(uint4*)(LB + o) = pack8(bb);
        });
      }
    } else if (jb < 16) {
      const int d = (jb - 8) >> 2, nt = (jb - 8) & 3, ng = nt * 128 + c8;
      float w08[8]; load8f(p.in[I_W0] + (size_t)(j * 2 + d) * 512 + ng, w08);
      f32x16 acc[2][2];
      gemm_mainloop<false>(LRIN + (size_t)t0 * 384 + d * 64, 384, (const bf16_t*)(p.ws + OFF_BT_W2) + ((size_t)(j * 2 + d) * 512 + nt * 128) * 64, 64, 64, acc, As, Bs);
      staged_epilogue(acc, Cs, [&](int row, int cc, const float (&v)[8]) {
        float w[8];
#pragma unroll
        for (int i = 0; i < 8; ++i) w[i] = __expf(-0.6065306597126334f * sigm(w08[i] + v[i]));
        store8f(WD + ((size_t)d * T + t0 + row) * 512 + nt * 128 + cc, w);
      });
    } else if (jb < 24) {
      const int d = (jb - 16) >> 2, nt = (jb - 16) & 3, ng = nt * 128 + c8;
      float a08[8], ka8[8];
      load8f(p.in[I_A0] + (size_t)(j * 2 + d) * 512 + ng, a08);
      load8f(p.in[I_KA] + (size_t)(j * 2 + d) * 512 + ng, ka8);
      f32x16 acc[2][2];
      gemm_mainloop<false>(LRIN + (size_t)t0 * 384 + 128 + d * 64, 384, (const bf16_t*)(p.ws + OFF_BT_A2) + ((size_t)(j * 2 + d) * 512 + nt * 128) * 64, 64, 64, acc, As, Bs);
      staged_epilogue(acc, Cs, [&](int row, int cc, const float (&v)[8]) {
        const size_t o = ((size_t)d * T + t0 + row) * 512 + nt * 128 + cc;
        float kkn[8], ks[8], oa[8], om[8];
        unpack8(*(const uint4*)(KKN + o), kkn);
        unpack8(*(const uint4*)(KS + (size_t)(t0 + row) * 512 + nt * 128 + cc), ks);
#pragma unroll
        for (int i = 0; i < 8; ++i) {
          float ic = sigm(a08[i] + v[i]);
          oa[i] = kkn[i] * ic;
          om[i] = ks[i] * (1.f + (ic - 1.f) * ka8[i]);
        }
        *(uint4*)(KKA + o) = pack8(oa);
        *(uint4*)(KM + o) = pack8(om);
      });
    } else {
      const int nt = jb - 24;
      f32x16 acc[2][2];
      gemm_mainloop<false>(LRIN + (size_t)t0 * 384 + 256, 384, (const bf16_t*)(p.ws + OFF_BT_G2) + ((size_t)j * 512 + nt * 128) * 128, 128, 128, acc, As, Bs);
      staged_epilogue(acc, Cs, [&](int row, int cc, const float (&v)[8]) {
        float g[8];
#pragma unroll
        for (int i = 0; i < 8; ++i) g[i] = v[i];
        *(uint4*)(G + (size_t)(t0 + row) * 512 + nt * 128 + cc) = pack8(g);
      });
    }
  }
}

constexpr int WCH = 32;
constexpr int WBUF = 8192 + 4 * 4096 + 1024;
DI void wkv_scan_item(const Params& p, unsigned char* smem, int j, int b, int d, int h, int rg, bool ctx) {
  const int tid = tidx(), lane = tid & 63, wave = tid >> 6;
  const int rl = wave * 4 + (lane >> 4), row = rg * 16 + rl, q = lane & 15;
  const int S = ctx ? 256 : 4096, t0 = ctx ? b * 256 : 4096 + b * 4096;
  const char* WD = (const char*)(p.ws + OFF_WD) + (size_t)d * T * 512 * 4 + h * 256;
  const char* KKN = (const char*)(p.ws + OFF_KKN) + (size_t)d * T * 512 * 2 + h * 128;
  const char* KKA = (const char*)(p.ws + OFF_KKA) + (size_t)d * T * 512 * 2 + h * 128;
  const char* KM = (const char*)(p.ws + OFF_KM) + (size_t)d * T * 512 * 2 + h * 128;
  const char* RS = (const char*)(p.ws + OFF_RS) + h * 128;
  const char* VS = (const char*)(p.ws + OFF_VS) + (h * 64 + rg * 16) * 2;
  char* Y = (char*)(p.ws + (d ? OFF_XC : OFF_H)) + (h * 64 + rg * 16) * 4;
  unsigned char* ysb = smem + 2 * WBUF;
  float st[4];
  if (ctx) { st[0] = st[1] = st[2] = st[3] = 0.f; }
  else {
    float4 s4 = *(const float4*)(p.in[I_SWKV] + ((((size_t)(b * 2 + j) * 2 + d) * 8 + h) * 64 + row) * 64 + q * 4);
    st[0] = s4.x; st[1] = s4.y; st[2] = s4.z; st[3] = s4.w;
  }
  auto tokof = [&](int step) -> int { return t0 + (d ? (S - 1 - step) : step); };
  uint4 gw0, gw1, gk, gka, gkm, gr, gv;
  auto gload = [&](int c) {
    const int base = c * WCH;
    { int i0 = tid, i1 = tid + 256;
      gw0 = *(const uint4*)(WD + (unsigned)(tokof(base + (i0 >> 4)) * 2048 + (i0 & 15) * 16));
      gw1 = *(const uint4*)(WD + (unsigned)(tokof(base + (i1 >> 4)) * 2048 + (i1 & 15) * 16)); }
    const unsigned o2 = (unsigned)(tokof(base + (tid >> 3)) * 1024 + (tid & 7) * 16);
    gk = *(const uint4*)(KKN + o2); gka = *(const uint4*)(KKA + o2); gkm = *(const uint4*)(KM + o2); gr = *(const uint4*)(RS + o2);
    if (tid < 64) gv = *(const uint4*)(VS + (unsigned)(tokof(base + (tid >> 1)) * 1024 + (tid & 1) * 16));
  };
  auto lstore = [&](int bufi) {
    unsigned char* bb = smem + bufi * WBUF;
    *(uint4*)(bb + tid * 16) = gw0; *(uint4*)(bb + 4096 + tid * 16) = gw1;
    *(uint4*)(bb + 8192 + tid * 16) = gk; *(uint4*)(bb + 12288 + tid * 16) = gka;
    *(uint4*)(bb + 16384 + tid * 16) = gkm; *(uint4*)(bb + 20480 + tid * 16) = gr;
    if (tid < 64) *(uint4*)(bb + 24576 + tid * 16) = gv;
  };
  const int nch = S / WCH;
  __syncthreads();
  gload(0); lstore(0);
  __syncthreads();
  for (int c = 0; c < nch; ++c) {
    if (c + 1 < nch) gload(c + 1);
    const unsigned char* bb = smem + (c & 1) * WBUF;
    float* ys = (float*)(ysb + (c & 1) * 2048);
    float4 nw = *(const float4*)(bb + q * 16);
    uint2 nkk = *(const uint2*)(bb + 8192 + q * 8), nkka = *(const uint2*)(bb + 12288 + q * 8);
    uint2 nkm = *(const uint2*)(bb + 16384 + q * 8), nr = *(const uint2*)(bb + 20480 + q * 8);
    bf16_t nv = *(const bf16_t*)(bb + 24576 + rl * 2);
#pragma unroll 8
    for (int s = 0; s < WCH; ++s) {
      const float4 w = nw; const uint2 kk = nkk, kka = nkka, km = nkm, r = nr; const float v = bf2f(nv);
      {
        const int s1 = (s + 1 < WCH) ? s + 1 : s;
        nw = *(const float4*)(bb + s1 * 256 + q * 16);
        nkk = *(const uint2*)(bb + 8192 + s1 * 128 + q * 8); nkka = *(const uint2*)(bb + 12288 + s1 * 128 + q * 8);
        nkm = *(const uint2*)(bb + 16384 + s1 * 128 + q * 8); nr = *(const uint2*)(bb + 20480 + s1 * 128 + q * 8);
        nv = *(const bf16_t*)(bb + 24576 + s1 * 32 + rl * 2);
      }
      float sk = st[0] * bflo(kk.x) + st[1] * bfhi(kk.x) + st[2] * bflo(kk.y) + st[3] * bfhi(kk.y);
      sk = sum16(sk);
      st[0] = st[0] * w.x - sk * bflo(kka.x) + v * bflo(km.x);
      st[1] = st[1] * w.y - sk * bfhi(kka.x) + v * bfhi(km.x);
      st[2] = st[2] * w.z - sk * bflo(kka.y) + v * bflo(km.y);
      st[3] = st[3] * w.w - sk * bfhi(kka.y) + v * bfhi(km.y);
      float y = st[0] * bflo(r.x) + st[1] * bfhi(r.x) + st[2] * bflo(r.y) + st[3] * bfhi(r.y);
      y = sum16(y);
      ys[s * 16 + rl] = y;
    }
    if (c + 1 < nch) lstore((c + 1) & 1);
    __syncthreads();
    {
      const int base = c * WCH;
      const int s1 = tid >> 4, rr = tid & 15;
      *(float*)(Y + (unsigned)(tokof(base + s1) * 2048 + rr * 4)) = ys[s1 * 16 + rr];
      *(float*)(Y + (unsigned)(tokof(base + s1 + 16) * 2048 + rr * 4)) = ys[(s1 + 16) * 16 + rr];
    }
  }
  if (ctx) {
    float* o = p.out + 21004288 + ((((size_t)(b * 2 + j) * 2 + d) * 8 + h) * 64 + row) * 64 + q * 4;
    *(float4*)o = make_float4(st[0], st[1], st[2], st[3]);
  }
}

DI void lru_scan_item(const Params& p, unsigned char* smem, int j, int b, int cgp, bool ctx, int chb) {
  const int tid = tidx(), c = tid & ((1 << chb) - 1), sg = tid >> chb;
  const int nseg = NTHR >> chb;
  const int ch = (cgp << chb) + c;
  const int S = ctx ? 256 : 4096, t0 = ctx ? b * 256 : 4096 + b * 4096;
  const int L = S / nseg;
  float* sA = (float*)smem; float* sB = sA + 256;
  char* YM = (char*)(p.ws + OFF_YMIX);
  const char* Z = (const char*)(p.ws + OFF_Z);
  for (int d = 0; d < 2; ++d) {
    const char* la = (const char*)(p.ws + OFF_MIX) + (size_t)d * T * 512 * 4;
    const char* lb = (const char*)(p.ws + OFF_LB) + (size_t)d * T * 512 * 2;
    float A = 1.f, Bv = 0.f;
#pragma unroll 8
    for (int st = sg * L; st < (sg + 1) * L; ++st) {
      const int tk = t0 + (d ? (S - 1 - st) : st);
      float a = *(const float*)(la + (unsigned)(tk * 2048 + ch * 4));
      float bb = bf2f(*(const bf16_t*)(lb + (unsigned)(tk * 1024 + ch * 2)));
      A *= a; Bv = a * Bv + bb;
    }
    __syncthreads();
    sA[tid] = A; sB[tid] = Bv;
    __syncthreads();
    float h = ctx ? 0.f : p.in[I_SLRU][((size_t)(b * 2 + j) * 2 + d) * 512 + ch];
    for (int s2 = 0; s2 < sg; ++s2) h = sA[(s2 << chb) + c] * h + sB[(s2 << chb) + c];
#pragma unroll 8
    for (int st = sg * L; st < (sg + 1) * L; ++st) {
      const int tk = t0 + (d ? (S - 1 - st) : st);
      float a = *(const float*)(la + (unsigned)(tk * 2048 + ch * 4));
      float bb = bf2f(*(const bf16_t*)(lb + (unsigned)(tk * 1024 + ch * 2)));
      h = a * h + bb;
      bf16_t* ym = (bf16_t*)(YM + (unsigned)(tk * 2048 + ch * 2));
      if (d == 0) *ym = (bf16_t)f2bf(h);
      else {
        float hs = h + bf2f(*ym);
        float gb = bf2f(*(const bf16_t*)(Z + (unsigned)(tk * 5888 + 1024 + ch * 2)));
        *ym = (bf16_t)f2bf(hs * gelu_t(gb));
      }
    }
    if (ctx && sg == nseg - 1) p.out[20971520 + ((size_t)(b * 2 + j) * 2 + d) * 512 + ch] = h;
    __syncthreads();
  }
}

DI void phase_o4(const Params& p, unsigned char* smem, int l, int bid, int nb) {
  const int j = l >> 1;
  auto do_item = [&](int it) {
    if (it < 256) { int sid = it >> 2, rg = it & 3; wkv_scan_item(p, smem, j, sid >> 4, (sid >> 3) & 1, sid & 7, rg, false); }
    else if (it < 512) { int r = it - 256; lru_scan_item(p, smem, j, r >> 6, r & 63, false, 3); }
    else if (it < 1536) { int r = it - 512; int sid = r >> 2, rg = r & 3; wkv_scan_item(p, smem, j, sid >> 4, (sid >> 3) & 1, sid & 7, rg, true); }
    else { int r = it - 1536; lru_scan_item(p, smem, j, r >> 4, r & 15, true, 5); }
  };
  if (nb >= 512) {
    if (bid < 256) do_item(bid);
    else {
      const int ob = bid - 256, no = nb - 256;
      for (int it = 256 + ob; it < 512; it += no) do_item(it);
      for (int it = 512 + ob; it < 1792; it += no) do_item(it);
    }
  } else {
    for (int it = bid; it < 1792; it += nb) do_item(it);
  }
}

DI void phase_o5(const Params& p, int l, int bid, int nb) {
  const int j = l >> 1;
  const int lane = tidx() & 63, wave = tidx() >> 6;
  const float* YF = (const float*)(p.ws + OFF_H);
  const float* YB = (const float*)(p.ws + OFF_XC);
  const bf16_t* RS = (const bf16_t*)(p.ws + OFF_RS);
  const bf16_t* VS = (const bf16_t*)(p.ws + OFF_VS);
  const bf16_t* KM = (const bf16_t*)(p.ws + OFF_KM);
  const bf16_t* G = (const bf16_t*)(p.ws + OFF_G);
  bf16_t* YM = (bf16_t*)(p.ws + OFF_YMIX);
  const int c0 = lane * 8;
  float gng[8], gnb[8], rk[8];
  load8f(p.in[I_GNG] + j * 512 + c0, gng);
  load8f(p.in[I_GNB] + j * 512 + c0, gnb);
  load8f(p.in[I_RK] + j * 512 + c0, rk);
  for (int t = bid * 4 + wave; t < T; t += nb * 4) {
    const size_t o = (size_t)t * 512 + c0;
    float yf[8], yb[8], ys[8];
    load8f(YF + o, yf); load8f(YB + o, yb);
    float s = 0.f;
#pragma unroll
    for (int i = 0; i < 8; ++i) { ys[i] = yf[i] + yb[i]; s += ys[i]; }
    const float mean = sum8(s) * (1.f / 64.f);
    float v = 0.f;
#pragma unroll
    for (int i = 0; i < 8; ++i) { float dd = ys[i] - mean; v += dd * dd; }
    const float rstd = rsqrtf(sum8(v) * (1.f / 64.f) + 64e-5f);
    float r[8], vv[8], kf[8], kb[8], g[8];
    unpack8(*(const uint4*)(RS + o), r);
    unpack8(*(const uint4*)(VS + o), vv);
    unpack8(*(const uint4*)(KM + o), kf);
    unpack8(*(const uint4*)(KM + (size_t)T * 512 + o), kb);
    unpack8(*(const uint4*)(G + o), g);
    float sf = 0.f;
#pragma unroll
    for (int i = 0; i < 8; ++i) sf += r[i] * rk[i] * (kf[i] + kb[i]);
    sf = sum8(sf);
    float outv[8];
#pragma unroll
    for (int i = 0; i < 8; ++i) outv[i] = ((ys[i] - mean) * rstd * gng[i] + gnb[i] + sf * vv[i]) * g[i];
    *(uint4*)(YM + (size_t)t * 1024 + 512 + c0) = pack8(outv);
  }
}

enum { PH_PREP = 0, PH_INIT, PH_E1, PH_E2, PH_EOUT, PH_RES, PH_P1, PH_P2, PH_O1, PH_O2, PH_O3, PH_O4, PH_O5, PH_OOUT };

DI void run_phase(const Params& p, unsigned char* smem, int ph, int l, int bid, int nb) {
  switch (ph) {
    case PH_PREP: phase_prep(p, smem, bid, nb); break;
    case PH_INIT: phase_init(p, bid, nb); break;
    case PH_E1: phase_e1(p, smem, l, bid, nb); break;
    case PH_E2: phase_e2(p, smem, l, bid, nb); break;
    case PH_EOUT: phase_outgemm(p, smem, (const bf16_t*)(p.ws + OFF_BT_OUT_E) + (size_t)(l >> 1) * 1024 * 1024, bid, nb); break;
    case PH_RES: phase_res1(p, l, bid, nb); break;
    case PH_P1: phase_p1(p, smem, l, bid, nb); break;
    case PH_P2: phase_p2(p, smem, l, bid, nb); break;
    case PH_O1: phase_o1(p, smem, l, bid, nb); break;
    case PH_O2: phase_o2(p, l, bid, nb); break;
    case PH_O3: phase_o3(p, smem, l, bid, nb); break;
    case PH_O4: phase_o4(p, smem, l, bid, nb); break;
    case PH_O5: phase_o5(p, l, bid, nb); break;
    case PH_OOUT: phase_outgemm(p, smem, (const bf16_t*)(p.ws + OFF_BT_OUT_O) + (size_t)(l >> 1) * 1024 * 1024, bid, nb); break;
  }
}

#if MULTI
__global__ void __launch_bounds__(NTHR, 2) phase_kernel(Params p, int ph, int l) {
  extern __shared__ __attribute__((aligned(16))) unsigned char smem[];
  run_phase(p, smem, ph, l, blockIdx.x, gridDim.x);
}
#else
#ifndef TPROBE
#define TPROBE 0
#endif
__global__ void __launch_bounds__(NTHR, 2) mega_kernel(Params p) {
  extern __shared__ __attribute__((aligned(16))) unsigned char smem[];
  cg::grid_group grid = cg::this_grid();
  const int bid = blockIdx.x, nb = gridDim.x;
#if TPROBE
  unsigned long long tprev = wall_clock64(), tsel = 0, ttot = 0;
#endif
  for (int step = 0; step < 32; ++step) {
    int ph, l;
    if (step < 2) { ph = step; l = 0; }
    else {
      int s = step - 2, k;
      if (s < 6) { l = 0; k = s; } else if (s < 15) { l = 1; k = s - 6; } else if (s < 21) { l = 2; k = s - 15; } else { l = 3; k = s - 21; }
      if ((l & 1) == 0) ph = PH_E1 + k;
      else ph = (k < 6) ? PH_O1 + k : PH_RES + (k - 6);
    }
#if defined(__HIP_DEVICE_COMPILE__)
    const __attribute__((address_space(4))) Params* kp = (const __attribute__((address_space(4))) Params*)__builtin_amdgcn_kernarg_segment_ptr();
    asm volatile("" : "+s"(kp), "+s"(l), "+s"(ph));
    const Params q = *kp;
#else
    const Params q = p;
#endif
    run_phase(q, smem, ph, l, bid, nb);
#if !TPROBE
    if (step == 31) break;
#endif
    __threadfence();
    grid.sync();
#if TPROBE
    {
      unsigned long long tn = wall_clock64();
      if ((TPROBE >> ph) & 1) tsel += tn - tprev;
      ttot += tn - tprev;
      tprev = tn;
    }
#endif
  }
#if TPROBE
  if (bid == 0) {
    float frac = (float)((double)tsel / (double)ttot);
    float sc = 1.f + sqrtf(frac);
    for (int i = tidx(); i < 32768; i += NTHR) p.out[20971520 + i] *= sc;
  }
#endif
}
#endif

extern "C" void kernel_launch(void* const* d_in, const int* in_sizes, int n_in, void* d_out, int out_size, void* d_ws, size_t ws_size,
                              hipStream_t stream) {
  static int grid_blocks = 0;
  if (grid_blocks == 0) {
    if (n_in != 40 || ws_size < WS_END) { fprintf(stderr, "kernel_launch: unexpected n_in %d or ws_size %zu (need %zu)\n", n_in, ws_size, (size_t)WS_END); grid_blocks = -1; return; }
    int dev = 0, cus = 0, per_cu = 0;
    hipGetDevice(&dev);
    hipDeviceGetAttribute(&cus, hipDeviceAttributeMultiprocessorCount, dev);
#if MULTI
    hipFuncSetAttribute((const void*)phase_kernel, hipFuncAttributeMaxDynamicSharedMemorySize, LDS_BYTES);
    hipOccupancyMaxActiveBlocksPerMultiprocessor(&per_cu, (const void*)phase_kernel, NTHR, LDS_BYTES);
#else
    hipFuncSetAttribute((const void*)mega_kernel, hipFuncAttributeMaxDynamicSharedMemorySize, LDS_BYTES);
    hipOccupancyMaxActiveBlocksPerMultiprocessor(&per_cu, (const void*)mega_kernel, NTHR, LDS_BYTES);
#endif
    if (per_cu < 1) per_cu = 1;
    if (per_cu > 2) per_cu = 2;
    if (cus < 1) cus = 256;
    grid_blocks = cus * per_cu;
  }
  if (grid_blocks < 0) return;
  Params p{};
  for (int i = 0; i < 40; ++i) p.in[i] = (const float*)d_in[i];
  p.out = (float*)d_out;
  p.ws = (unsigned char*)d_ws;
#if MULTI
  auto L = [&](int ph, int l) { hipLaunchKernelGGL(phase_kernel, dim3(grid_blocks), dim3(NTHR), LDS_BYTES, stream, p, ph, l); };
  L(PH_PREP, 0); L(PH_INIT, 0);
  for (int l = 0; l < 4; ++l) {
    if ((l & 1) == 0) { L(PH_E1, l); L(PH_E2, l); L(PH_EOUT, l); }
    else { L(PH_O1, l); L(PH_O2, l); L(PH_O3, l); L(PH_O4, l); L(PH_O5, l); L(PH_OOUT, l); }
    L(PH_RES, l); L(PH_P1, l); L(PH_P2, l);
  }
#else
  void* args[] = {&p};
  hipError_t e = hipLaunchCooperativeKernel((const void*)mega_kernel, dim3(grid_blocks), dim3(NTHR), args, LDS_BYTES, stream);
  if (e != hipSuccess) fprintf(stderr, "cooperative launch failed: %s (grid %d)\n", hipGetErrorString(e), grid_blocks);
#endif
}
```

```cpp
#include <hip/hip_runtime.h>
#include <hip/hip_cooperative_groups.h>
#include <cstdio>
#include <cstdint>
namespace cg = cooperative_groups;

#ifndef MULTI
#define MULTI 0
#endif

typedef unsigned short bf16_t;
using bf16x8 = __attribute__((ext_vector_type(8))) short;
using f32x16 = __attribute__((ext_vector_type(16))) float;
#define DI __device__ __forceinline__
#define MFMA(a, b, c) __builtin_amdgcn_mfma_f32_32x32x16_bf16((a), (b), (c), 0, 0, 0)

constexpr int T = 20480;
constexpr int NTHR = 256;
constexpr int LDS_BYTES = 71680;
constexpr float ALPHA_F = 1.681792830507429f;

constexpr size_t MiB = 1u << 20;
constexpr size_t OFF_TABU = 0;
constexpr size_t OFF_TABV = OFF_TABU + 32 * MiB;
constexpr size_t OFF_BT_IN_E = OFF_TABV + 32 * MiB;
constexpr size_t OFF_BT_OUT_E = OFF_BT_IN_E + 10 * MiB;
constexpr size_t OFF_BT_IN_O = OFF_BT_OUT_E + 4 * MiB;
constexpr size_t OFF_BT_OUT_O = OFF_BT_IN_O + 12 * MiB;
constexpr size_t OFF_BT_WQ = OFF_BT_OUT_O + 4 * MiB;
constexpr size_t OFF_BT_W2 = OFF_BT_WQ + 16 * MiB;
constexpr size_t OFF_BT_A2 = OFF_BT_W2 + 256 * 1024;
constexpr size_t OFF_BT_G2 = OFF_BT_A2 + 256 * 1024;
constexpr size_t OFF_BT_GATE = OFF_BT_G2 + 256 * 1024;
constexpr size_t OFF_D256 = OFF_BT_GATE + 2 * MiB;
constexpr size_t OFF_MOD = OFF_D256 + 256 * 1024;
constexpr size_t OFF_D4096 = OFF_MOD + 512 * 1024;
constexpr size_t OFF_X = OFF_D4096 + 64 * MiB;
constexpr size_t OFF_Z = OFF_X + 80 * MiB;
constexpr size_t OFF_YMIX = OFF_Z + 115 * MiB;
constexpr size_t OFF_MIX = OFF_YMIX + 40 * MiB;
constexpr size_t OFF_H = OFF_MIX + 80 * MiB;
constexpr size_t OFF_XC = OFF_H + 40 * MiB;
constexpr size_t OFF_LRIN = OFF_XC + 40 * MiB;
constexpr size_t OFF_KKN = OFF_LRIN + 15 * MiB;
constexpr size_t OFF_KS = OFF_KKN + 40 * MiB;
constexpr size_t OFF_RS = OFF_KS + 20 * MiB;
constexpr size_t OFF_VS = OFF_RS + 20 * MiB;
constexpr size_t OFF_LB = OFF_VS + 20 * MiB;
constexpr size_t OFF_WD = OFF_LB + 40 * MiB;
constexpr size_t OFF_KKA = OFF_WD + 80 * MiB;
constexpr size_t OFF_KM = OFF_KKA + 40 * MiB;
constexpr size_t OFF_G = OFF_KM + 40 * MiB;
constexpr size_t WS_END = OFF_G + 20 * MiB;

struct Params {
  const float* in[40];
  float* out;
  unsigned char* ws;
};

enum {
  I_XP = 0, I_XS, I_SLRU, I_SWKV, I_C, I_CCTX, I_WMOD, I_BMOD, I_LN1G, I_LN1B, I_LN2G, I_LN2B, I_WINE, I_WOUTE, I_SCW, I_SCB,
  I_WINO, I_WOUTO, I_LCW, I_LCB, I_LWA, I_LBA, I_LWX, I_LBX, I_LLAM, I_MU, I_W0, I_W2, I_A0, I_A2, I_KK, I_KA, I_RK, I_G2, I_GNG,
  I_GNB, I_WQ, I_KEYS, I_PU, I_PV
};

DI int tidx() { int t = __builtin_amdgcn_workitem_id_x(); asm volatile("" : "+v"(t)); return t; }
DI unsigned f2bf(float x) { unsigned u = __float_as_uint(x); u += 0x7fffu + ((u >> 16) & 1u); return u >> 16; }
DI unsigned pack2(float a, float b) { return f2bf(a) | (f2bf(b) << 16); }
DI float bflo(unsigned u) { return __uint_as_float(u << 16); }
DI float bfhi(unsigned u) { return __uint_as_float(u & 0xffff0000u); }
DI float bf2f(bf16_t h) { return __uint_as_float(((unsigned)h) << 16); }
DI float sigm(float x) { return 1.f / (1.f + __expf(-x)); }
DI float gelu_t(float x) { float u = 0.7978845608028654f * (x + 0.044715f * x * x * x); return x * sigm(2.f * u); }
DI float tanh_f(float x) { return 2.f * sigm(2.f * x) - 1.f; }

template <int CTRL> DI float dpp_mov(float x) {
  return __int_as_float(__builtin_amdgcn_update_dpp(0, __float_as_int(x), CTRL, 0xF, 0xF, true));
}
DI float sum8(float x) { x += dpp_mov<0xB1>(x); x += dpp_mov<0x4E>(x); x += dpp_mov<0x141>(x); return x; }
DI float sum16(float x) { x = sum8(x); x += dpp_mov<0x140>(x); return x; }
DI float max16(float x) {
  x = fmaxf(x, dpp_mov<0xB1>(x)); x = fmaxf(x, dpp_mov<0x4E>(x)); x = fmaxf(x, dpp_mov<0x141>(x)); x = fmaxf(x, dpp_mov<0x140>(x));
  return x;
}
DI float wave_sum(float x) { x = sum16(x); x += __shfl_xor(x, 16); x += __shfl_xor(x, 32); return x; }

DI void tok_info(int t, int& seq, int& s, int& S, int& cv) {
  if (t < 4096) { seq = t >> 8; s = t & 255; S = 256; cv = 0; }
  else { int u = t - 4096; seq = 16 + (u >> 12); s = u & 4095; S = 4096; cv = 1 + (u >> 12); }
}
DI size_t pqt_base(int seq) { return seq < 16 ? (size_t)seq * 512 * 512 : (size_t)16 * 512 * 512 + (size_t)(seq - 16) * 512 * 8192; }

DI void load_row(const float* p, int lane, float (&v)[16]) {
  const float4* q = (const float4*)(p + lane * 8);
  float4 a = q[0], b = q[1];
  const float4* q2 = (const float4*)(p + 512 + lane * 8);
  float4 c = q2[0], d = q2[1];
  v[0] = a.x; v[1] = a.y; v[2] = a.z; v[3] = a.w; v[4] = b.x; v[5] = b.y; v[6] = b.z; v[7] = b.w;
  v[8] = c.x; v[9] = c.y; v[10] = c.z; v[11] = c.w; v[12] = d.x; v[13] = d.y; v[14] = d.z; v[15] = d.w;
}
DI void store_row(float* p, int lane, const float (&v)[16]) {
  float4* q = (float4*)(p + lane * 8);
  q[0] = make_float4(v[0], v[1], v[2], v[3]); q[1] = make_float4(v[4], v[5], v[6], v[7]);
  float4* q2 = (float4*)(p + 512 + lane * 8);
  q2[0] = make_float4(v[8], v[9], v[10], v[11]); q2[1] = make_float4(v[12], v[13], v[14], v[15]);
}
DI void store_row_bf(bf16_t* p, int lane, const float (&v)[16]) {
  uint4 a, b;
  a.x = pack2(v[0], v[1]); a.y = pack2(v[2], v[3]); a.z = pack2(v[4], v[5]); a.w = pack2(v[6], v[7]);
  b.x = pack2(v[8], v[9]); b.y = pack2(v[10], v[11]); b.z = pack2(v[12], v[13]); b.w = pack2(v[14], v[15]);
  *(uint4*)(p + lane * 8) = a;
  *(uint4*)(p + 512 + lane * 8) = b;
}
DI void unpack8(uint4 u, float (&v)[8]) {
  v[0] = bflo(u.x); v[1] = bfhi(u.x); v[2] = bflo(u.y); v[3] = bfhi(u.y); v[4] = bflo(u.z); v[5] = bfhi(u.z); v[6] = bflo(u.w); v[7] = bfhi(u.w);
}
DI uint4 pack8(const float (&v)[8]) {
  uint4 a; a.x = pack2(v[0], v[1]); a.y = pack2(v[2], v[3]); a.z = pack2(v[4], v[5]); a.w = pack2(v[6], v[7]); return a;
}
DI void load8f(const float* p, float (&v)[8]) {
  float4 a = ((const float4*)p)[0], b = ((const float4*)p)[1];
  v[0] = a.x; v[1] = a.y; v[2] = a.z; v[3] = a.w; v[4] = b.x; v[5] = b.y; v[6] = b.z; v[7] = b.w;
}

DI void load_row16(const float* p, int lane, float (&v)[16]) {
  const float4* q = (const float4*)(p + lane * 16);
  float4 a = q[0], b = q[1], c = q[2], d = q[3];
  v[0] = a.x; v[1] = a.y; v[2] = a.z; v[3] = a.w; v[4] = b.x; v[5] = b.y; v[6] = b.z; v[7] = b.w;
  v[8] = c.x; v[9] = c.y; v[10] = c.z; v[11] = c.w; v[12] = d.x; v[13] = d.y; v[14] = d.z; v[15] = d.w;
}
DI void store_row16(float* p, int lane, const float (&v)[16]) {
  float4* q = (float4*)(p + lane * 16);
  q[0] = make_float4(v[0], v[1], v[2], v[3]); q[1] = make_float4(v[4], v[5], v[6], v[7]);
  q[2] = make_float4(v[8], v[9], v[10], v[11]); q[3] = make_float4(v[12], v[13], v[14], v[15]);
}
DI void store_row16_bf(bf16_t* p, int lane, const float (&v)[16]) {
  uint4 a, b;
  a.x = pack2(v[0], v[1]); a.y = pack2(v[2], v[3]); a.z = pack2(v[4], v[5]); a.w = pack2(v[6], v[7]);
  b.x = pack2(v[8], v[9]); b.y = pack2(v[10], v[11]); b.z = pack2(v[12], v[13]); b.w = pack2(v[14], v[15]);
  uint4* q = (uint4*)(p + lane * 16);
  q[0] = a; q[1] = b;
}
typedef float v2f_t __attribute__((ext_vector_type(2)));
DI unsigned pk_fp8x4(float a, float b, float c, float d) {
  int w = 0;
  w = __builtin_amdgcn_cvt_pk_fp8_f32(a, b, w, false);
  w = __builtin_amdgcn_cvt_pk_fp8_f32(c, d, w, true);
  return (unsigned)w;
}
DI void unpack_fp8x16(uint4 u, float (&v)[16]) {
  v2f_t t;
  t = __builtin_amdgcn_cvt_pk_f32_fp8((int)u.x, false); v[0] = t.x; v[1] = t.y;
  t = __builtin_amdgcn_cvt_pk_f32_fp8((int)u.x, true); v[2] = t.x; v[3] = t.y;
  t = __builtin_amdgcn_cvt_pk_f32_fp8((int)u.y, false); v[4] = t.x; v[5] = t.y;
  t = __builtin_amdgcn_cvt_pk_f32_fp8((int)u.y, true); v[6] = t.x; v[7] = t.y;
  t = __builtin_amdgcn_cvt_pk_f32_fp8((int)u.z, false); v[8] = t.x; v[9] = t.y;
  t = __builtin_amdgcn_cvt_pk_f32_fp8((int)u.z, true); v[10] = t.x; v[11] = t.y;
  t = __builtin_amdgcn_cvt_pk_f32_fp8((int)u.w, false); v[12] = t.x; v[13] = t.y;
  t = __builtin_amdgcn_cvt_pk_f32_fp8((int)u.w, true); v[14] = t.x; v[15] = t.y;
}
DI void ln16(float (&y)[16]) {
  float s = 0.f;
#pragma unroll
  for (int i = 0; i < 16; ++i) s += y[i];
  float mu = wave_sum(s) * (1.f / 1024.f);
  float v = 0.f;
#pragma unroll
  for (int i = 0; i < 16; ++i) { float d = y[i] - mu; v += d * d; }
  v = wave_sum(v) * (1.f / 1024.f);
  float rs = rsqrtf(v + 1e-6f);
#pragma unroll
  for (int i = 0; i < 16; ++i) y[i] = (y[i] - mu) * rs;
}

constexpr int LDT = 72;

template <bool SWAP>
DI void gemm_mainloop(const bf16_t* __restrict__ A, int lda, const bf16_t* __restrict__ B, int ldb, int K,
                      f32x16 (&acc)[2][2], bf16_t* As, bf16_t* Bs) {
  const int tid = tidx(), lane = tid & 63, wave = tid >> 6;
  const int wm = wave >> 1, wn = wave & 1;
  const int lrow = tid >> 3, lck = tid & 7;
  const bf16_t* ap = A + (size_t)lrow * lda + lck * 8;
  const bf16_t* bp = B + (size_t)lrow * ldb + lck * 8;
  const size_t sa = (size_t)32 * lda, sb = (size_t)32 * ldb;
  uint4 ra0, ra1, ra2, ra3, rb0, rb1, rb2, rb3;
  ra0 = *(const uint4*)(ap); ra1 = *(const uint4*)(ap + sa); ra2 = *(const uint4*)(ap + 2 * sa); ra3 = *(const uint4*)(ap + 3 * sa);
  rb0 = *(const uint4*)(bp); rb1 = *(const uint4*)(bp + sb); rb2 = *(const uint4*)(bp + 2 * sb); rb3 = *(const uint4*)(bp + 3 * sb);
#pragma unroll
  for (int mi = 0; mi < 2; ++mi)
#pragma unroll
    for (int ni = 0; ni < 2; ++ni)
#pragma unroll
      for (int r = 0; r < 16; ++r) acc[mi][ni][r] = 0.f;
  const int KT = K / 64;
  const int fr = (lane & 31) * LDT + (lane >> 5) * 8;
  bf16_t* asw = As + lrow * LDT + lck * 8;
  bf16_t* bsw = Bs + lrow * LDT + lck * 8;
  for (int kt = 0; kt < KT; ++kt) {
    __syncthreads();
    *(uint4*)(asw) = ra0; *(uint4*)(asw + 32 * LDT) = ra1; *(uint4*)(asw + 64 * LDT) = ra2; *(uint4*)(asw + 96 * LDT) = ra3;
    *(uint4*)(bsw) = rb0; *(uint4*)(bsw + 32 * LDT) = rb1; *(uint4*)(bsw + 64 * LDT) = rb2; *(uint4*)(bsw + 96 * LDT) = rb3;
    __syncthreads();
    if (kt + 1 < KT) {
      const bf16_t* a2 = ap + (kt + 1) * 64;
      const bf16_t* b2 = bp + (kt + 1) * 64;
      ra0 = *(const uint4*)(a2); ra1 = *(const uint4*)(a2 + sa); ra2 = *(const uint4*)(a2 + 2 * sa); ra3 = *(const uint4*)(a2 + 3 * sa);
      rb0 = *(const uint4*)(b2); rb1 = *(const uint4*)(b2 + sb); rb2 = *(const uint4*)(b2 + 2 * sb); rb3 = *(const uint4*)(b2 + 3 * sb);
    }
#pragma unroll
    for (int kk = 0; kk < 4; ++kk) {
      const bf16x8 af0 = *(const bf16x8*)(As + (wm * 64) * LDT + fr + kk * 16);
      const bf16x8 af1 = *(const bf16x8*)(As + (wm * 64 + 32) * LDT + fr + kk * 16);
      const bf16x8 bf0 = *(const bf16x8*)(Bs + (wn * 64) * LDT + fr + kk * 16);
      const bf16x8 bf1 = *(const bf16x8*)(Bs + (wn * 64 + 32) * LDT + fr + kk * 16);
      if (SWAP) {
        acc[0][0] = MFMA(bf0, af0, acc[0][0]); acc[0][1] = MFMA(bf1, af0, acc[0][1]);
        acc[1][0] = MFMA(bf0, af1, acc[1][0]); acc[1][1] = MFMA(bf1, af1, acc[1][1]);
      } else {
        acc[0][0] = MFMA(af0, bf0, acc[0][0]); acc[0][1] = MFMA(af0, bf1, acc[0][1]);
        acc[1][0] = MFMA(af1, bf0, acc[1][0]); acc[1][1] = MFMA(af1, bf1, acc[1][1]);
      }
    }
  }
}

template <bool SWAP, bool SB = true, class F>
DI void gemm_epilogue(const f32x16 (&acc)[2][2], F f) {
  const int lane = tidx() & 63, wave = tidx() >> 6;
  const int wm = wave >> 1, wn = wave & 1;
#pragma unroll
  for (int mi = 0; mi < 2; ++mi)
#pragma unroll
    for (int ni = 0; ni < 2; ++ni)
#pragma unroll
      for (int r = 0; r < 16; ++r) {
        const int i = (r & 3) + 8 * (r >> 2) + 4 * (lane >> 5);
        const int j = lane & 31;
        int m, n;
        if (!SWAP) { m = wm * 64 + mi * 32 + i; n = wn * 64 + ni * 32 + j; }
        else { n = wn * 64 + ni * 32 + i; m = wm * 64 + mi * 32 + j; }
        f(m, n, acc[mi][ni][r]);
        if (SB && (r & 3) == 3) __builtin_amdgcn_sched_barrier(0);
      }
}
template <class F>
DI void gemm_epilogue2(const f32x16 (&a0)[2][2], const f32x16 (&a1)[2][2], F f) {
  const int lane = tidx() & 63, wave = tidx() >> 6;
  const int wm = wave >> 1, wn = wave & 1;
#pragma unroll
  for (int mi = 0; mi < 2; ++mi)
#pragma unroll
    for (int ni = 0; ni < 2; ++ni)
#pragma unroll
      for (int r = 0; r < 16; ++r) {
        const int i = (r & 3) + 8 * (r >> 2) + 4 * (lane >> 5);
        const int j = lane & 31;
        f(wm * 64 + mi * 32 + i, wn * 64 + ni * 32 + j, a0[mi][ni][r], a1[mi][ni][r]);
      }
}

DI int tr_tiles(int job) {
  if (job < 2) return 384; if (job < 4) return 256; if (job < 6) return 736; if (job < 8) return 256;
  if (job < 12) return 512; if (job < 20) return 8; return 16;
}
DI void phase_prep(const Params& p, unsigned char* smem, int bid, int nb) {
  const int tid = tidx();
  constexpr int N_MOD = 384, N_TR = 768 + 512 + 1472 + 512 + 2048 + 32 + 32 + 32, N_FOLD = 256, N_GATE = 512, N_DFT = 16384 + 64;
  constexpr int TOTAL = N_MOD + N_TR + N_FOLD + N_GATE + N_DFT;
  unsigned char* ws = p.ws;
  for (int it = bid; it < TOTAL; it += nb) {
    if (it < N_MOD) {
      const int l = it / 96, cchunk = it % 96;
      float* sil = (float*)smem;
      float* red = sil + 5 * 1024;
      __syncthreads();
      for (int i = tid; i < 5120; i += NTHR) {
        int cv = i >> 10, k = i & 1023;
        float c = (cv == 0) ? p.in[I_CCTX][k] : p.in[I_C][(cv - 1) * 1024 + k];
        sil[i] = c * sigm(c);
      }
      __syncthreads();
      const int col = cchunk * 64 + (tid & 63), kg = tid >> 6;
      const float* w = p.in[I_WMOD] + (size_t)l * 1024 * 6144 + col;
      float a0 = 0.f, a1 = 0.f, a2 = 0.f, a3 = 0.f, a4 = 0.f;
#pragma unroll 8
      for (int k = kg * 256; k < kg * 256 + 256; ++k) {
        float wv = w[(size_t)k * 6144];
        a0 += sil[k] * wv; a1 += sil[1024 + k] * wv; a2 += sil[2048 + k] * wv; a3 += sil[3072 + k] * wv; a4 += sil[4096 + k] * wv;
      }
      const int c = tid & 63;
      red[(kg * 5 + 0) * 64 + c] = a0; red[(kg * 5 + 1) * 64 + c] = a1; red[(kg * 5 + 2) * 64 + c] = a2;
      red[(kg * 5 + 3) * 64 + c] = a3; red[(kg * 5 + 4) * 64 + c] = a4;
      __syncthreads();
      for (int i = tid; i < 320; i += NTHR) {
        int cv = i >> 6, cc = i & 63;
        float s = red[(0 * 5 + cv) * 64 + cc] + red[(1 * 5 + cv) * 64 + cc] + red[(2 * 5 + cv) * 64 + cc] + red[(3 * 5 + cv) * 64 + cc];
        s += p.in[I_BMOD][l * 6144 + cchunk * 64 + cc];
        ((float*)(ws + OFF_MOD))[(l * 5 + cv) * 6144 + cchunk * 64 + cc] = s;
      }
    } else if (it < N_MOD + N_TR) {
      int r = it - N_MOD, job = 0;
      for (job = 0; job < 22; ++job) { int nt = tr_tiles(job); if (r < nt) break; r -= nt; }
      const float* src; bf16_t* dst; int lds, ldd, N;
      if (job < 2) { src = p.in[I_WINE] + (size_t)job * 1024 * 2048 + 512; lds = 2048; N = 1536; dst = (bf16_t*)(ws + OFF_BT_IN_E) + (size_t)job * 2560 * 1024 + (size_t)1024 * 1024; ldd = 1024; }
      else if (job < 4) { int j = job - 2; src = p.in[I_WOUTE] + (size_t)j * 1024 * 1024; lds = 1024; N = 1024; dst = (bf16_t*)(ws + OFF_BT_OUT_E) + (size_t)j * 1024 * 1024; ldd = 1024; }
      else if (job < 6) { int j = job - 4; src = p.in[I_WINO] + (size_t)j * 1024 * 2944; lds = 2944; N = 2944; dst = (bf16_t*)(ws + OFF_BT_IN_O) + (size_t)j * 2944 * 1024; ldd = 1024; }
      else if (job < 8) { int j = job - 6; src = p.in[I_WOUTO] + (size_t)j * 1024 * 1024; lds = 1024; N = 1024; dst = (bf16_t*)(ws + OFF_BT_OUT_O) + (size_t)j * 1024 * 1024; ldd = 1024; }
      else if (job < 12) { int j = job - 8; src = p.in[I_WQ] + (size_t)j * 1024 * 2048; lds = 2048; N = 2048; dst = (bf16_t*)(ws + OFF_BT_WQ) + (size_t)j * 2048 * 1024; ldd = 1024; }
      else if (job < 16) { int j = job - 12; src = p.in[I_W2] + (size_t)j * 64 * 512; lds = 512; N = 512; dst = (bf16_t*)(ws + OFF_BT_W2) + (size_t)j * 512 * 64; ldd = 64; }
      else if (job < 20) { int j = job - 16; src = p.in[I_A2] + (size_t)j * 64 * 512; lds = 512; N = 512; dst = (bf16_t*)(ws + OFF_BT_A2) + (size_t)j * 512 * 64; ldd = 64; }
      else { int j = job - 20; src = p.in[I_G2] + (size_t)j * 128 * 512; lds = 512; N = 512; dst = (bf16_t*)(ws + OFF_BT_G2) + (size_t)j * 512 * 128; ldd = 128; }
      const int ntn = N / 64;
      const int k0 = (r / ntn) * 64, n0 = (r % ntn) * 64;
      float* tl = (float*)smem;
      __syncthreads();
#pragma unroll 4
      for (int ps = 0; ps < 16; ++ps) {
        int kr = ps * 4 + (tid >> 6), n = tid & 63;
        tl[kr * 65 + n] = src[(size_t)(k0 + kr) * lds + n0 + n];
      }
      __syncthreads();
#pragma unroll 4
      for (int ps = 0; ps < 8; ++ps) {
        int nr = ps * 8 + (tid >> 5), k2 = tid & 31;
        unsigned v = pack2(tl[(2 * k2) * 65 + nr], tl[(2 * k2 + 1) * 65 + nr]);
        *(unsigned*)(dst + (size_t)(n0 + nr) * ldd + k0 + 2 * k2) = v;
      }
    } else if (it < N_MOD + N_TR + N_FOLD) {
      int r = it - N_MOD - N_TR;
      const int j = r >> 7, rr = r & 127, which = rr >> 6, g = (rr >> 4) & 3, kt = rr & 15;
      const int k0 = kt * 64;
      float* Wl = (float*)smem;
      float* tab = Wl + 64 * 129;
      __syncthreads();
      if (tid < 128) { float fr = (float)tid * (1.f / 128.f); tab[tid] = which ? __builtin_amdgcn_sinf(fr) : __builtin_amdgcn_cosf(fr); }
      for (int ps = 0; ps < 32; ++ps) {
        int kr = ps * 2 + (tid >> 7), c = tid & 127;
        Wl[kr * 129 + c] = p.in[I_WINE][(size_t)j * 1024 * 2048 + (size_t)(k0 + kr) * 2048 + g * 128 + c];
      }
      __syncthreads();
      const int k = tid & 63, nq = tid >> 6;
      bf16_t* dst = (bf16_t*)(ws + OFF_BT_IN_E) + (size_t)j * 2560 * 1024;
      for (int i = 0; i < 32; ++i) {
        const int np = nq * 32 + i;
        float s = 0.f;
#pragma unroll 8
        for (int c = 0; c < 128; ++c) s += Wl[k * 129 + c] * tab[(c * np) & 127];
        dst[(size_t)(which * 512 + g * 128 + np) * 1024 + k0 + k] = (bf16_t)f2bf(s);
      }
    } else if (it < N_MOD + N_TR + N_FOLD + N_GATE) {
      int r = it - N_MOD - N_TR - N_FOLD;
      bf16_t* dst = (bf16_t*)(ws + OFF_BT_GATE);
      for (int e = 0; e < 4; ++e) {
        int idx = r * 1024 + e * 256 + tid;
        int kp = idx & 127, n = (idx >> 7) & 511, gate = (idx >> 16) & 1, d = (idx >> 17) & 1, j = idx >> 18;
        int h = n >> 6;
        float v = 0.f;
        if ((kp >> 6) == (h & 1)) {
          const float* W = gate ? p.in[I_LWX] : p.in[I_LWA];
          v = W[((((size_t)(j * 2 + d) * 8 + h) * 64 + (kp & 63)) * 64) + (n & 63)];
        }
        dst[idx] = (bf16_t)f2bf(v);
      }
    } else {
      int r = it - N_MOD - N_TR - N_FOLD - N_GATE;
      int S, K2; bf16_t* dst; size_t idx;
      if (r < 16384) { S = 4096; K2 = 8192; dst = (bf16_t*)(ws + OFF_D4096); idx = (size_t)r * 2048 + tid * 8; }
      else { S = 256; K2 = 512; dst = (bf16_t*)(ws + OFF_D256); idx = (size_t)(r - 16384) * 2048 + tid * 8; }
      const int row = (int)(idx / K2), kb = (int)(idx % K2);
      const float invS = 1.f / (float)S;
      float v[8];
#pragma unroll
      for (int e = 0; e < 8; ++e) {
        int k = kb + e;
        if (k < S) { int m = (row * k) & (S - 1); v[e] = __builtin_amdgcn_cosf((float)m * invS); }
        else { int m = (row * (k - S)) & (S - 1); v[e] = -__builtin_amdgcn_sinf((float)m * invS); }
      }
      *(uint4*)(dst + idx) = pack8(v);
    }
  }
}

DI void mod_store_h(const Params& p, int t, int lane, int cv, int l, int off_scale, int off_shift, float (&y)[16]) {
  const float* mod = (const float*)(p.ws + OFF_MOD) + (size_t)(l * 5 + cv) * 6144;
  float sc[16], sh[16];
  load_row(mod + off_scale * 1024, lane, sc);
  load_row(mod + off_shift * 1024, lane, sh);
#pragma unroll
  for (int i = 0; i < 16; ++i) y[i] = y[i] * (1.f + sc[i]) + sh[i];
  store_row_bf((bf16_t*)(p.ws + OFF_H) + (size_t)t * 1024, lane, y);
}

DI float pos_embed(int n, int c) {
  int pos = (c < 512) ? (n >> 6) : (n & 63);
  int cc = c & 511, i = cc & 255;
  float om = exp2f(-(float)i * (13.287712379549449f / 256.f));
  float rev = (float)pos * om * 0.15915494309189535f;
  return cc < 256 ? __builtin_amdgcn_sinf(rev) : __builtin_amdgcn_cosf(rev);
}

DI void phase_init(const Params& p, int bid, int nb) {
  const int lane = tidx() & 63, wave = tidx() >> 6;
  float sc[16], sh[16];
  int cvl = -1;
  for (int t = bid * 4 + wave; t < T; t += nb * 4) {
    int seq, s, S, cv; tok_info(t, seq, s, S, cv);
    if (cv != cvl) {
      const float* mod = (const float*)(p.ws + OFF_MOD) + (size_t)cv * 6144;
      load_row(mod + 1024, lane, sc); load_row(mod, lane, sh);
      cvl = cv;
    }
    float y[16];
    const float* src = (t < 4096) ? p.in[I_XP] + (size_t)t * 1024 : p.in[I_XS] + (size_t)(t - 4096) * 1024;
    load_row(src, lane, y);
    if (t >= 4096) {
#pragma unroll
      for (int i = 0; i < 16; ++i) { int c = (i < 8) ? lane * 8 + i : 512 + lane * 8 + (i - 8); y[i] += pos_embed(s, c); }
    }
    store_row((float*)(p.ws + OFF_X) + (size_t)t * 1024, lane, y);
    ln16(y);
#pragma unroll
    for (int i = 0; i < 16; ++i) y[i] = y[i] * (1.f + sc[i]) + sh[i];
    store_row_bf((bf16_t*)(p.ws + OFF_H) + (size_t)t * 1024, lane, y);
  }
}

constexpr float U_SCALE = 32.f;
DI void convert_tables(const Params& p, int l, int bid, int nb) {
  const size_t n16 = (size_t)16384 * 1024 / 16;
  for (int tb = 0; tb < 2; ++tb) {
    const float* src = p.in[tb ? I_PV : I_PU] + (size_t)l * 16384 * 1024;
    uint4* dst = (uint4*)(p.ws + (tb ? OFF_TABV : OFF_TABU));
    const float sc = tb ? 1.f : U_SCALE;
    for (size_t i = (size_t)bid * NTHR + tidx(); i < n16; i += (size_t)nb * NTHR) {
      const float4* s4 = (const float4*)(src + i * 16);
      float4 a = s4[0], b = s4[1], c = s4[2], d = s4[3];
      uint4 o;
      o.x = pk_fp8x4(a.x * sc, a.y * sc, a.z * sc, a.w * sc); o.y = pk_fp8x4(b.x * sc, b.y * sc, b.z * sc, b.w * sc);
      o.z = pk_fp8x4(c.x * sc, c.y * sc, c.z * sc, c.w * sc); o.w = pk_fp8x4(d.x * sc, d.y * sc, d.z * sc, d.w * sc);
      dst[i] = o;
    }
  }
}

DI void phase_e1(const Params& p, unsigned char* smem, int l, int bid, int nb) {
  const int j = l >> 1;
  bf16_t* As = (bf16_t*)smem; bf16_t* Bs = As + 128 * LDT;
  const bf16_t* H = (const bf16_t*)(p.ws + OFF_H);
  const bf16_t* Bt = (const bf16_t*)(p.ws + OFF_BT_IN_E) + (size_t)j * 2560 * 1024;
  bf16_t* PQT = (bf16_t*)(p.ws + OFF_Z);
  bf16_t* ZC = (bf16_t*)(p.ws + OFF_Z + 40 * MiB);
  for (int it = bid; it < 160 * 20; it += nb) {
    const int mt = it / 20, nt = it % 20, t0 = mt * 128;
    f32x16 acc[2][2];
    if (nt < 8) {
      gemm_mainloop<true>(H + (size_t)t0 * 1024, 1024, Bt + (size_t)nt * 128 * 1024, 1024, 1024, acc, As, Bs);
      int seq, s0, S, cv; tok_info(t0, seq, s0, S, cv);
      bf16_t* base = PQT + pqt_base(seq);
      const int S2 = 2 * S;
      gemm_epilogue<true>(acc, [&](int m, int n, float v) {
        int ng = nt * 128 + n; int which = ng >> 9, ch = ng & 511;
        base[(size_t)ch * S2 + which * S + s0 + m] = (bf16_t)f2bf(v);
      });
    } else {
      gemm_mainloop<false>(H + (size_t)t0 * 1024, 1024, Bt + (size_t)nt * 128 * 1024, 1024, 1024, acc, As, Bs);
      gemm_epilogue<false>(acc, [&](int m, int n, float v) {
        ZC[(size_t)(t0 + m) * 1536 + (nt - 8) * 128 + n] = (bf16_t)f2bf(v);
      });
    }
  }
  convert_tables(p, l, bid, nb);
}

DI void phase_e2(const Params& p, unsigned char* smem, int l, int bid, int nb) {
  const int j = l >> 1;
  bf16_t* As = (bf16_t*)smem; bf16_t* Bs = As + 128 * LDT;
  const bf16_t* PQT = (const bf16_t*)(p.ws + OFF_Z);
  const bf16_t* ZC = (const bf16_t*)(p.ws + OFF_Z + 40 * MiB);
  bf16_t* YM = (bf16_t*)(p.ws + OFF_YMIX);
  for (int it = bid; it < 640 + 1280; it += nb) {
    if (it < 640) {
      int seq, mt, nt, S, t0; const bf16_t* A;
      if (it < 512) { seq = 16 + it / 128; int r = it % 128; mt = r >> 2; nt = r & 3; S = 4096; A = (const bf16_t*)(p.ws + OFF_D4096) + (size_t)mt * 128 * 8192; t0 = 4096 + (seq - 16) * 4096 + mt * 128; }
      else { int r = it - 512; seq = r >> 3; mt = (r & 7) >> 2; nt = r & 3; S = 256; A = (const bf16_t*)(p.ws + OFF_D256) + (size_t)mt * 128 * 512; t0 = seq * 256 + mt * 128; }
      const bf16_t* B = PQT + pqt_base(seq) + (size_t)nt * 128 * (2 * S);
      f32x16 acc[2][2];
      gemm_mainloop<false>(A, 2 * S, B, 2 * S, 2 * S, acc, As, Bs);
      const float scale = rsqrtf(128.f * (float)S);
      gemm_epilogue<false>(acc, [&](int m, int n, float v) {
        YM[(size_t)(t0 + m) * 1024 + nt * 128 + n] = (bf16_t)f2bf(v * scale);
      });
    } else {
      const int t0 = (it - 640) * 16, c = tidx() * 2;
      int seq, s0, S, cv; tok_info(t0, seq, s0, S, cv);
      const float* cw = p.in[I_SCW] + (size_t)j * 3 * 512;
      const float w0a = cw[c], w0b = cw[c + 1], w1a = cw[512 + c], w1b = cw[512 + c + 1], w2a = cw[1024 + c], w2b = cw[1024 + c + 1];
      const float ba = p.in[I_SCB][j * 512 + c], bb = p.in[I_SCB][j * 512 + c + 1];
      auto uval = [&](int t, float& ua, float& ub) {
        unsigned cg_ = *(const unsigned*)(ZC + (size_t)t * 1536 + 512 + c);
        unsigned xi = *(const unsigned*)(ZC + (size_t)t * 1536 + 1024 + c);
        ua = bflo(cg_) * bflo(xi); ub = bfhi(cg_) * bfhi(xi);
      };
      float pa = 0.f, pb = 0.f, ca, cb, na, nb_;
      if (s0 > 0) uval(t0 - 1, pa, pb);
      uval(t0, ca, cb);
      for (int i = 0; i < 16; ++i) {
        const int t = t0 + i;
        na = 0.f; nb_ = 0.f;
        if (s0 + i + 1 < S) uval(t + 1, na, nb_);
        unsigned bg = *(const unsigned*)(ZC + (size_t)t * 1536 + c);
        float ya = bflo(bg) * (w0a * pa + w1a * ca + w2a * na + ba);
        float yb = bfhi(bg) * (w0b * pb + w1b * cb + w2b * nb_ + bb);
        *(unsigned*)(YM + (size_t)t * 1024 + 512 + c) = pack2(ya, yb);
        pa = ca; pb = cb; ca = na; cb = nb_;
      }
    }
  }
}

DI void phase_outgemm(const Params& p, unsigned char* smem, const bf16_t* Bt, int bid, int nb) {
  bf16_t* As = (bf16_t*)smem; bf16_t* Bs = As + 128 * LDT;
  const bf16_t* YM = (const bf16_t*)(p.ws + OFF_YMIX);
  float* MIX = (float*)(p.ws + OFF_MIX);
  for (int it = bid; it < 160 * 8; it += nb) {
    const int mt = it >> 3, nt = it & 7, t0 = mt * 128;
    f32x16 acc[2][2];
    gemm_mainloop<false>(YM + (size_t)t0 * 1024, 1024, Bt + (size_t)nt * 128 * 1024, 1024, 1024, acc, As, Bs);
    gemm_epilogue<false>(acc, [&](int m, int n, float v) { MIX[(size_t)(t0 + m) * 1024 + nt * 128 + n] = v; });
  }
}

DI void phase_res1(const Params& p, int l, int bid, int nb) {
  const int lane = tidx() & 63, wave = tidx() >> 6;
  float* X = (float*)(p.ws + OFF_X);
  const float* MIX = (const float*)(p.ws + OFF_MIX);
  float lg[16], lb[16], g1[16], sc[16], sh[16];
  load_row(p.in[I_LN1G] + l * 1024, lane, lg);
  load_row(p.in[I_LN1B] + l * 1024, lane, lb);
  int cvl = -1;
  for (int t = bid * 4 + wave; t < T; t += nb * 4) {
    int seq, s, S, cv; tok_info(t, seq, s, S, cv);
    if (cv != cvl) {
      const float* mod = (const float*)(p.ws + OFF_MOD) + (size_t)(l * 5 + cv) * 6144;
      load_row(mod + 2 * 1024, lane, g1); load_row(mod + 4 * 1024, lane, sc); load_row(mod + 3 * 1024, lane, sh);
      cvl = cv;
    }
    float x[16], m[16];
    load_row(X + (size_t)t * 1024, lane, x);
    load_row(MIX + (size_t)t * 1024, lane, m);
#pragma unroll
    for (int i = 0; i < 16; ++i) x[i] = ALPHA_F * x[i] + g1[i] * m[i];
    ln16(x);
#pragma unroll
    for (int i = 0; i < 16; ++i) x[i] = x[i] * lg[i] + lb[i];
    store_row(X + (size_t)t * 1024, lane, x);
    ln16(x);
#pragma unroll
    for (int i = 0; i < 16; ++i) x[i] = x[i] * (1.f + sc[i]) + sh[i];
    store_row_bf((bf16_t*)(p.ws + OFF_H) + (size_t)t * 1024, lane, x);
  }
}

DI void insert16(float (&tv)[16], int (&ti)[16], float x, int xi) {
#pragma unroll
  for (int k = 0; k < 16; ++k) {
    bool gt = x > tv[k];
    float ov = tv[k]; int oi = ti[k];
    tv[k] = gt ? x : ov; ti[k] = gt ? xi : oi;
    x = gt ? ov : x; xi = gt ? oi : xi;
  }
}
DI void phase_p1(const Params& p, unsigned char* smem, int l, int bid, int nb) {
  const int tid = tidx(), lane = tid & 63, wave = tid >> 6;
  const int wm = wave >> 1, wn = wave & 1;
  bf16_t* As = (bf16_t*)smem; bf16_t* Bs = As + 128 * LDT;
  bf16_t* Qs = (bf16_t*)smem;
  bf16_t* Ks = (bf16_t*)(smem + 36864);
  float* Sc = (float*)smem;
  float* Lv = (float*)smem;
  int* Li = (int*)(smem + 8192);
  const bf16_t* H = (const bf16_t*)(p.ws + OFF_H);
  const bf16_t* Bt = (const bf16_t*)(p.ws + OFF_BT_WQ) + (size_t)l * 2048 * 1024;
  float* TKV = (float*)(p.ws + OFF_WD);
  int* TKI = (int*)(p.ws + OFF_WD + 20 * MiB);
  for (int it = bid; it < 160 * 16; it += nb) {
    const int mt = it >> 4, hp = it & 15, t0 = mt * 128;
    f32x16 acc[2][2];
    gemm_mainloop<false>(H + (size_t)t0 * 1024, 1024, Bt + (size_t)hp * 128 * 1024, 1024, 1024, acc, As, Bs);
    {
      const float* kp = p.in[I_KEYS] + (size_t)(l * 16 + hp) * 16384;
#pragma unroll 4
      for (int i = 0; i < 16; ++i) {
        int idx = i * 256 + tid;
        int row = idx >> 5, c4 = idx & 31;
        float4 v = *(const float4*)(kp + row * 128 + c4 * 4);
        uint2 u; u.x = pack2(v.x, v.y); u.y = pack2(v.z, v.w);
        *(uint2*)(Ks + row * 136 + c4 * 4) = u;
      }
    }
    __syncthreads();
    gemm_epilogue<false>(acc, [&](int m, int n, float v) { Qs[m * 136 + n] = (bf16_t)f2bf(v); });
    __syncthreads();
#pragma unroll
    for (int mi = 0; mi < 2; ++mi)
#pragma unroll
      for (int ni = 0; ni < 2; ++ni)
#pragma unroll
        for (int r = 0; r < 16; ++r) acc[mi][ni][r] = 0.f;
    {
      const int fr = (lane & 31) * 136 + (lane >> 5) * 8;
#pragma unroll
      for (int kk = 0; kk < 8; ++kk) {
        bf16x8 af[2], bfr[2];
#pragma unroll
        for (int mi = 0; mi < 2; ++mi) af[mi] = *(const bf16x8*)(Qs + (wm * 64 + mi * 32) * 136 + fr + kk * 16);
#pragma unroll
        for (int ni = 0; ni < 2; ++ni) bfr[ni] = *(const bf16x8*)(Ks + (wn * 64 + ni * 32) * 136 + fr + kk * 16);
#pragma unroll
        for (int mi = 0; mi < 2; ++mi)
#pragma unroll
          for (int ni = 0; ni < 2; ++ni) acc[mi][ni] = MFMA(af[mi], bfr[ni], acc[mi][ni]);
      }
    }
    __syncthreads();
    gemm_epilogue<false>(acc, [&](int m, int n, float v) { Sc[m * 129 + n] = v; });
    __syncthreads();
    const int row = tid & 127, half = tid >> 7;
    float tv[16]; int ti[16];
#pragma unroll
    for (int k = 0; k < 16; ++k) { tv[k] = -3.0e38f; ti[k] = 0; }
    for (int e = 0; e < 64; ++e) insert16(tv, ti, Sc[row * 129 + half * 64 + e], half * 64 + e);
    __syncthreads();
    if (half == 1) {
#pragma unroll
      for (int k = 0; k < 16; ++k) { Lv[k * 128 + row] = tv[k]; Li[k * 128 + row] = ti[k]; }
    }
    __syncthreads();
    if (half == 0) {
#pragma unroll
      for (int k = 0; k < 16; ++k) insert16(tv, ti, Lv[k * 128 + row], Li[k * 128 + row]);
      float* ov = TKV + ((size_t)(t0 + row) * 16 + hp) * 16;
      int* oi = TKI + ((size_t)(t0 + row) * 16 + hp) * 16;
#pragma unroll
      for (int k = 0; k < 16; k += 4) {
        *(float4*)(ov + k) = make_float4(tv[k], tv[k + 1], tv[k + 2], tv[k + 3]);
        *(int4*)(oi + k) = make_int4(ti[k], ti[k + 1], ti[k + 2], ti[k + 3]);
      }
    }
  }
}

DI void phase_p2(const Params& p, unsigned char* smem, int l, int bid, int nb) {
  const int lane = tidx() & 63, wave = tidx() >> 6;
  int* sIdx = (int*)(smem + wave * 1024);
  float* sSc = (float*)(smem + wave * 1024 + 512);
  const bf16_t* H = (const bf16_t*)(p.ws + OFF_H);
  const float* TKV = (const float*)(p.ws + OFF_WD);
  const int* TKI = (const int*)(p.ws + OFF_WD + 20 * MiB);
  const bf16_t* TU = (const bf16_t*)(p.ws + OFF_TABU);
  const bf16_t* TV = (const bf16_t*)(p.ws + OFF_TABV);
  float* X = (float*)(p.ws + OFF_X);
  int ci = 0, cj = 0;
  {
    int q = lane;
    if (q < 16) { ci = 0; cj = q; } else if (q < 24) { ci = 1; cj = q - 16; } else if (q < 29) { ci = 2; cj = q - 24; }
    else if (q < 33) { ci = 3; cj = q - 29; } else if (q < 36) { ci = 4; cj = q - 33; }
    else if (q < 42) { ci = 5 + ((q - 36) >> 1); cj = (q - 36) & 1; } else if (q < 50) { ci = 8 + (q - 42); cj = 0; }
  }
  float plg[16], plb[16], pg2[16];
  load_row16(p.in[I_LN2G] + l * 1024, lane, plg);
  load_row16(p.in[I_LN2B] + l * 1024, lane, plb);
  int cvl = -1;
  for (int t = bid * 4 + wave; t < T; t += nb * 4) {
    int seq, s, S, cv; tok_info(t, seq, s, S, cv);
    float hreg[16];
    {
      const uint4* hp_ = (const uint4*)(H + (size_t)t * 1024 + lane * 16);
      uint4 a = hp_[0], b = hp_[1];
      float v0[8], v1[8]; unpack8(a, v0); unpack8(b, v1);
#pragma unroll
      for (int i = 0; i < 8; ++i) { hreg[i] = v0[i]; hreg[8 + i] = v1[i]; }
    }
    __builtin_amdgcn_wave_barrier();
    for (int h = 0; h < 8; ++h) {
      const float* v1p = TKV + ((size_t)t * 16 + h * 2) * 16;
      const int* i1p = TKI + ((size_t)t * 16 + h * 2) * 16;
      float c = -3.0e38f; int eidx = 0;
      if (lane < 50) { c = v1p[ci] + v1p[16 + cj]; eidx = i1p[ci] * 128 + i1p[16 + cj]; }
      int rank = 0;
#pragma unroll 5
      for (int m = 0; m < 50; ++m) {
        float cm = __int_as_float(__builtin_amdgcn_readlane(__float_as_int(c), m));
        rank += (cm > c || (cm == c && m < lane)) ? 1 : 0;
      }
      if (lane < 50 && rank < 16) { sIdx[h * 16 + rank] = eidx; sSc[h * 16 + rank] = c; }
    }
    __builtin_amdgcn_wave_barrier();
    {
      float s0 = sSc[lane], s1 = sSc[64 + lane];
      float m0 = max16(s0), m1 = max16(s1);
      float e0 = __expf(s0 - m0), e1 = __expf(s1 - m1);
      float d0 = sum16(e0), d1 = sum16(e1);
      __builtin_amdgcn_wave_barrier();
      sSc[lane] = e0 / d0; sSc[64 + lane] = e1 / d1;
    }
    __builtin_amdgcn_wave_barrier();
    float out[16];
#pragma unroll
    for (int i = 0; i < 16; ++i) out[i] = 0.f;
    const unsigned char* TU8 = (const unsigned char*)TU;
    const unsigned char* TV8 = (const unsigned char*)TV;
    for (int sb = 0; sb < 128; sb += 8) {
      uint4 u[8], w[8]; float gt[8];
#pragma unroll
      for (int k = 0; k < 8; ++k) {
        int e = __builtin_amdgcn_readfirstlane(sIdx[sb + k]);
        gt[k] = sSc[sb + k];
        u[k] = *(const uint4*)(TU8 + (size_t)e * 1024 + lane * 16);
        w[k] = *(const uint4*)(TV8 + (size_t)e * 1024 + lane * 16);
      }
      float dot[8];
#pragma unroll
      for (int k = 0; k < 8; ++k) {
        float a[16]; unpack_fp8x16(u[k], a);
        float d = 0.f;
#pragma unroll
        for (int i = 0; i < 16; ++i) d += hreg[i] * a[i];
        dot[k] = d;
      }
#pragma unroll
      for (int k = 0; k < 8; ++k) dot[k] = wave_sum(dot[k]);
#pragma unroll
      for (int k = 0; k < 8; ++k) {
        float wgt = gt[k] * gelu_t(dot[k] * (1.f / U_SCALE));
        float a[16]; unpack_fp8x16(w[k], a);
#pragma unroll
        for (int i = 0; i < 16; ++i) out[i] += wgt * a[i];
      }
    }
    if (cv != cvl) {
      const float* mod = (const float*)(p.ws + OFF_MOD) + (size_t)(l * 5 + cv) * 6144;
      load_row16(mod + 5 * 1024, lane, pg2);
      cvl = cv;
    }
    float x[16];
    load_row16(X + (size_t)t * 1024, lane, x);
#pragma unroll
    for (int i = 0; i < 16; ++i) x[i] = ALPHA_F * x[i] + pg2[i] * out[i];
    ln16(x);
#pragma unroll
    for (int i = 0; i < 16; ++i) x[i] = x[i] * plg[i] + plb[i];
    if (l == 3) {
      store_row16(p.out + (size_t)t * 1024, lane, x);
    } else {
      store_row16(X + (size_t)t * 1024, lane, x);
      ln16(x);
      {
        float psc[16], psh[16];
        const float* modn = (const float*)(p.ws + OFF_MOD) + (size_t)((l + 1) * 5 + cv) * 6144;
        load_row16(modn + 1024, lane, psc); load_row16(modn, lane, psh);
#pragma unroll
        for (int i = 0; i < 16; ++i) x[i] = x[i] * (1.f + psc[i]) + psh[i];
      }
      store_row16_bf((bf16_t*)(p.ws + OFF_H) + (size_t)t * 1024, lane, x);
    }
  }
}

DI void phase_o1(const Params& p, unsigned char* smem, int l, int bid, int nb) {
  const int j = l >> 1;
  bf16_t* As = (bf16_t*)smem; bf16_t* Bs = As + 128 * LDT;
  const bf16_t* H = (const bf16_t*)(p.ws + OFF_H);
  const bf16_t* Bt = (const bf16_t*)(p.ws + OFF_BT_IN_O) + (size_t)j * 2944 * 1024;
  bf16_t* Z = (bf16_t*)(p.ws + OFF_Z);
  for (int it = bid; it < 160 * 23; it += nb) {
    const int mt = it / 23, nt = it % 23, t0 = mt * 128;
    f32x16 acc[2][2];
    gemm_mainloop<false>(H + (size_t)t0 * 1024, 1024, Bt + (size_t)nt * 128 * 1024, 1024, 1024, acc, As, Bs);
    gemm_epilogue<false>(acc, [&](int m, int n, float v) { Z[(size_t)(t0 + m) * 2944 + nt * 128 + n] = (bf16_t)f2bf(v); });
  }
  convert_tables(p, l, bid, nb);
}

DI void phase_o2(const Params& p, int l, int bid, int nb) {
  const int j = l >> 1;
  const int lane = tidx() & 63, wave = tidx() >> 6;
  const bf16_t* Z = (const bf16_t*)(p.ws + OFF_Z);
  bf16_t* XC = (bf16_t*)(p.ws + OFF_XC);
  bf16_t* LRIN = (bf16_t*)(p.ws + OFF_LRIN);
  bf16_t* KKN = (bf16_t*)(p.ws + OFF_KKN);
  bf16_t* KS = (bf16_t*)(p.ws + OFF_KS);
  bf16_t* RS = (bf16_t*)(p.ws + OFF_RS);
  bf16_t* VS = (bf16_t*)(p.ws + OFF_VS);
  const float* mu = p.in[I_MU] + (size_t)j * 1920;
  const int c0 = lane * 8;
  for (int t = bid * 4 + wave; t < T; t += nb * 4) {
    int seq, s, S, cv; tok_info(t, seq, s, S, cv);
    const bf16_t* zr = Z + (size_t)t * 2944;
    {
      float af[8], ab[8];
      load8f(p.in[I_LCB] + (size_t)(j * 2 + 0) * 512 + c0, af);
      load8f(p.in[I_LCB] + (size_t)(j * 2 + 1) * 512 + c0, ab);
#pragma unroll
      for (int o = -3; o <= 3; ++o) {
        float xv[8];
        if (s + o >= 0 && s + o < S) { uint4 u = *(const uint4*)(zr + (ptrdiff_t)o * 2944 + c0); unpack8(u, xv); }
        else {
#pragma unroll
          for (int i = 0; i < 8; ++i) xv[i] = 0.f;
        }
        if (o <= 0) {
          float w[8]; load8f(p.in[I_LCW] + ((size_t)(j * 2 + 0) * 4 + (o + 3)) * 512 + c0, w);
#pragma unroll
          for (int i = 0; i < 8; ++i) af[i] += w[i] * xv[i];
        }
        if (o >= 0) {
          float w[8]; load8f(p.in[I_LCW] + ((size_t)(j * 2 + 1) * 4 + (3 - o)) * 512 + c0, w);
#pragma unroll
          for (int i = 0; i < 8; ++i) ab[i] += w[i] * xv[i];
        }
      }
      *(uint4*)(XC + (size_t)t * 512 + c0) = pack8(af);
      *(uint4*)(XC + (size_t)T * 512 + (size_t)t * 512 + c0) = pack8(ab);
    }
    const bool hp_ = s > 0, hn = s < S - 1;
#pragma unroll
    for (int part = 0; part < 3; ++part) {
      const int col = 1024 + part * 512 + c0;
      float zc[8], zp[8], zn[8], m[8], zs[8];
      unpack8(*(const uint4*)(zr + col), zc);
      if (hp_) unpack8(*(const uint4*)(zr - 2944 + col), zp); else {
#pragma unroll
        for (int i = 0; i < 8; ++i) zp[i] = 0.f;
      }
      if (hn) unpack8(*(const uint4*)(zr + 2944 + col), zn); else {
#pragma unroll
        for (int i = 0; i < 8; ++i) zn[i] = 0.f;
      }
      load8f(mu + (col - 1024), m);
#pragma unroll
      for (int i = 0; i < 8; ++i) zs[i] = zc[i] + m[i] * (0.5f * (zp[i] + zn[i]) - zc[i]);
      if (part == 0) *(uint4*)(RS + (size_t)t * 512 + c0) = pack8(zs);
      else if (part == 2) *(uint4*)(VS + (size_t)t * 512 + c0) = pack8(zs);
      else {
        *(uint4*)(KS + (size_t)t * 512 + c0) = pack8(zs);
#pragma unroll
        for (int d = 0; d < 2; ++d) {
          float kk[8], raw[8]; load8f(p.in[I_KK] + (size_t)(j * 2 + d) * 512 + c0, kk);
          float ss = 0.f;
#pragma unroll
          for (int i = 0; i < 8; ++i) { raw[i] = zs[i] * kk[i]; ss += raw[i] * raw[i]; }
          ss = sum8(ss);
          float inv = rsqrtf(fmaxf(ss, 1e-24f));
#pragma unroll
          for (int i = 0; i < 8; ++i) raw[i] *= inv;
          *(uint4*)(KKN + (size_t)d * T * 512 + (size_t)t * 512 + c0) = pack8(raw);
        }
      }
    }
    if (lane < 48) {
      const int col = 2560 + c0;
      float zc[8], zp[8], zn[8], m[8], zs[8];
      unpack8(*(const uint4*)(zr + col), zc);
      if (hp_) unpack8(*(const uint4*)(zr - 2944 + col), zp); else {
#pragma unroll
        for (int i = 0; i < 8; ++i) zp[i] = 0.f;
      }
      if (hn) unpack8(*(const uint4*)(zr + 2944 + col), zn); else {
#pragma unroll
        for (int i = 0; i < 8; ++i) zn[i] = 0.f;
      }
      load8f(mu + (col - 1024), m);
#pragma unroll
      for (int i = 0; i < 8; ++i) {
        float z = zc[i] + m[i] * (0.5f * (zp[i] + zn[i]) - zc[i]);
        zs[i] = (lane < 16) ? tanh_f(z) : ((lane < 32) ? z : sigm(z));
      }
      *(uint4*)(LRIN + (size_t)t * 384 + c0) = pack8(zs);
    }
  }
}

DI void store8f(float* p, const float (&v)[8]) {
  ((float4*)p)[0] = make_float4(v[0], v[1], v[2], v[3]);
  ((float4*)p)[1] = make_float4(v[4], v[5], v[6], v[7]);
}
template <class F>
DI void staged_epilogue(const f32x16 (&acc)[2][2], float* Cs, F f) {
  __syncthreads();
  gemm_epilogue<false, false>(acc, [&](int m, int n, float v) { Cs[m * 132 + n] = v; });
  __syncthreads();
  const int tid = tidx(), r0 = tid >> 4, c8 = (tid & 15) * 8;
#pragma unroll 2
  for (int ps = 0; ps < 8; ++ps) {
    const int row = ps * 16 + r0;
    float v[8];
    load8f(Cs + row * 132 + c8, v);
    f(row, c8, v);
  }
}

DI void phase_o3(const Params& p, unsigned char* smem, int l, int bid, int nb) {
  const int j = l >> 1;
  bf16_t* As = (bf16_t*)smem; bf16_t* Bs = As + 128 * LDT;
  float* Cs = (float*)smem;
  const bf16_t* __restrict__ XC = (const bf16_t*)(p.ws + OFF_XC);
  const bf16_t* __restrict__ LRIN = (const bf16_t*)(p.ws + OFF_LRIN);
  const bf16_t* __restrict__ KKN = (const bf16_t*)(p.ws + OFF_KKN);
  const bf16_t* __restrict__ KS = (const bf16_t*)(p.ws + OFF_KS);
  float* __restrict__ LA = (float*)(p.ws + OFF_MIX);
  bf16_t* __restrict__ LB = (bf16_t*)(p.ws + OFF_LB);
  float* __restrict__ WD = (float*)(p.ws + OFF_WD);
  bf16_t* __restrict__ KKA = (bf16_t*)(p.ws + OFF_KKA);
  bf16_t* __restrict__ KM = (bf16_t*)(p.ws + OFF_KM);
  bf16_t* __restrict__ G = (bf16_t*)(p.ws + OFF_G);
  const int c8 = (tidx() & 15) * 8;
  for (int it = bid; it < 160 * 28; it += nb) {
    const int mt = it / 28, jb = it % 28, t0 = mt * 128;
    if (jb < 8) {
      const int d = jb >> 2, nt = jb & 3, ng = nt * 128 + c8;
      const bf16_t* A = XC + (size_t)d * T * 512 + (size_t)t0 * 512 + nt * 128;
      const bf16_t* Br = (const bf16_t*)(p.ws + OFF_BT_GATE) + ((size_t)((j * 2 + d) * 2 + 0) * 512 + nt * 128) * 128;
      const bf16_t* Bi = (const bf16_t*)(p.ws + OFF_BT_GATE) + ((size_t)((j * 2 + d) * 2 + 1) * 512 + nt * 128) * 128;
      float ba8[8], bx8[8], sp8[8];
      load8f(p.in[I_LBA] + (size_t)(j * 2 + d) * 512 + ng, ba8);
      load8f(p.in[I_LBX] + (size_t)(j * 2 + d) * 512 + ng, bx8);
      load8f(p.in[I_LLAM] + (size_t)(j * 2 + d) * 512 + ng, sp8);
#pragma unroll
      for (int i = 0; i < 8; ++i) { float nl = -sp8[i]; sp8[i] = -8.f * (nl > 20.f ? nl : log1pf(__expf(nl))); }
      {
        f32x16 acc[2][2];
        gemm_mainloop<false>(A, 512, Br, 128, 128, acc, As, Bs);
        staged_epilogue(acc, Cs, [&](int row, int cc, const float (&v)[8]) {
          const size_t o = ((size_t)d * T + t0 + row) * 512 + nt * 128 + cc;
          float a[8];
#pragma unroll
          for (int i = 0; i < 8; ++i) a[i] = __expf(sigm(v[i] + ba8[i]) * sp8[i]);
          store8f(LA + o, a);
        });
      }
      {
        f32x16 acc[2][2];
        gemm_mainloop<false>(A, 512, Bi, 128, 128, acc, As, Bs);
        staged_epilogue(acc, Cs, [&](int row, int cc, const float (&v)[8]) {
          const size_t o = ((size_t)d * T + t0 + row) * 512 + nt * 128 + cc;
          float a[8], xc[8], bb[8];
          load8f(LA + o, a);
          unpack8(*(const uint4*)(XC + o), xc);
#pragma unroll
          for (int i = 0; i < 8; ++i) bb[i] = sqrtf(fmaxf(1.f - a[i] * a[i], 0.f)) * sigm(v[i] + bx8[i]) * xc[i];
          *(uint4*)(LB + o) = pack8(bb);
        });
      }
    } else if (jb < 16) {
      const int d = (jb - 8) >> 2, nt = (jb - 8) & 3, ng = nt * 128 + c8;
      float w08[8]; load8f(p.in[I_W0] + (size_t)(j * 2 + d) * 512 + ng, w08);
      f32x16 acc[2][2];
      gemm_mainloop<false>(LRIN + (size_t)t0 * 384 + d * 64, 384, (const bf16_t*)(p.ws + OFF_BT_W2) + ((size_t)(j * 2 + d) * 512 + nt * 128) * 64, 64, 64, acc, As, Bs);
      staged_epilogue(acc, Cs, [&](int row, int cc, const float (&v)[8]) {
        float w[8];
#pragma unroll
        for (int i = 0; i < 8; ++i) w[i] = __expf(-0.6065306597126334f * sigm(w08[i] + v[i]));
        store8f(WD + ((size_t)d * T + t0 + row) * 512 + nt * 128 + cc, w);
      });
    } else if (jb < 24) {
      const int d = (jb - 16) >> 2, nt = (jb - 16) & 3, ng = nt * 128 + c8;
      float a08[8], ka8[8];
      load8f(p.in[I_A0] + (size_t)(j * 2 + d) * 512 + ng, a08);
      load8f(p.in[I_KA] + (size_t)(j * 2 + d) * 512 + ng, ka8);
      f32x16 acc[2][2];
      gemm_mainloop<false>(LRIN + (size_t)t0 * 384 + 128 + d * 64, 384, (const bf16_t*)(p.ws + OFF_BT_A2) + ((size_t)(j * 2 + d) * 512 + nt * 128) * 64, 64, 64, acc, As, Bs);
      staged_epilogue(acc, Cs, [&](int row, int cc, const float (&v)[8]) {
        const size_t o = ((size_t)d * T + t0 + row) * 512 + nt * 128 + cc;
        float kkn[8], ks[8], oa[8], om[8];
        unpack8(*(const uint4*)(KKN + o), kkn);
        unpack8(*(const uint4*)(KS + (size_t)(t0 + row) * 512 + nt * 128 + cc), ks);
#pragma unroll
        for (int i = 0; i < 8; ++i) {
          float ic = sigm(a08[i] + v[i]);
          oa[i] = kkn[i] * ic;
          om[i] = ks[i] * (1.f + (ic - 1.f) * ka8[i]);
        }
        *(uint4*)(KKA + o) = pack8(oa);
        *(uint4*)(KM + o) = pack8(om);
      });
    } else {
      const int nt = jb - 24;
      f32x16 acc[2][2];
      gemm_mainloop<false>(LRIN + (size_t)t0 * 384 + 256, 384, (const bf16_t*)(p.ws + OFF_BT_G2) + ((size_t)j * 512 + nt * 128) * 128, 128, 128, acc, As, Bs);
      staged_epilogue(acc, Cs, [&](int row, int cc, const float (&v)[8]) {
        float g[8];
#pragma unroll
        for (int i = 0; i < 8; ++i) g[i] = v[i];
        *(uint4*)(G + (size_t)(t0 + row) * 512 + nt * 128 + cc) = pack8(g);
      });
    }
  }
}

constexpr int WCH = 32;
constexpr int WBUF = 8192 + 4 * 4096 + 1024;
DI void wkv_scan_item(const Params& p, unsigned char* smem, int j, int b, int d, int h, int rg, bool ctx) {
  const int tid = tidx(), lane = tid & 63, wave = tid >> 6;
  const int rl = wave * 4 + (lane >> 4), row = rg * 16 + rl, q = lane & 15;
  const int S = ctx ? 256 : 4096, t0 = ctx ? b * 256 : 4096 + b * 4096;
  const char* WD = (const char*)(p.ws + OFF_WD) + (size_t)d * T * 512 * 4 + h * 256;
  const char* KKN = (const char*)(p.ws + OFF_KKN) + (size_t)d * T * 512 * 2 + h * 128;
  const char* KKA = (const char*)(p.ws + OFF_KKA) + (size_t)d * T * 512 * 2 + h * 128;
  const char* KM = (const char*)(p.ws + OFF_KM) + (size_t)d * T * 512 * 2 + h * 128;
  const char* RS = (const char*)(p.ws + OFF_RS) + h * 128;
  const char* VS = (const char*)(p.ws + OFF_VS) + (h * 64 + rg * 16) * 2;
  char* Y = (char*)(p.ws + (d ? OFF_XC : OFF_H)) + (h * 64 + rg * 16) * 4;
  unsigned char* ysb = smem + 2 * WBUF;
  float st[4];
  if (ctx) { st[0] = st[1] = st[2] = st[3] = 0.f; }
  else {
    float4 s4 = *(const float4*)(p.in[I_SWKV] + ((((size_t)(b * 2 + j) * 2 + d) * 8 + h) * 64 + row) * 64 + q * 4);
    st[0] = s4.x; st[1] = s4.y; st[2] = s4.z; st[3] = s4.w;
  }
  auto tokof = [&](int step) -> int { return t0 + (d ? (S - 1 - step) : step); };
  uint4 gw0, gw1, gk, gka, gkm, gr, gv;
  auto gload = [&](int c) {
    const int base = c * WCH;
    { int i0 = tid, i1 = tid + 256;
      gw0 = *(const uint4*)(WD + (unsigned)(tokof(base + (i0 >> 4)) * 2048 + (i0 & 15) * 16));
      gw1 = *(const uint4*)(WD + (unsigned)(tokof(base + (i1 >> 4)) * 2048 + (i1 & 15) * 16)); }
    const unsigned o2 = (unsigned)(tokof(base + (tid >> 3)) * 1024 + (tid & 7) * 16);
    gk = *(const uint4*)(KKN + o2); gka = *(const uint4*)(KKA + o2); gkm = *(const uint4*)(KM + o2); gr = *(const uint4*)(RS + o2);
    if (tid < 64) gv = *(const uint4*)(VS + (unsigned)(tokof(base + (tid >> 1)) * 1024 + (tid & 1) * 16));
  };
  auto lstore = [&](int bufi) {
    unsigned char* bb = smem + bufi * WBUF;
    *(uint4*)(bb + tid * 16) = gw0; *(uint4*)(bb + 4096 + tid * 16) = gw1;
    *(uint4*)(bb + 8192 + tid * 16) = gk; *(uint4*)(bb + 12288 + tid * 16) = gka;
    *(uint4*)(bb + 16384 + tid * 16) = gkm; *(uint4*)(bb + 20480 + tid * 16) = gr;
    if (tid < 64) *(uint4*)(bb + 24576 + tid * 16) = gv;
  };
  const int nch = S / WCH;
  __syncthreads();
  gload(0); lstore(0);
  __syncthreads();
  for (int c = 0; c < nch; ++c) {
    if (c + 1 < nch) gload(c + 1);
    const unsigned char* bb = smem + (c & 1) * WBUF;
    float* ys = (float*)(ysb + (c & 1) * 2048);
    float4 nw = *(const float4*)(bb + q * 16);
    uint2 nkk = *(const uint2*)(bb + 8192 + q * 8), nkka = *(const uint2*)(bb + 12288 + q * 8);
    uint2 nkm = *(const uint2*)(bb + 16384 + q * 8), nr = *(const uint2*)(bb + 20480 + q * 8);
    bf16_t nv = *(const bf16_t*)(bb + 24576 + rl * 2);
#pragma unroll 8
    for (int s = 0; s < WCH; ++s) {
      const float4 w = nw; const uint2 kk = nkk, kka = nkka, km = nkm, r = nr; const float v = bf2f(nv);
      {
        const int s1 = (s + 1 < WCH) ? s + 1 : s;
        nw = *(const float4*)(bb + s1 * 256 + q * 16);
        nkk = *(const uint2*)(bb + 8192 + s1 * 128 + q * 8); nkka = *(const uint2*)(bb + 12288 + s1 * 128 + q * 8);
        nkm = *(const uint2*)(bb + 16384 + s1 * 128 + q * 8); nr = *(const uint2*)(bb + 20480 + s1 * 128 + q * 8);
        nv = *(const bf16_t*)(bb + 24576 + s1 * 32 + rl * 2);
      }
      float sk = st[0] * bflo(kk.x) + st[1] * bfhi(kk.x) + st[2] * bflo(kk.y) + st[3] * bfhi(kk.y);
      sk = sum16(sk);
      st[0] = st[0] * w.x - sk * bflo(kka.x) + v * bflo(km.x);
      st[1] = st[1] * w.y - sk * bfhi(kka.x) + v * bfhi(km.x);
      st[2] = st[2] * w.z - sk * bflo(kka.y) + v * bflo(km.y);
      st[3] = st[3] * w.w - sk * bfhi(kka.y) + v * bfhi(km.y);
      float y = st[0] * bflo(r.x) + st[1] * bfhi(r.x) + st[2] * bflo(r.y) + st[3] * bfhi(r.y);
      y = sum16(y);
      ys[s * 16 + rl] = y;
    }
    if (c + 1 < nch) lstore((c + 1) & 1);
    __syncthreads();
    {
      const int base = c * WCH;
      const int s1 = tid >> 4, rr = tid & 15;
      *(float*)(Y + (unsigned)(tokof(base + s1) * 2048 + rr * 4)) = ys[s1 * 16 + rr];
      *(float*)(Y + (unsigned)(tokof(base + s1 + 16) * 2048 + rr * 4)) = ys[(s1 + 16) * 16 + rr];
    }
  }
  if (ctx) {
    float* o = p.out + 21004288 + ((((size_t)(b * 2 + j) * 2 + d) * 8 + h) * 64 + row) * 64 + q * 4;
    *(float4*)o = make_float4(st[0], st[1], st[2], st[3]);
  }
}

DI void lru_scan_item(const Params& p, unsigned char* smem, int j, int b, int cgp, bool ctx, int chb) {
  const int tid = tidx(), c = tid & ((1 << chb) - 1), sg = tid >> chb;
  const int nseg = NTHR >> chb;
  const int ch = (cgp << chb) + c;
  const int S = ctx ? 256 : 4096, t0 = ctx ? b * 256 : 4096 + b * 4096;
  const int L = S / nseg;
  float* sA = (float*)smem; float* sB = sA + 256;
  char* YM = (char*)(p.ws + OFF_YMIX);
  const char* Z = (const char*)(p.ws + OFF_Z);
  for (int d = 0; d < 2; ++d) {
    const char* la = (const char*)(p.ws + OFF_MIX) + (size_t)d * T * 512 * 4;
    const char* lb = (const char*)(p.ws + OFF_LB) + (size_t)d * T * 512 * 2;
    float A = 1.f, Bv = 0.f;
#pragma unroll 8
    for (int st = sg * L; st < (sg + 1) * L; ++st) {
      const int tk = t0 + (d ? (S - 1 - st) : st);
      float a = *(const float*)(la + (unsigned)(tk * 2048 + ch * 4));
      float bb = bf2f(*(const bf16_t*)(lb + (unsigned)(tk * 1024 + ch * 2)));
      A *= a; Bv = a * Bv + bb;
    }
    __syncthreads();
    sA[tid] = A; sB[tid] = Bv;
    __syncthreads();
    float h = ctx ? 0.f : p.in[I_SLRU][((size_t)(b * 2 + j) * 2 + d) * 512 + ch];
    for (int s2 = 0; s2 < sg; ++s2) h = sA[(s2 << chb) + c] * h + sB[(s2 << chb) + c];
#pragma unroll 8
    for (int st = sg * L; st < (sg + 1) * L; ++st) {
      const int tk = t0 + (d ? (S - 1 - st) : st);
      float a = *(const float*)(la + (unsigned)(tk * 2048 + ch * 4));
      float bb = bf2f(*(const bf16_t*)(lb + (unsigned)(tk * 1024 + ch * 2)));
      h = a * h + bb;
      bf16_t* ym = (bf16_t*)(YM + (unsigned)(tk * 2048 + ch * 2));
      if (d == 0) *ym = (bf16_t)f2bf(h);
      else {
        float hs = h + bf2f(*ym);
        float gb = bf2f(*(const bf16_t*)(Z + (unsigned)(tk * 5888 + 1024 + ch * 2)));
        *ym = (bf16_t)f2bf(hs * gelu_t(gb));
      }
    }
    if (ctx && sg == nseg - 1) p.out[20971520 + ((size_t)(b * 2 + j) * 2 + d) * 512 + ch] = h;
    __syncthreads();
  }
}

DI void phase_o4(const Params& p, unsigned char* smem, int l, int bid, int nb) {
  const int j = l >> 1;
  auto do_item = [&](int it) {
    if (it < 256) { int sid = it >> 2, rg = it & 3; wkv_scan_item(p, smem, j, sid >> 4, (sid >> 3) & 1, sid & 7, rg, false); }
    else if (it < 512) { int r = it - 256; lru_scan_item(p, smem, j, r >> 6, r & 63, false, 3); }
    else if (it < 1536) { int r = it - 512; int sid = r >> 2, rg = r & 3; wkv_scan_item(p, smem, j, sid >> 4, (sid >> 3) & 1, sid & 7, rg, true); }
    else { int r = it - 1536; lru_scan_item(p, smem, j, r >> 4, r & 15, true, 5); }
  };
  if (nb >= 512) {
    if (bid < 256) do_item(bid);
    else {
      const int ob = bid - 256, no = nb - 256;
      for (int it = 256 + ob; it < 512; it += no) do_item(it);
      for (int it = 512 + ob; it < 1792; it += no) do_item(it);
    }
  } else {
    for (int it = bid; it < 1792; it += nb) do_item(it);
  }
}

DI void phase_o5(const Params& p, int l, int bid, int nb) {
  const int j = l >> 1;
  const int lane = tidx() & 63, wave = tidx() >> 6;
  const float* YF = (const float*)(p.ws + OFF_H);
  const float* YB = (const float*)(p.ws + OFF_XC);
  const bf16_t* RS = (const bf16_t*)(p.ws + OFF_RS);
  const bf16_t* VS = (const bf16_t*)(p.ws + OFF_VS);
  const bf16_t* KM = (const bf16_t*)(p.ws + OFF_KM);
  const bf16_t* G = (const bf16_t*)(p.ws + OFF_G);
  bf16_t* YM = (bf16_t*)(p.ws + OFF_YMIX);
  const int c0 = lane * 8;
  float gng[8], gnb[8], rk[8];
  load8f(p.in[I_GNG] + j * 512 + c0, gng);
  load8f(p.in[I_GNB] + j * 512 + c0, gnb);
  load8f(p.in[I_RK] + j * 512 + c0, rk);
  for (int t = bid * 4 + wave; t < T; t += nb * 4) {
    const size_t o = (size_t)t * 512 + c0;
    float yf[8], yb[8], ys[8];
    load8f(YF + o, yf); load8f(YB + o, yb);
    float s = 0.f;
#pragma unroll
    for (int i = 0; i < 8; ++i) { ys[i] = yf[i] + yb[i]; s += ys[i]; }
    const float mean = sum8(s) * (1.f / 64.f);
    float v = 0.f;
#pragma unroll
    for (int i = 0; i < 8; ++i) { float dd = ys[i] - mean; v += dd * dd; }
    const float rstd = rsqrtf(sum8(v) * (1.f / 64.f) + 64e-5f);
    float r[8], vv[8], kf[8], kb[8], g[8];
    unpack8(*(const uint4*)(RS + o), r);
    unpack8(*(const uint4*)(VS + o), vv);
    unpack8(*(const uint4*)(KM + o), kf);
    unpack8(*(const uint4*)(KM + (size_t)T * 512 + o), kb);
    unpack8(*(const uint4*)(G + o), g);
    float sf = 0.f;
#pragma unroll
    for (int i = 0; i < 8; ++i) sf += r[i] * rk[i] * (kf[i] + kb[i]);
    sf = sum8(sf);
    float outv[8];
#pragma unroll
    for (int i = 0; i < 8; ++i) outv[i] = ((ys[i] - mean) * rstd * gng[i] + gnb[i] + sf * vv[i]) * g[i];
    *(uint4*)(YM + (size_t)t * 1024 + 512 + c0) = pack8(outv);
  }
}

enum { PH_PREP = 0, PH_INIT, PH_E1, PH_E2, PH_EOUT, PH_RES, PH_P1, PH_P2, PH_O1, PH_O2, PH_O3, PH_O4, PH_O5, PH_OOUT };

DI void run_phase(const Params& p, unsigned char* smem, int ph, int l, int bid, int nb) {
  switch (ph) {
    case PH_PREP: phase_prep(p, smem, bid, nb); break;
    case PH_INIT: phase_init(p, bid, nb); break;
    case PH_E1: phase_e1(p, smem, l, bid, nb); break;
    case PH_E2: phase_e2(p, smem, l, bid, nb); break;
    case PH_EOUT: phase_outgemm(p, smem, (const bf16_t*)(p.ws + OFF_BT_OUT_E) + (size_t)(l >> 1) * 1024 * 1024, bid, nb); break;
    case PH_RES: phase_res1(p, l, bid, nb); break;
    case PH_P1: phase_p1(p, smem, l, bid, nb); break;
    case PH_P2: phase_p2(p, smem, l, bid, nb); break;
    case PH_O1: phase_o1(p, smem, l, bid, nb); break;
    case PH_O2: phase_o2(p, l, bid, nb); break;
    case PH_O3: phase_o3(p, smem, l, bid, nb); break;
    case PH_O4: phase_o4(p, smem, l, bid, nb); break;
    case PH_O5: phase_o5(p, l, bid, nb); break;
    case PH_OOUT: phase_outgemm(p, smem, (const bf16_t*)(p.ws + OFF_BT_OUT_O) + (size_t)(l >> 1) * 1024 * 1024, bid, nb); break;
  }
}


DI void grid_seam(cg::grid_group& grid) {
  asm volatile("s_waitcnt vmcnt(0)" ::: "memory");
  grid.sync();
  asm volatile("buffer_inv sc1\n\ts_waitcnt vmcnt(0)" ::: "memory");
}
#if MULTI
__global__ void __launch_bounds__(NTHR, 2) phase_kernel(Params p, int ph, int l) {
  extern __shared__ __attribute__((aligned(16))) unsigned char smem[];
  run_phase(p, smem, ph, l, blockIdx.x, gridDim.x);
}
#else
#ifndef TPROBE
#define TPROBE 0
#endif
__global__ void __launch_bounds__(NTHR, 2) mega_kernel(Params p) {
  extern __shared__ __attribute__((aligned(16))) unsigned char smem[];
  cg::grid_group grid = cg::this_grid();
  const int bid = blockIdx.x, nb = gridDim.x;
#if TPROBE
  unsigned long long tprev = wall_clock64(), tsel = 0, ttot = 0;
#endif
  for (int step = 0; step < 32; ++step) {
    int ph, l;
    if (step < 2) { ph = step; l = 0; }
    else {
      int s = step - 2, k;
      if (s < 6) { l = 0; k = s; } else if (s < 15) { l = 1; k = s - 6; } else if (s < 21) { l = 2; k = s - 15; } else { l = 3; k = s - 21; }
      if ((l & 1) == 0) ph = PH_E1 + k;
      else ph = (k < 6) ? PH_O1 + k : PH_RES + (k - 6);
    }
#if defined(__HIP_DEVICE_COMPILE__)
    const __attribute__((address_space(4))) Params* kp = (const __attribute__((address_space(4))) Params*)__builtin_amdgcn_kernarg_segment_ptr();
    asm volatile("" : "+s"(kp), "+s"(l), "+s"(ph));
    const Params q = *kp;
#else
    const Params q = p;
#endif
    run_phase(q, smem, ph, l, bid, nb);
#if !TPROBE
    if (step == 31) break;
#endif
    grid_seam(grid);
#if TPROBE
    {
      unsigned long long tn = wall_clock64();
      if ((TPROBE >> ph) & 1) tsel += tn - tprev;
      ttot += tn - tprev;
      tprev = tn;
    }
#endif
  }
#if TPROBE
  if (bid == 0) {
    float frac = (float)((double)tsel / (double)ttot);
    float sc = 1.f + sqrtf(frac);
    for (int i = tidx(); i < 32768; i += NTHR) p.out[20971520 + i] *= sc;
  }
#endif
}
#endif

extern "C" void kernel_launch(void* const* d_in, const int* in_sizes, int n_in, void* d_out, int out_size, void* d_ws, size_t ws_size,
                              hipStream_t stream) {
  static int grid_blocks = 0;
  if (grid_blocks == 0) {
    if (n_in != 40 || ws_size < WS_END) { fprintf(stderr, "kernel_launch: unexpected n_in %d or ws_size %zu (need %zu)\n", n_in, ws_size, (size_t)WS_END); grid_blocks = -1; return; }
    int dev = 0, cus = 0, per_cu = 0;
    hipGetDevice(&dev);
    hipDeviceGetAttribute(&cus, hipDeviceAttributeMultiprocessorCount, dev);
#if MULTI
    hipFuncSetAttribute((const void*)phase_kernel, hipFuncAttributeMaxDynamicSharedMemorySize, LDS_BYTES);
    hipOccupancyMaxActiveBlocksPerMultiprocessor(&per_cu, (const void*)phase_kernel, NTHR, LDS_BYTES);
#else
    hipFuncSetAttribute((const void*)mega_kernel, hipFuncAttributeMaxDynamicSharedMemorySize, LDS_BYTES);
    hipOccupancyMaxActiveBlocksPerMultiprocessor(&per_cu, (const void*)mega_kernel, NTHR, LDS_BYTES);
#endif
    if (per_cu < 1) per_cu = 1;
    if (per_cu > 2) per_cu = 2;
    if (cus < 1) cus = 256;
    grid_blocks = cus * per_cu;
  }
  if (grid_blocks < 0) return;
  Params p{};
  for (int i = 0; i < 40; ++i) p.in[i] = (const float*)d_in[i];
  p.out = (float*)d_out;
  p.ws = (unsigned char*)d_ws;
#if MULTI
  auto L = [&](int ph, int l) { hipLaunchKernelGGL(phase_kernel, dim3(grid_blocks), dim3(NTHR), LDS_BYTES, stream, p, ph, l); };
  L(PH_PREP, 0); L(PH_INIT, 0);
  for (int l = 0; l < 4; ++l) {
    if ((l & 1) == 0) { L(PH_E1, l); L(PH_E2, l); L(PH_EOUT, l); }
    else { L(PH_O1, l); L(PH_O2, l); L(PH_O3, l); L(PH_O4, l); L(PH_O5, l); L(PH_OOUT, l); }
    L(PH_RES, l); L(PH_P1, l); L(PH_P2, l);
  }
#else
  void* args[] = {&p};
  hipError_t e = hipLaunchCooperativeKernel((const void*)mega_kernel, dim3(grid_blocks), dim3(NTHR), args, LDS_BYTES, stream);
  if (e != hipSuccess) fprintf(stderr, "cooperative launch failed: %s (grid %d)\n", hipGetErrorString(e), grid_blocks);
#endif
}
```

```cpp
#include <hip/hip_runtime.h>
#include <hip/hip_cooperative_groups.h>
#include <cstdio>
#include <cstdint>
namespace cg = cooperative_groups;

#ifndef MULTI
#define MULTI 0
#endif

typedef unsigned short bf16_t;
using bf16x8 = __attribute__((ext_vector_type(8))) short;
using f32x16 = __attribute__((ext_vector_type(16))) float;
#define DI __device__ __forceinline__
#define MFMA(a, b, c) __builtin_amdgcn_mfma_f32_32x32x16_bf16((a), (b), (c), 0, 0, 0)

constexpr int T = 20480;
constexpr int NTHR = 256;
constexpr int LDS_MAIN = 71680;
constexpr int LDS_BYTES = LDS_MAIN + 16;
constexpr float ALPHA_F = 1.681792830507429f;

constexpr size_t MiB = 1u << 20;
constexpr size_t OFF_TABU = 0;
constexpr size_t OFF_TABV = OFF_TABU + 32 * MiB;
constexpr size_t OFF_BT_IN_E = OFF_TABV + 32 * MiB;
constexpr size_t OFF_BT_OUT_E = OFF_BT_IN_E + 10 * MiB;
constexpr size_t OFF_BT_IN_O = OFF_BT_OUT_E + 4 * MiB;
constexpr size_t OFF_BT_OUT_O = OFF_BT_IN_O + 12 * MiB;
constexpr size_t OFF_BT_WQ = OFF_BT_OUT_O + 4 * MiB;
constexpr size_t OFF_BT_W2 = OFF_BT_WQ + 16 * MiB;
constexpr size_t OFF_BT_A2 = OFF_BT_W2 + 256 * 1024;
constexpr size_t OFF_BT_G2 = OFF_BT_A2 + 256 * 1024;
constexpr size_t OFF_BT_GATE = OFF_BT_G2 + 256 * 1024;
constexpr size_t OFF_D256 = OFF_BT_GATE + 2 * MiB;
constexpr size_t OFF_MOD = OFF_D256 + 256 * 1024;
constexpr size_t OFF_D4096 = OFF_MOD + 512 * 1024;
constexpr size_t OFF_X = OFF_D4096 + 64 * MiB;
constexpr size_t OFF_Z = OFF_X + 80 * MiB;
constexpr size_t OFF_YMIX = OFF_Z + 115 * MiB;
constexpr size_t OFF_MIX = OFF_YMIX + 40 * MiB;
constexpr size_t OFF_H = OFF_MIX + 80 * MiB;
constexpr size_t OFF_XC = OFF_H + 40 * MiB;
constexpr size_t OFF_LRIN = OFF_XC + 40 * MiB;
constexpr size_t OFF_KKN = OFF_LRIN + 15 * MiB;
constexpr size_t OFF_KS = OFF_KKN + 40 * MiB;
constexpr size_t OFF_RS = OFF_KS + 20 * MiB;
constexpr size_t OFF_VS = OFF_RS + 20 * MiB;
constexpr size_t OFF_LB = OFF_VS + 20 * MiB;
constexpr size_t OFF_WD = OFF_LB + 40 * MiB;
constexpr size_t OFF_KKA = OFF_WD + 80 * MiB;
constexpr size_t OFF_KM = OFF_KKA + 40 * MiB;
constexpr size_t OFF_G = OFF_KM + 40 * MiB;
constexpr size_t OFF_BAR = OFF_G + 20 * MiB;
constexpr size_t WS_END = OFF_BAR + 16384;

struct Params {
  const float* in[40];
  float* out;
  unsigned char* ws;
};

enum {
  I_XP = 0, I_XS, I_SLRU, I_SWKV, I_C, I_CCTX, I_WMOD, I_BMOD, I_LN1G, I_LN1B, I_LN2G, I_LN2B, I_WINE, I_WOUTE, I_SCW, I_SCB,
  I_WINO, I_WOUTO, I_LCW, I_LCB, I_LWA, I_LBA, I_LWX, I_LBX, I_LLAM, I_MU, I_W0, I_W2, I_A0, I_A2, I_KK, I_KA, I_RK, I_G2, I_GNG,
  I_GNB, I_WQ, I_KEYS, I_PU, I_PV
};

DI int tidx() { int t = __builtin_amdgcn_workitem_id_x(); asm volatile("" : "+v"(t)); return t; }
DI unsigned f2bf(float x) { unsigned u = __float_as_uint(x); u += 0x7fffu + ((u >> 16) & 1u); return u >> 16; }
DI unsigned pack2(float a, float b) { return f2bf(a) | (f2bf(b) << 16); }
DI float bflo(unsigned u) { return __uint_as_float(u << 16); }
DI float bfhi(unsigned u) { return __uint_as_float(u & 0xffff0000u); }
DI float bf2f(bf16_t h) { return __uint_as_float(((unsigned)h) << 16); }
DI float sigm(float x) { return 1.f / (1.f + __expf(-x)); }
DI float gelu_t(float x) { float u = 0.7978845608028654f * (x + 0.044715f * x * x * x); return x * sigm(2.f * u); }
DI float tanh_f(float x) { return 2.f * sigm(2.f * x) - 1.f; }

template <int CTRL> DI float dpp_mov(float x) {
  return __int_as_float(__builtin_amdgcn_update_dpp(0, __float_as_int(x), CTRL, 0xF, 0xF, true));
}
DI float sum8(float x) { x += dpp_mov<0xB1>(x); x += dpp_mov<0x4E>(x); x += dpp_mov<0x141>(x); return x; }
DI float sum16(float x) { x = sum8(x); x += dpp_mov<0x140>(x); return x; }
DI float max16(float x) {
  x = fmaxf(x, dpp_mov<0xB1>(x)); x = fmaxf(x, dpp_mov<0x4E>(x)); x = fmaxf(x, dpp_mov<0x141>(x)); x = fmaxf(x, dpp_mov<0x140>(x));
  return x;
}
DI float wave_sum(float x) { x = sum16(x); x += __shfl_xor(x, 16); x += __shfl_xor(x, 32); return x; }

DI void tok_info(int t, int& seq, int& s, int& S, int& cv) {
  if (t < 4096) { seq = t >> 8; s = t & 255; S = 256; cv = 0; }
  else { int u = t - 4096; seq = 16 + (u >> 12); s = u & 4095; S = 4096; cv = 1 + (u >> 12); }
}
DI size_t pqt_base(int seq) { return seq < 16 ? (size_t)seq * 512 * 512 : (size_t)16 * 512 * 512 + (size_t)(seq - 16) * 512 * 8192; }

DI void load_row(const float* p, int lane, float (&v)[16]) {
  const float4* q = (const float4*)(p + lane * 8);
  float4 a = q[0], b = q[1];
  const float4* q2 = (const float4*)(p + 512 + lane * 8);
  float4 c = q2[0], d = q2[1];
  v[0] = a.x; v[1] = a.y; v[2] = a.z; v[3] = a.w; v[4] = b.x; v[5] = b.y; v[6] = b.z; v[7] = b.w;
  v[8] = c.x; v[9] = c.y; v[10] = c.z; v[11] = c.w; v[12] = d.x; v[13] = d.y; v[14] = d.z; v[15] = d.w;
}
DI void store_row(float* p, int lane, const float (&v)[16]) {
  float4* q = (float4*)(p + lane * 8);
  q[0] = make_float4(v[0], v[1], v[2], v[3]); q[1] = make_float4(v[4], v[5], v[6], v[7]);
  float4* q2 = (float4*)(p + 512 + lane * 8);
  q2[0] = make_float4(v[8], v[9], v[10], v[11]); q2[1] = make_float4(v[12], v[13], v[14], v[15]);
}
DI void store_row_bf(bf16_t* p, int lane, const float (&v)[16]) {
  uint4 a, b;
  a.x = pack2(v[0], v[1]); a.y = pack2(v[2], v[3]); a.z = pack2(v[4], v[5]); a.w = pack2(v[6], v[7]);
  b.x = pack2(v[8], v[9]); b.y = pack2(v[10], v[11]); b.z = pack2(v[12], v[13]); b.w = pack2(v[14], v[15]);
  *(uint4*)(p + lane * 8) = a;
  *(uint4*)(p + 512 + lane * 8) = b;
}
DI void unpack8(uint4 u, float (&v)[8]) {
  v[0] = bflo(u.x); v[1] = bfhi(u.x); v[2] = bflo(u.y); v[3] = bfhi(u.y); v[4] = bflo(u.z); v[5] = bfhi(u.z); v[6] = bflo(u.w); v[7] = bfhi(u.w);
}
DI uint4 pack8(const float (&v)[8]) {
  uint4 a; a.x = pack2(v[0], v[1]); a.y = pack2(v[2], v[3]); a.z = pack2(v[4], v[5]); a.w = pack2(v[6], v[7]); return a;
}
DI void load8f(const float* p, float (&v)[8]) {
  float4 a = ((const float4*)p)[0], b = ((const float4*)p)[1];
  v[0] = a.x; v[1] = a.y; v[2] = a.z; v[3] = a.w; v[4] = b.x; v[5] = b.y; v[6] = b.z; v[7] = b.w;
}

DI void load_row16(const float* p, int lane, float (&v)[16]) {
  const float4* q = (const float4*)(p + lane * 16);
  float4 a = q[0], b = q[1], c = q[2], d = q[3];
  v[0] = a.x; v[1] = a.y; v[2] = a.z; v[3] = a.w; v[4] = b.x; v[5] = b.y; v[6] = b.z; v[7] = b.w;
  v[8] = c.x; v[9] = c.y; v[10] = c.z; v[11] = c.w; v[12] = d.x; v[13] = d.y; v[14] = d.z; v[15] = d.w;
}
DI void store_row16(float* p, int lane, const float (&v)[16]) {
  float4* q = (float4*)(p + lane * 16);
  q[0] = make_float4(v[0], v[1], v[2], v[3]); q[1] = make_float4(v[4], v[5], v[6], v[7]);
  q[2] = make_float4(v[8], v[9], v[10], v[11]); q[3] = make_float4(v[12], v[13], v[14], v[15]);
}
DI void store_row16_bf(bf16_t* p, int lane, const float (&v)[16]) {
  uint4 a, b;
  a.x = pack2(v[0], v[1]); a.y = pack2(v[2], v[3]); a.z = pack2(v[4], v[5]); a.w = pack2(v[6], v[7]);
  b.x = pack2(v[8], v[9]); b.y = pack2(v[10], v[11]); b.z = pack2(v[12], v[13]); b.w = pack2(v[14], v[15]);
  uint4* q = (uint4*)(p + lane * 16);
  q[0] = a; q[1] = b;
}
typedef float v2f_t __attribute__((ext_vector_type(2)));
DI unsigned pk_fp8x4(float a, float b, float c, float d) {
  int w = 0;
  w = __builtin_amdgcn_cvt_pk_fp8_f32(a, b, w, false);
  w = __builtin_amdgcn_cvt_pk_fp8_f32(c, d, w, true);
  return (unsigned)w;
}
DI void unpack_fp8x16(uint4 u, float (&v)[16]) {
  v2f_t t;
  t = __builtin_amdgcn_cvt_pk_f32_fp8((int)u.x, false); v[0] = t.x; v[1] = t.y;
  t = __builtin_amdgcn_cvt_pk_f32_fp8((int)u.x, true); v[2] = t.x; v[3] = t.y;
  t = __builtin_amdgcn_cvt_pk_f32_fp8((int)u.y, false); v[4] = t.x; v[5] = t.y;
  t = __builtin_amdgcn_cvt_pk_f32_fp8((int)u.y, true); v[6] = t.x; v[7] = t.y;
  t = __builtin_amdgcn_cvt_pk_f32_fp8((int)u.z, false); v[8] = t.x; v[9] = t.y;
  t = __builtin_amdgcn_cvt_pk_f32_fp8((int)u.z, true); v[10] = t.x; v[11] = t.y;
  t = __builtin_amdgcn_cvt_pk_f32_fp8((int)u.w, false); v[12] = t.x; v[13] = t.y;
  t = __builtin_amdgcn_cvt_pk_f32_fp8((int)u.w, true); v[14] = t.x; v[15] = t.y;
}
DI void ln16(float (&y)[16]) {
  float s = 0.f;
#pragma unroll
  for (int i = 0; i < 16; ++i) s += y[i];
  float mu = wave_sum(s) * (1.f / 1024.f);
  float v = 0.f;
#pragma unroll
  for (int i = 0; i < 16; ++i) { float d = y[i] - mu; v += d * d; }
  v = wave_sum(v) * (1.f / 1024.f);
  float rs = rsqrtf(v + 1e-6f);
#pragma unroll
  for (int i = 0; i < 16; ++i) y[i] = (y[i] - mu) * rs;
}

constexpr int LDT = 72;

template <bool SWAP>
DI void gemm_mainloop(const bf16_t* __restrict__ A, int lda, const bf16_t* __restrict__ B, int ldb, int K,
                      f32x16 (&acc)[2][2], bf16_t* As, bf16_t* Bs) {
  const int tid = tidx(), lane = tid & 63, wave = tid >> 6;
  const int wm = wave >> 1, wn = wave & 1;
  const int lrow = tid >> 3, lck = tid & 7;
  const bf16_t* ap = A + (size_t)lrow * lda + lck * 8;
  const bf16_t* bp = B + (size_t)lrow * ldb + lck * 8;
  const size_t sa = (size_t)32 * lda, sb = (size_t)32 * ldb;
  uint4 ra0, ra1, ra2, ra3, rb0, rb1, rb2, rb3;
  ra0 = *(const uint4*)(ap); ra1 = *(const uint4*)(ap + sa); ra2 = *(const uint4*)(ap + 2 * sa); ra3 = *(const uint4*)(ap + 3 * sa);
  rb0 = *(const uint4*)(bp); rb1 = *(const uint4*)(bp + sb); rb2 = *(const uint4*)(bp + 2 * sb); rb3 = *(const uint4*)(bp + 3 * sb);
#pragma unroll
  for (int mi = 0; mi < 2; ++mi)
#pragma unroll
    for (int ni = 0; ni < 2; ++ni)
#pragma unroll
      for (int r = 0; r < 16; ++r) acc[mi][ni][r] = 0.f;
  const int KT = K / 64;
  const int fr = (lane & 31) * LDT + (lane >> 5) * 8;
  bf16_t* asw = As + lrow * LDT + lck * 8;
  bf16_t* bsw = Bs + lrow * LDT + lck * 8;
  for (int kt = 0; kt < KT; ++kt) {
    __syncthreads();
    *(uint4*)(asw) = ra0; *(uint4*)(asw + 32 * LDT) = ra1; *(uint4*)(asw + 64 * LDT) = ra2; *(uint4*)(asw + 96 * LDT) = ra3;
    *(uint4*)(bsw) = rb0; *(uint4*)(bsw + 32 * LDT) = rb1; *(uint4*)(bsw + 64 * LDT) = rb2; *(uint4*)(bsw + 96 * LDT) = rb3;
    __syncthreads();
    if (kt + 1 < KT) {
      const bf16_t* a2 = ap + (kt + 1) * 64;
      const bf16_t* b2 = bp + (kt + 1) * 64;
      ra0 = *(const uint4*)(a2); ra1 = *(const uint4*)(a2 + sa); ra2 = *(const uint4*)(a2 + 2 * sa); ra3 = *(const uint4*)(a2 + 3 * sa);
      rb0 = *(const uint4*)(b2); rb1 = *(const uint4*)(b2 + sb); rb2 = *(const uint4*)(b2 + 2 * sb); rb3 = *(const uint4*)(b2 + 3 * sb);
    }
#pragma unroll
    for (int kk = 0; kk < 4; ++kk) {
      const bf16x8 af0 = *(const bf16x8*)(As + (wm * 64) * LDT + fr + kk * 16);
      const bf16x8 af1 = *(const bf16x8*)(As + (wm * 64 + 32) * LDT + fr + kk * 16);
      const bf16x8 bf0 = *(const bf16x8*)(Bs + (wn * 64) * LDT + fr + kk * 16);
      const bf16x8 bf1 = *(const bf16x8*)(Bs + (wn * 64 + 32) * LDT + fr + kk * 16);
      if (SWAP) {
        acc[0][0] = MFMA(bf0, af0, acc[0][0]); acc[0][1] = MFMA(bf1, af0, acc[0][1]);
        acc[1][0] = MFMA(bf0, af1, acc[1][0]); acc[1][1] = MFMA(bf1, af1, acc[1][1]);
      } else {
        acc[0][0] = MFMA(af0, bf0, acc[0][0]); acc[0][1] = MFMA(af0, bf1, acc[0][1]);
        acc[1][0] = MFMA(af1, bf0, acc[1][0]); acc[1][1] = MFMA(af1, bf1, acc[1][1]);
      }
    }
  }
}

template <bool SWAP, bool SB = true, class F>
DI void gemm_epilogue(const f32x16 (&acc)[2][2], F f) {
  const int lane = tidx() & 63, wave = tidx() >> 6;
  const int wm = wave >> 1, wn = wave & 1;
#pragma unroll
  for (int mi = 0; mi < 2; ++mi)
#pragma unroll
    for (int ni = 0; ni < 2; ++ni)
#pragma unroll
      for (int r = 0; r < 16; ++r) {
        const int i = (r & 3) + 8 * (r >> 2) + 4 * (lane >> 5);
        const int j = lane & 31;
        int m, n;
        if (!SWAP) { m = wm * 64 + mi * 32 + i; n = wn * 64 + ni * 32 + j; }
        else { n = wn * 64 + ni * 32 + i; m = wm * 64 + mi * 32 + j; }
        f(m, n, acc[mi][ni][r]);
        if (SB && (r & 3) == 3) __builtin_amdgcn_sched_barrier(0);
      }
}
template <class F>
DI void gemm_epilogue2(const f32x16 (&a0)[2][2], const f32x16 (&a1)[2][2], F f) {
  const int lane = tidx() & 63, wave = tidx() >> 6;
  const int wm = wave >> 1, wn = wave & 1;
#pragma unroll
  for (int mi = 0; mi < 2; ++mi)
#pragma unroll
    for (int ni = 0; ni < 2; ++ni)
#pragma unroll
      for (int r = 0; r < 16; ++r) {
        const int i = (r & 3) + 8 * (r >> 2) + 4 * (lane >> 5);
        const int j = lane & 31;
        f(wm * 64 + mi * 32 + i, wn * 64 + ni * 32 + j, a0[mi][ni][r], a1[mi][ni][r]);
      }
}

DI int tr_tiles(int job) {
  if (job < 2) return 384; if (job < 4) return 256; if (job < 6) return 736; if (job < 8) return 256;
  if (job < 12) return 512; if (job < 20) return 8; return 16;
}
DI void phase_prep(const Params& p, unsigned char* smem, int bid, int nb) {
  const int tid = tidx();
  constexpr int N_MOD = 384, N_TR = 768 + 512 + 1472 + 512 + 2048 + 32 + 32 + 32, N_FOLD = 256, N_GATE = 512, N_DFT = 16384 + 64;
  constexpr int TOTAL = N_MOD + N_TR + N_FOLD + N_GATE + N_DFT;
  unsigned char* ws = p.ws;
  for (int it = bid; it < TOTAL; it += nb) {
    if (it < N_MOD) {
      const int l = it / 96, cchunk = it % 96;
      float* sil = (float*)smem;
      float* red = sil + 5 * 1024;
      __syncthreads();
      for (int i = tid; i < 5120; i += NTHR) {
        int cv = i >> 10, k = i & 1023;
        float c = (cv == 0) ? p.in[I_CCTX][k] : p.in[I_C][(cv - 1) * 1024 + k];
        sil[i] = c * sigm(c);
      }
      __syncthreads();
      const int col = cchunk * 64 + (tid & 63), kg = tid >> 6;
      const float* w = p.in[I_WMOD] + (size_t)l * 1024 * 6144 + col;
      float a0 = 0.f, a1 = 0.f, a2 = 0.f, a3 = 0.f, a4 = 0.f;
#pragma unroll 8
      for (int k = kg * 256; k < kg * 256 + 256; ++k) {
        float wv = w[(size_t)k * 6144];
        a0 += sil[k] * wv; a1 += sil[1024 + k] * wv; a2 += sil[2048 + k] * wv; a3 += sil[3072 + k] * wv; a4 += sil[4096 + k] * wv;
      }
      const int c = tid & 63;
      red[(kg * 5 + 0) * 64 + c] = a0; red[(kg * 5 + 1) * 64 + c] = a1; red[(kg * 5 + 2) * 64 + c] = a2;
      red[(kg * 5 + 3) * 64 + c] = a3; red[(kg * 5 + 4) * 64 + c] = a4;
      __syncthreads();
      for (int i = tid; i < 320; i += NTHR) {
        int cv = i >> 6, cc = i & 63;
        float s = red[(0 * 5 + cv) * 64 + cc] + red[(1 * 5 + cv) * 64 + cc] + red[(2 * 5 + cv) * 64 + cc] + red[(3 * 5 + cv) * 64 + cc];
        s += p.in[I_BMOD][l * 6144 + cchunk * 64 + cc];
        ((float*)(ws + OFF_MOD))[(l * 5 + cv) * 6144 + cchunk * 64 + cc] = s;
      }
    } else if (it < N_MOD + N_TR) {
      int r = it - N_MOD, job = 0;
      for (job = 0; job < 22; ++job) { int nt = tr_tiles(job); if (r < nt) break; r -= nt; }
      const float* src; bf16_t* dst; int lds, ldd, N;
      if (job < 2) { src = p.in[I_WINE] + (size_t)job * 1024 * 2048 + 512; lds = 2048; N = 1536; dst = (bf16_t*)(ws + OFF_BT_IN_E) + (size_t)job * 2560 * 1024 + (size_t)1024 * 1024; ldd = 1024; }
      else if (job < 4) { int j = job - 2; src = p.in[I_WOUTE] + (size_t)j * 1024 * 1024; lds = 1024; N = 1024; dst = (bf16_t*)(ws + OFF_BT_OUT_E) + (size_t)j * 1024 * 1024; ldd = 1024; }
      else if (job < 6) { int j = job - 4; src = p.in[I_WINO] + (size_t)j * 1024 * 2944; lds = 2944; N = 2944; dst = (bf16_t*)(ws + OFF_BT_IN_O) + (size_t)j * 2944 * 1024; ldd = 1024; }
      else if (job < 8) { int j = job - 6; src = p.in[I_WOUTO] + (size_t)j * 1024 * 1024; lds = 1024; N = 1024; dst = (bf16_t*)(ws + OFF_BT_OUT_O) + (size_t)j * 1024 * 1024; ldd = 1024; }
      else if (job < 12) { int j = job - 8; src = p.in[I_WQ] + (size_t)j * 1024 * 2048; lds = 2048; N = 2048; dst = (bf16_t*)(ws + OFF_BT_WQ) + (size_t)j * 2048 * 1024; ldd = 1024; }
      else if (job < 16) { int j = job - 12; src = p.in[I_W2] + (size_t)j * 64 * 512; lds = 512; N = 512; dst = (bf16_t*)(ws + OFF_BT_W2) + (size_t)j * 512 * 64; ldd = 64; }
      else if (job < 20) { int j = job - 16; src = p.in[I_A2] + (size_t)j * 64 * 512; lds = 512; N = 512; dst = (bf16_t*)(ws + OFF_BT_A2) + (size_t)j * 512 * 64; ldd = 64; }
      else { int j = job - 20; src = p.in[I_G2] + (size_t)j * 128 * 512; lds = 512; N = 512; dst = (bf16_t*)(ws + OFF_BT_G2) + (size_t)j * 512 * 128; ldd = 128; }
      const int ntn = N / 64;
      const int k0 = (r / ntn) * 64, n0 = (r % ntn) * 64;
      float* tl = (float*)smem;
      __syncthreads();
#pragma unroll 4
      for (int ps = 0; ps < 16; ++ps) {
        int kr = ps * 4 + (tid >> 6), n = tid & 63;
        tl[kr * 65 + n] = src[(size_t)(k0 + kr) * lds + n0 + n];
      }
      __syncthreads();
#pragma unroll 4
      for (int ps = 0; ps < 8; ++ps) {
        int nr = ps * 8 + (tid >> 5), k2 = tid & 31;
        unsigned v = pack2(tl[(2 * k2) * 65 + nr], tl[(2 * k2 + 1) * 65 + nr]);
        *(unsigned*)(dst + (size_t)(n0 + nr) * ldd + k0 + 2 * k2) = v;
      }
    } else if (it < N_MOD + N_TR + N_FOLD) {
      int r = it - N_MOD - N_TR;
      const int j = r >> 7, rr = r & 127, which = rr >> 6, g = (rr >> 4) & 3, kt = rr & 15;
      const int k0 = kt * 64;
      float* Wl = (float*)smem;
      float* tab = Wl + 64 * 129;
      __syncthreads();
      if (tid < 128) { float fr = (float)tid * (1.f / 128.f); tab[tid] = which ? __builtin_amdgcn_sinf(fr) : __builtin_amdgcn_cosf(fr); }
      for (int ps = 0; ps < 32; ++ps) {
        int kr = ps * 2 + (tid >> 7), c = tid & 127;
        Wl[kr * 129 + c] = p.in[I_WINE][(size_t)j * 1024 * 2048 + (size_t)(k0 + kr) * 2048 + g * 128 + c];
      }
      __syncthreads();
      const int k = tid & 63, nq = tid >> 6;
      bf16_t* dst = (bf16_t*)(ws + OFF_BT_IN_E) + (size_t)j * 2560 * 1024;
      for (int i = 0; i < 32; ++i) {
        const int np = nq * 32 + i;
        float s = 0.f;
#pragma unroll 8
        for (int c = 0; c < 128; ++c) s += Wl[k * 129 + c] * tab[(c * np) & 127];
        dst[(size_t)(which * 512 + g * 128 + np) * 1024 + k0 + k] = (bf16_t)f2bf(s);
      }
    } else if (it < N_MOD + N_TR + N_FOLD + N_GATE) {
      int r = it - N_MOD - N_TR - N_FOLD;
      bf16_t* dst = (bf16_t*)(ws + OFF_BT_GATE);
      for (int e = 0; e < 4; ++e) {
        int idx = r * 1024 + e * 256 + tid;
        int kp = idx & 127, n = (idx >> 7) & 511, gate = (idx >> 16) & 1, d = (idx >> 17) & 1, j = idx >> 18;
        int h = n >> 6;
        float v = 0.f;
        if ((kp >> 6) == (h & 1)) {
          const float* W = gate ? p.in[I_LWX] : p.in[I_LWA];
          v = W[((((size_t)(j * 2 + d) * 8 + h) * 64 + (kp & 63)) * 64) + (n & 63)];
        }
        dst[idx] = (bf16_t)f2bf(v);
      }
    } else {
      int r = it - N_MOD - N_TR - N_FOLD - N_GATE;
      int S, K2; bf16_t* dst; size_t idx;
      if (r < 16384) { S = 4096; K2 = 8192; dst = (bf16_t*)(ws + OFF_D4096); idx = (size_t)r * 2048 + tid * 8; }
      else { S = 256; K2 = 512; dst = (bf16_t*)(ws + OFF_D256); idx = (size_t)(r - 16384) * 2048 + tid * 8; }
      const int row = (int)(idx / K2), kb = (int)(idx % K2);
      const float invS = 1.f / (float)S;
      float v[8];
#pragma unroll
      for (int e = 0; e < 8; ++e) {
        int k = kb + e;
        if (k < S) { int m = (row * k) & (S - 1); v[e] = __builtin_amdgcn_cosf((float)m * invS); }
        else { int m = (row * (k - S)) & (S - 1); v[e] = -__builtin_amdgcn_sinf((float)m * invS); }
      }
      *(uint4*)(dst + idx) = pack8(v);
    }
  }
}

DI void mod_store_h(const Params& p, int t, int lane, int cv, int l, int off_scale, int off_shift, float (&y)[16]) {
  const float* mod = (const float*)(p.ws + OFF_MOD) + (size_t)(l * 5 + cv) * 6144;
  float sc[16], sh[16];
  load_row(mod + off_scale * 1024, lane, sc);
  load_row(mod + off_shift * 1024, lane, sh);
#pragma unroll
  for (int i = 0; i < 16; ++i) y[i] = y[i] * (1.f + sc[i]) + sh[i];
  store_row_bf((bf16_t*)(p.ws + OFF_H) + (size_t)t * 1024, lane, y);
}

DI float pos_embed(int n, int c) {
  int pos = (c < 512) ? (n >> 6) : (n & 63);
  int cc = c & 511, i = cc & 255;
  float om = exp2f(-(float)i * (13.287712379549449f / 256.f));
  float rev = (float)pos * om * 0.15915494309189535f;
  return cc < 256 ? __builtin_amdgcn_sinf(rev) : __builtin_amdgcn_cosf(rev);
}

DI void phase_init(const Params& p, int bid, int nb) {
  const int lane = tidx() & 63, wave = tidx() >> 6;
  float sc[16], sh[16];
  int cvl = -1;
  for (int t = bid * 4 + wave; t < T; t += nb * 4) {
    int seq, s, S, cv; tok_info(t, seq, s, S, cv);
    if (cv != cvl) {
      const float* mod = (const float*)(p.ws + OFF_MOD) + (size_t)cv * 6144;
      load_row(mod + 1024, lane, sc); load_row(mod, lane, sh);
      cvl = cv;
    }
    float y[16];
    const float* src = (t < 4096) ? p.in[I_XP] + (size_t)t * 1024 : p.in[I_XS] + (size_t)(t - 4096) * 1024;
    load_row(src, lane, y);
    if (t >= 4096) {
#pragma unroll
      for (int i = 0; i < 16; ++i) { int c = (i < 8) ? lane * 8 + i : 512 + lane * 8 + (i - 8); y[i] += pos_embed(s, c); }
    }
    store_row((float*)(p.ws + OFF_X) + (size_t)t * 1024, lane, y);
    ln16(y);
#pragma unroll
    for (int i = 0; i < 16; ++i) y[i] = y[i] * (1.f + sc[i]) + sh[i];
    store_row_bf((bf16_t*)(p.ws + OFF_H) + (size_t)t * 1024, lane, y);
  }
}

constexpr float U_SCALE = 32.f;
DI void convert_tables(const Params& p, int l, int bid, int nb) {
  const size_t n16 = (size_t)16384 * 1024 / 16;
  for (int tb = 0; tb < 2; ++tb) {
    const float* src = p.in[tb ? I_PV : I_PU] + (size_t)l * 16384 * 1024;
    uint4* dst = (uint4*)(p.ws + (tb ? OFF_TABV : OFF_TABU));
    const float sc = tb ? 1.f : U_SCALE;
    for (size_t i = (size_t)bid * NTHR + tidx(); i < n16; i += (size_t)nb * NTHR) {
      const float4* s4 = (const float4*)(src + i * 16);
      float4 a = s4[0], b = s4[1], c = s4[2], d = s4[3];
      uint4 o;
      o.x = pk_fp8x4(a.x * sc, a.y * sc, a.z * sc, a.w * sc); o.y = pk_fp8x4(b.x * sc, b.y * sc, b.z * sc, b.w * sc);
      o.z = pk_fp8x4(c.x * sc, c.y * sc, c.z * sc, c.w * sc); o.w = pk_fp8x4(d.x * sc, d.y * sc, d.z * sc, d.w * sc);
      dst[i] = o;
    }
  }
}

DI void phase_e1(const Params& p, unsigned char* smem, int l, int bid, int nb) {
  const int j = l >> 1;
  bf16_t* As = (bf16_t*)smem; bf16_t* Bs = As + 128 * LDT;
  const bf16_t* H = (const bf16_t*)(p.ws + OFF_H);
  const bf16_t* Bt = (const bf16_t*)(p.ws + OFF_BT_IN_E) + (size_t)j * 2560 * 1024;
  bf16_t* PQT = (bf16_t*)(p.ws + OFF_Z);
  bf16_t* ZC = (bf16_t*)(p.ws + OFF_Z + 40 * MiB);
  for (int it = bid; it < 160 * 20; it += nb) {
    const int mt = it / 20, nt = it % 20, t0 = mt * 128;
    f32x16 acc[2][2];
    if (nt < 8) {
      gemm_mainloop<true>(H + (size_t)t0 * 1024, 1024, Bt + (size_t)nt * 128 * 1024, 1024, 1024, acc, As, Bs);
      int seq, s0, S, cv; tok_info(t0, seq, s0, S, cv);
      bf16_t* base = PQT + pqt_base(seq);
      const int S2 = 2 * S;
      gemm_epilogue<true>(acc, [&](int m, int n, float v) {
        int ng = nt * 128 + n; int which = ng >> 9, ch = ng & 511;
        base[(size_t)ch * S2 + which * S + s0 + m] = (bf16_t)f2bf(v);
      });
    } else {
      gemm_mainloop<false>(H + (size_t)t0 * 1024, 1024, Bt + (size_t)nt * 128 * 1024, 1024, 1024, acc, As, Bs);
      gemm_epilogue<false>(acc, [&](int m, int n, float v) {
        ZC[(size_t)(t0 + m) * 1536 + (nt - 8) * 128 + n] = (bf16_t)f2bf(v);
      });
    }
  }
  convert_tables(p, l, bid, nb);
}

DI void phase_e2(const Params& p, unsigned char* smem, int l, int bid, int nb) {
  const int j = l >> 1;
  bf16_t* As = (bf16_t*)smem; bf16_t* Bs = As + 128 * LDT;
  const bf16_t* PQT = (const bf16_t*)(p.ws + OFF_Z);
  const bf16_t* ZC = (const bf16_t*)(p.ws + OFF_Z + 40 * MiB);
  bf16_t* YM = (bf16_t*)(p.ws + OFF_YMIX);
  for (int it = bid; it < 640 + 1280; it += nb) {
    if (it < 640) {
      int seq, mt, nt, S, t0; const bf16_t* A;
      if (it < 512) { seq = 16 + it / 128; int r = it % 128; mt = r >> 2; nt = r & 3; S = 4096; A = (const bf16_t*)(p.ws + OFF_D4096) + (size_t)mt * 128 * 8192; t0 = 4096 + (seq - 16) * 4096 + mt * 128; }
      else { int r = it - 512; seq = r >> 3; mt = (r & 7) >> 2; nt = r & 3; S = 256; A = (const bf16_t*)(p.ws + OFF_D256) + (size_t)mt * 128 * 512; t0 = seq * 256 + mt * 128; }
      const bf16_t* B = PQT + pqt_base(seq) + (size_t)nt * 128 * (2 * S);
      f32x16 acc[2][2];
      gemm_mainloop<false>(A, 2 * S, B, 2 * S, 2 * S, acc, As, Bs);
      const float scale = rsqrtf(128.f * (float)S);
      gemm_epilogue<false>(acc, [&](int m, int n, float v) {
        YM[(size_t)(t0 + m) * 1024 + nt * 128 + n] = (bf16_t)f2bf(v * scale);
      });
    } else {
      const int t0 = (it - 640) * 16, c = tidx() * 2;
      int seq, s0, S, cv; tok_info(t0, seq, s0, S, cv);
      const float* cw = p.in[I_SCW] + (size_t)j * 3 * 512;
      const float w0a = cw[c], w0b = cw[c + 1], w1a = cw[512 + c], w1b = cw[512 + c + 1], w2a = cw[1024 + c], w2b = cw[1024 + c + 1];
      const float ba = p.in[I_SCB][j * 512 + c], bb = p.in[I_SCB][j * 512 + c + 1];
      auto uval = [&](int t, float& ua, float& ub) {
        unsigned cg_ = *(const unsigned*)(ZC + (size_t)t * 1536 + 512 + c);
        unsigned xi = *(const unsigned*)(ZC + (size_t)t * 1536 + 1024 + c);
        ua = bflo(cg_) * bflo(xi); ub = bfhi(cg_) * bfhi(xi);
      };
      float pa = 0.f, pb = 0.f, ca, cb, na, nb_;
      if (s0 > 0) uval(t0 - 1, pa, pb);
      uval(t0, ca, cb);
      for (int i = 0; i < 16; ++i) {
        const int t = t0 + i;
        na = 0.f; nb_ = 0.f;
        if (s0 + i + 1 < S) uval(t + 1, na, nb_);
        unsigned bg = *(const unsigned*)(ZC + (size_t)t * 1536 + c);
        float ya = bflo(bg) * (w0a * pa + w1a * ca + w2a * na + ba);
        float yb = bfhi(bg) * (w0b * pb + w1b * cb + w2b * nb_ + bb);
        *(unsigned*)(YM + (size_t)t * 1024 + 512 + c) = pack2(ya, yb);
        pa = ca; pb = cb; ca = na; cb = nb_;
      }
    }
  }
}

DI void phase_outgemm(const Params& p, unsigned char* smem, const bf16_t* Bt, int bid, int nb) {
  bf16_t* As = (bf16_t*)smem; bf16_t* Bs = As + 128 * LDT;
  const bf16_t* YM = (const bf16_t*)(p.ws + OFF_YMIX);
  float* MIX = (float*)(p.ws + OFF_MIX);
  for (int it = bid; it < 160 * 8; it += nb) {
    const int mt = it >> 3, nt = it & 7, t0 = mt * 128;
    f32x16 acc[2][2];
    gemm_mainloop<false>(YM + (size_t)t0 * 1024, 1024, Bt + (size_t)nt * 128 * 1024, 1024, 1024, acc, As, Bs);
    gemm_epilogue<false>(acc, [&](int m, int n, float v) { MIX[(size_t)(t0 + m) * 1024 + nt * 128 + n] = v; });
  }
}

DI void phase_res1(const Params& p, int l, int bid, int nb) {
  const int lane = tidx() & 63, wave = tidx() >> 6;
  float* X = (float*)(p.ws + OFF_X);
  const float* MIX = (const float*)(p.ws + OFF_MIX);
  float lg[16], lb[16], g1[16], sc[16], sh[16];
  load_row(p.in[I_LN1G] + l * 1024, lane, lg);
  load_row(p.in[I_LN1B] + l * 1024, lane, lb);
  int cvl = -1;
  for (int t = bid * 4 + wave; t < T; t += nb * 4) {
    int seq, s, S, cv; tok_info(t, seq, s, S, cv);
    if (cv != cvl) {
      const float* mod = (const float*)(p.ws + OFF_MOD) + (size_t)(l * 5 + cv) * 6144;
      load_row(mod + 2 * 1024, lane, g1); load_row(mod + 4 * 1024, lane, sc); load_row(mod + 3 * 1024, lane, sh);
      cvl = cv;
    }
    float x[16], m[16];
    load_row(X + (size_t)t * 1024, lane, x);
    load_row(MIX + (size_t)t * 1024, lane, m);
#pragma unroll
    for (int i = 0; i < 16; ++i) x[i] = ALPHA_F * x[i] + g1[i] * m[i];
    ln16(x);
#pragma unroll
    for (int i = 0; i < 16; ++i) x[i] = x[i] * lg[i] + lb[i];
    store_row(X + (size_t)t * 1024, lane, x);
    ln16(x);
#pragma unroll
    for (int i = 0; i < 16; ++i) x[i] = x[i] * (1.f + sc[i]) + sh[i];
    store_row_bf((bf16_t*)(p.ws + OFF_H) + (size_t)t * 1024, lane, x);
  }
}

DI void insert16(float (&tv)[16], int (&ti)[16], float x, int xi) {
#pragma unroll
  for (int k = 0; k < 16; ++k) {
    bool gt = x > tv[k];
    float ov = tv[k]; int oi = ti[k];
    tv[k] = gt ? x : ov; ti[k] = gt ? xi : oi;
    x = gt ? ov : x; xi = gt ? oi : xi;
  }
}
DI void phase_p1(const Params& p, unsigned char* smem, int l, int bid, int nb) {
  const int tid = tidx(), lane = tid & 63, wave = tid >> 6;
  const int wm = wave >> 1, wn = wave & 1;
  bf16_t* As = (bf16_t*)smem; bf16_t* Bs = As + 128 * LDT;
  bf16_t* Qs = (bf16_t*)smem;
  bf16_t* Ks = (bf16_t*)(smem + 36864);
  float* Sc = (float*)smem;
  float* Lv = (float*)smem;
  int* Li = (int*)(smem + 8192);
  const bf16_t* H = (const bf16_t*)(p.ws + OFF_H);
  const bf16_t* Bt = (const bf16_t*)(p.ws + OFF_BT_WQ) + (size_t)l * 2048 * 1024;
  float* TKV = (float*)(p.ws + OFF_WD);
  int* TKI = (int*)(p.ws + OFF_WD + 20 * MiB);
  for (int it = bid; it < 160 * 16; it += nb) {
    const int mt = it >> 4, hp = it & 15, t0 = mt * 128;
    f32x16 acc[2][2];
    gemm_mainloop<false>(H + (size_t)t0 * 1024, 1024, Bt + (size_t)hp * 128 * 1024, 1024, 1024, acc, As, Bs);
    {
      const float* kp = p.in[I_KEYS] + (size_t)(l * 16 + hp) * 16384;
#pragma unroll 4
      for (int i = 0; i < 16; ++i) {
        int idx = i * 256 + tid;
        int row = idx >> 5, c4 = idx & 31;
        float4 v = *(const float4*)(kp + row * 128 + c4 * 4);
        uint2 u; u.x = pack2(v.x, v.y); u.y = pack2(v.z, v.w);
        *(uint2*)(Ks + row * 136 + c4 * 4) = u;
      }
    }
    __syncthreads();
    gemm_epilogue<false>(acc, [&](int m, int n, float v) { Qs[m * 136 + n] = (bf16_t)f2bf(v); });
    __syncthreads();
#pragma unroll
    for (int mi = 0; mi < 2; ++mi)
#pragma unroll
      for (int ni = 0; ni < 2; ++ni)
#pragma unroll
        for (int r = 0; r < 16; ++r) acc[mi][ni][r] = 0.f;
    {
      const int fr = (lane & 31) * 136 + (lane >> 5) * 8;
#pragma unroll
      for (int kk = 0; kk < 8; ++kk) {
        bf16x8 af[2], bfr[2];
#pragma unroll
        for (int mi = 0; mi < 2; ++mi) af[mi] = *(const bf16x8*)(Qs + (wm * 64 + mi * 32) * 136 + fr + kk * 16);
#pragma unroll
        for (int ni = 0; ni < 2; ++ni) bfr[ni] = *(const bf16x8*)(Ks + (wn * 64 + ni * 32) * 136 + fr + kk * 16);
#pragma unroll
        for (int mi = 0; mi < 2; ++mi)
#pragma unroll
          for (int ni = 0; ni < 2; ++ni) acc[mi][ni] = MFMA(af[mi], bfr[ni], acc[mi][ni]);
      }
    }
    __syncthreads();
    gemm_epilogue<false>(acc, [&](int m, int n, float v) { Sc[m * 129 + n] = v; });
    __syncthreads();
    const int row = tid & 127, half = tid >> 7;
    float tv[16]; int ti[16];
#pragma unroll
    for (int k = 0; k < 16; ++k) { tv[k] = -3.0e38f; ti[k] = 0; }
    for (int e = 0; e < 64; ++e) insert16(tv, ti, Sc[row * 129 + half * 64 + e], half * 64 + e);
    __syncthreads();
    if (half == 1) {
#pragma unroll
      for (int k = 0; k < 16; ++k) { Lv[k * 128 + row] = tv[k]; Li[k * 128 + row] = ti[k]; }
    }
    __syncthreads();
    if (half == 0) {
#pragma unroll
      for (int k = 0; k < 16; ++k) insert16(tv, ti, Lv[k * 128 + row], Li[k * 128 + row]);
      float* ov = TKV + ((size_t)(t0 + row) * 16 + hp) * 16;
      int* oi = TKI + ((size_t)(t0 + row) * 16 + hp) * 16;
#pragma unroll
      for (int k = 0; k < 16; k += 4) {
        *(float4*)(ov + k) = make_float4(tv[k], tv[k + 1], tv[k + 2], tv[k + 3]);
        *(int4*)(oi + k) = make_int4(ti[k], ti[k + 1], ti[k + 2], ti[k + 3]);
      }
    }
  }
}

DI void phase_p2(const Params& p, unsigned char* smem, int l, int bid, int nb) {
  const int lane = tidx() & 63, wave = tidx() >> 6;
  int* sIdx = (int*)(smem + wave * 1024);
  float* sSc = (float*)(smem + wave * 1024 + 512);
  const bf16_t* H = (const bf16_t*)(p.ws + OFF_H);
  const float* TKV = (const float*)(p.ws + OFF_WD);
  const int* TKI = (const int*)(p.ws + OFF_WD + 20 * MiB);
  const bf16_t* TU = (const bf16_t*)(p.ws + OFF_TABU);
  const bf16_t* TV = (const bf16_t*)(p.ws + OFF_TABV);
  float* X = (float*)(p.ws + OFF_X);
  int ci = 0, cj = 0;
  {
    int q = lane;
    if (q < 16) { ci = 0; cj = q; } else if (q < 24) { ci = 1; cj = q - 16; } else if (q < 29) { ci = 2; cj = q - 24; }
    else if (q < 33) { ci = 3; cj = q - 29; } else if (q < 36) { ci = 4; cj = q - 33; }
    else if (q < 42) { ci = 5 + ((q - 36) >> 1); cj = (q - 36) & 1; } else if (q < 50) { ci = 8 + (q - 42); cj = 0; }
  }
  float plg[16], plb[16], pg2[16];
  load_row16(p.in[I_LN2G] + l * 1024, lane, plg);
  load_row16(p.in[I_LN2B] + l * 1024, lane, plb);
  int cvl = -1;
  for (int t = bid * 4 + wave; t < T; t += nb * 4) {
    int seq, s, S, cv; tok_info(t, seq, s, S, cv);
    float hreg[16];
    {
      const uint4* hp_ = (const uint4*)(H + (size_t)t * 1024 + lane * 16);
      uint4 a = hp_[0], b = hp_[1];
      float v0[8], v1[8]; unpack8(a, v0); unpack8(b, v1);
#pragma unroll
      for (int i = 0; i < 8; ++i) { hreg[i] = v0[i]; hreg[8 + i] = v1[i]; }
    }
    __builtin_amdgcn_wave_barrier();
    for (int h = 0; h < 8; ++h) {
      const float* v1p = TKV + ((size_t)t * 16 + h * 2) * 16;
      const int* i1p = TKI + ((size_t)t * 16 + h * 2) * 16;
      float c = -3.0e38f; int eidx = 0;
      if (lane < 50) { c = v1p[ci] + v1p[16 + cj]; eidx = i1p[ci] * 128 + i1p[16 + cj]; }
      int rank = 0;
#pragma unroll 5
      for (int m = 0; m < 50; ++m) {
        float cm = __int_as_float(__builtin_amdgcn_readlane(__float_as_int(c), m));
        rank += (cm > c || (cm == c && m < lane)) ? 1 : 0;
      }
      if (lane < 50 && rank < 16) { sIdx[h * 16 + rank] = eidx; sSc[h * 16 + rank] = c; }
    }
    __builtin_amdgcn_wave_barrier();
    {
      float s0 = sSc[lane], s1 = sSc[64 + lane];
      float m0 = max16(s0), m1 = max16(s1);
      float e0 = __expf(s0 - m0), e1 = __expf(s1 - m1);
      float d0 = sum16(e0), d1 = sum16(e1);
      __builtin_amdgcn_wave_barrier();
      sSc[lane] = e0 / d0; sSc[64 + lane] = e1 / d1;
    }
    __builtin_amdgcn_wave_barrier();
    float out[16];
#pragma unroll
    for (int i = 0; i < 16; ++i) out[i] = 0.f;
    const unsigned char* TU8 = (const unsigned char*)TU;
    const unsigned char* TV8 = (const unsigned char*)TV;
    for (int sb = 0; sb < 128; sb += 8) {
      uint4 u[8], w[8]; float gt[8];
#pragma unroll
      for (int k = 0; k < 8; ++k) {
        int e = __builtin_amdgcn_readfirstlane(sIdx[sb + k]);
        gt[k] = sSc[sb + k];
        u[k] = *(const uint4*)(TU8 + (size_t)e * 1024 + lane * 16);
        w[k] = *(const uint4*)(TV8 + (size_t)e * 1024 + lane * 16);
      }
      float dot[8];
#pragma unroll
      for (int k = 0; k < 8; ++k) {
        float a[16]; unpack_fp8x16(u[k], a);
        float d = 0.f;
#pragma unroll
        for (int i = 0; i < 16; ++i) d += hreg[i] * a[i];
        dot[k] = d;
      }
#pragma unroll
      for (int k = 0; k < 8; ++k) dot[k] = wave_sum(dot[k]);
#pragma unroll
      for (int k = 0; k < 8; ++k) {
        float wgt = gt[k] * gelu_t(dot[k] * (1.f / U_SCALE));
        float a[16]; unpack_fp8x16(w[k], a);
#pragma unroll
        for (int i = 0; i < 16; ++i) out[i] += wgt * a[i];
      }
    }
    if (cv != cvl) {
      const float* mod = (const float*)(p.ws + OFF_MOD) + (size_t)(l * 5 + cv) * 6144;
      load_row16(mod + 5 * 1024, lane, pg2);
      cvl = cv;
    }
    float x[16];
    load_row16(X + (size_t)t * 1024, lane, x);
#pragma unroll
    for (int i = 0; i < 16; ++i) x[i] = ALPHA_F * x[i] + pg2[i] * out[i];
    ln16(x);
#pragma unroll
    for (int i = 0; i < 16; ++i) x[i] = x[i] * plg[i] + plb[i];
    if (l == 3) {
      store_row16(p.out + (size_t)t * 1024, lane, x);
    } else {
      store_row16(X + (size_t)t * 1024, lane, x);
      ln16(x);
      {
        float psc[16], psh[16];
        const float* modn = (const float*)(p.ws + OFF_MOD) + (size_t)((l + 1) * 5 + cv) * 6144;
        load_row16(modn + 1024, lane, psc); load_row16(modn, lane, psh);
#pragma unroll
        for (int i = 0; i < 16; ++i) x[i] = x[i] * (1.f + psc[i]) + psh[i];
      }
      store_row16_bf((bf16_t*)(p.ws + OFF_H) + (size_t)t * 1024, lane, x);
    }
  }
}

DI void phase_o1(const Params& p, unsigned char* smem, int l, int bid, int nb) {
  const int j = l >> 1;
  bf16_t* As = (bf16_t*)smem; bf16_t* Bs = As + 128 * LDT;
  const bf16_t* H = (const bf16_t*)(p.ws + OFF_H);
  const bf16_t* Bt = (const bf16_t*)(p.ws + OFF_BT_IN_O) + (size_t)j * 2944 * 1024;
  bf16_t* Z = (bf16_t*)(p.ws + OFF_Z);
  for (int it = bid; it < 160 * 23; it += nb) {
    const int mt = it / 23, nt = it % 23, t0 = mt * 128;
    f32x16 acc[2][2];
    gemm_mainloop<false>(H + (size_t)t0 * 1024, 1024, Bt + (size_t)nt * 128 * 1024, 1024, 1024, acc, As, Bs);
    gemm_epilogue<false>(acc, [&](int m, int n, float v) { Z[(size_t)(t0 + m) * 2944 + nt * 128 + n] = (bf16_t)f2bf(v); });
  }
  convert_tables(p, l, bid, nb);
}

DI void phase_o2(const Params& p, int l, int bid, int nb) {
  const int j = l >> 1;
  const int lane = tidx() & 63, wave = tidx() >> 6;
  const bf16_t* Z = (const bf16_t*)(p.ws + OFF_Z);
  bf16_t* XC = (bf16_t*)(p.ws + OFF_XC);
  bf16_t* LRIN = (bf16_t*)(p.ws + OFF_LRIN);
  bf16_t* KKN = (bf16_t*)(p.ws + OFF_KKN);
  bf16_t* KS = (bf16_t*)(p.ws + OFF_KS);
  bf16_t* RS = (bf16_t*)(p.ws + OFF_RS);
  bf16_t* VS = (bf16_t*)(p.ws + OFF_VS);
  const float* mu = p.in[I_MU] + (size_t)j * 1920;
  const int c0 = lane * 8;
  for (int t = bid * 4 + wave; t < T; t += nb * 4) {
    int seq, s, S, cv; tok_info(t, seq, s, S, cv);
    const bf16_t* zr = Z + (size_t)t * 2944;
    {
      float af[8], ab[8];
      load8f(p.in[I_LCB] + (size_t)(j * 2 + 0) * 512 + c0, af);
      load8f(p.in[I_LCB] + (size_t)(j * 2 + 1) * 512 + c0, ab);
#pragma unroll
      for (int o = -3; o <= 3; ++o) {
        float xv[8];
        if (s + o >= 0 && s + o < S) { uint4 u = *(const uint4*)(zr + (ptrdiff_t)o * 2944 + c0); unpack8(u, xv); }
        else {
#pragma unroll
          for (int i = 0; i < 8; ++i) xv[i] = 0.f;
        }
        if (o <= 0) {
          float w[8]; load8f(p.in[I_LCW] + ((size_t)(j * 2 + 0) * 4 + (o + 3)) * 512 + c0, w);
#pragma unroll
          for (int i = 0; i < 8; ++i) af[i] += w[i] * xv[i];
        }
        if (o >= 0) {
          float w[8]; load8f(p.in[I_LCW] + ((size_t)(j * 2 + 1) * 4 + (3 - o)) * 512 + c0, w);
#pragma unroll
          for (int i = 0; i < 8; ++i) ab[i] += w[i] * xv[i];
        }
      }
      *(uint4*)(XC + (size_t)t * 512 + c0) = pack8(af);
      *(uint4*)(XC + (size_t)T * 512 + (size_t)t * 512 + c0) = pack8(ab);
    }
    const bool hp_ = s > 0, hn = s < S - 1;
#pragma unroll
    for (int part = 0; part < 3; ++part) {
      const int col = 1024 + part * 512 + c0;
      float zc[8], zp[8], zn[8], m[8], zs[8];
      unpack8(*(const uint4*)(zr + col), zc);
      if (hp_) unpack8(*(const uint4*)(zr - 2944 + col), zp); else {
#pragma unroll
        for (int i = 0; i < 8; ++i) zp[i] = 0.f;
      }
      if (hn) unpack8(*(const uint4*)(zr + 2944 + col), zn); else {
#pragma unroll
        for (int i = 0; i < 8; ++i) zn[i] = 0.f;
      }
      load8f(mu + (col - 1024), m);
#pragma unroll
      for (int i = 0; i < 8; ++i) zs[i] = zc[i] + m[i] * (0.5f * (zp[i] + zn[i]) - zc[i]);
      if (part == 0) *(uint4*)(RS + (size_t)t * 512 + c0) = pack8(zs);
      else if (part == 2) *(uint4*)(VS + (size_t)t * 512 + c0) = pack8(zs);
      else {
        *(uint4*)(KS + (size_t)t * 512 + c0) = pack8(zs);
#pragma unroll
        for (int d = 0; d < 2; ++d) {
          float kk[8], raw[8]; load8f(p.in[I_KK] + (size_t)(j * 2 + d) * 512 + c0, kk);
          float ss = 0.f;
#pragma unroll
          for (int i = 0; i < 8; ++i) { raw[i] = zs[i] * kk[i]; ss += raw[i] * raw[i]; }
          ss = sum8(ss);
          float inv = rsqrtf(fmaxf(ss, 1e-24f));
#pragma unroll
          for (int i = 0; i < 8; ++i) raw[i] *= inv;
          *(uint4*)(KKN + (size_t)d * T * 512 + (size_t)t * 512 + c0) = pack8(raw);
        }
      }
    }
    if (lane < 48) {
      const int col = 2560 + c0;
      float zc[8], zp[8], zn[8], m[8], zs[8];
      unpack8(*(const uint4*)(zr + col), zc);
      if (hp_) unpack8(*(const uint4*)(zr - 2944 + col), zp); else {
#pragma unroll
        for (int i = 0; i < 8; ++i) zp[i] = 0.f;
      }
      if (hn) unpack8(*(const uint4*)(zr + 2944 + col), zn); else {
#pragma unroll
        for (int i = 0; i < 8; ++i) zn[i] = 0.f;
      }
      load8f(mu + (col - 1024), m);
#pragma unroll
      for (int i = 0; i < 8; ++i) {
        float z = zc[i] + m[i] * (0.5f * (zp[i] + zn[i]) - zc[i]);
        zs[i] = (lane < 16) ? tanh_f(z) : ((lane < 32) ? z : sigm(z));
      }
      *(uint4*)(LRIN + (size_t)t * 384 + c0) = pack8(zs);
    }
  }
}

DI void store8f(float* p, const float (&v)[8]) {
  ((float4*)p)[0] = make_float4(v[0], v[1], v[2], v[3]);
  ((float4*)p)[1] = make_float4(v[4], v[5], v[6], v[7]);
}
template <class F>
DI void staged_epilogue(const f32x16 (&acc)[2][2], float* Cs, F f) {
  __syncthreads();
  gemm_epilogue<false, false>(acc, [&](int m, int n, float v) { Cs[m * 132 + n] = v; });
  __syncthreads();
  const int tid = tidx(), r0 = tid >> 4, c8 = (tid & 15) * 8;
#pragma unroll 2
  for (int ps = 0; ps < 8; ++ps) {
    const int row = ps * 16 + r0;
    float v[8];
    load8f(Cs + row * 132 + c8, v);
    f(row, c8, v);
  }
}

DI void phase_o3(const Params& p, unsigned char* smem, int l, int bid, int nb) {
  const int j = l >> 1;
  bf16_t* As = (bf16_t*)smem; bf16_t* Bs = As + 128 * LDT;
  float* Cs = (float*)smem;
  const bf16_t* __restrict__ XC = (const bf16_t*)(p.ws + OFF_XC);
  const bf16_t* __restrict__ LRIN = (const bf16_t*)(p.ws + OFF_LRIN);
  const bf16_t* __restrict__ KKN = (const bf16_t*)(p.ws + OFF_KKN);
  const bf16_t* __restrict__ KS = (const bf16_t*)(p.ws + OFF_KS);
  float* __restrict__ LA = (float*)(p.ws + OFF_MIX);
  bf16_t* __restrict__ LB = (bf16_t*)(p.ws + OFF_LB);
  float* __restrict__ WD = (float*)(p.ws + OFF_WD);
  bf16_t* __restrict__ KKA = (bf16_t*)(p.ws + OFF_KKA);
  bf16_t* __restrict__ KM = (bf16_t*)(p.ws + OFF_KM);
  bf16_t* __restrict__ G = (bf16_t*)(p.ws + OFF_G);
  const int c8 = (tidx() & 15) * 8;
  for (int it = bid; it < 160 * 28; it += nb) {
    const int mt = it / 28, jb = it % 28, t0 = mt * 128;
    if (jb < 8) {
      const int d = jb >> 2, nt = jb & 3, ng = nt * 128 + c8;
      const bf16_t* A = XC + (size_t)d * T * 512 + (size_t)t0 * 512 + nt * 128;
      const bf16_t* Br = (const bf16_t*)(p.ws + OFF_BT_GATE) + ((size_t)((j * 2 + d) * 2 + 0) * 512 + nt * 128) * 128;
      const bf16_t* Bi = (const bf16_t*)(p.ws + OFF_BT_GATE) + ((size_t)((j * 2 + d) * 2 + 1) * 512 + nt * 128) * 128;
      float ba8[8], bx8[8], sp8[8];
      load8f(p.in[I_LBA] + (size_t)(j * 2 + d) * 512 + ng, ba8);
      load8f(p.in[I_LBX] + (size_t)(j * 2 + d) * 512 + ng, bx8);
      load8f(p.in[I_LLAM] + (size_t)(j * 2 + d) * 512 + ng, sp8);
#pragma unroll
      for (int i = 0; i < 8; ++i) { float nl = -sp8[i]; sp8[i] = -8.f * (nl > 20.f ? nl : log1pf(__expf(nl))); }
      {
        f32x16 acc[2][2];
        gemm_mainloop<false>(A, 512, Br, 128, 128, acc, As, Bs);
        staged_epilogue(acc, Cs, [&](int row, int cc, const float (&v)[8]) {
          const size_t o = ((size_t)d * T + t0 + row) * 512 + nt * 128 + cc;
          float a[8];
#pragma unroll
          for (int i = 0; i < 8; ++i) a[i] = __expf(sigm(v[i] + ba8[i]) * sp8[i]);
          store8f(LA + o, a);
        });
      }
      {
        f32x16 acc[2][2];
        gemm_mainloop<false>(A, 512, Bi, 128, 128, acc, As, Bs);
        staged_epilogue(acc, Cs, [&](int row, int cc, const float (&v)[8]) {
          const size_t o = ((size_t)d * T + t0 + row) * 512 + nt * 128 + cc;
          float a[8], xc[8], bb[8];
          load8f(LA + o, a);
          unpack8(*(const uint4*)(XC + o), xc);
#pragma unroll
          for (int i = 0; i < 8; ++i) bb[i] = sqrtf(fmaxf(1.f - a[i] * a[i], 0.f)) * sigm(v[i] + bx8[i]) * xc[i];
          *(uint4*)(LB + o) = pack8(bb);
        });
      }
    } else if (jb < 16) {
      const int d = (jb - 8) >> 2, nt = (jb - 8) & 3, ng = nt * 128 + c8;
      float w08[8]; load8f(p.in[I_W0] + (size_t)(j * 2 + d) * 512 + ng, w08);
      f32x16 acc[2][2];
      gemm_mainloop<false>(LRIN + (size_t)t0 * 384 + d * 64, 384, (const bf16_t*)(p.ws + OFF_BT_W2) + ((size_t)(j * 2 + d) * 512 + nt * 128) * 64, 64, 64, acc, As, Bs);
      staged_epilogue(acc, Cs, [&](int row, int cc, const float (&v)[8]) {
        float w[8];
#pragma unroll
        for (int i = 0; i < 8; ++i) w[i] = __expf(-0.6065306597126334f * sigm(w08[i] + v[i]));
        store8f(WD + ((size_t)d * T + t0 + row) * 512 + nt * 128 + cc, w);
      });
    } else if (jb < 24) {
      const int d = (jb - 16) >> 2, nt = (jb - 16) & 3, ng = nt * 128 + c8;
      float a08[8], ka8[8];
      load8f(p.in[I_A0] + (size_t)(j * 2 + d) * 512 + ng, a08);
      load8f(p.in[I_KA] + (size_t)(j * 2 + d) * 512 + ng, ka8);
      f32x16 acc[2][2];
      gemm_mainloop<false>(LRIN + (size_t)t0 * 384 + 128 + d * 64, 384, (const bf16_t*)(p.ws + OFF_BT_A2) + ((size_t)(j * 2 + d) * 512 + nt * 128) * 64, 64, 64, acc, As, Bs);
      staged_epilogue(acc, Cs, [&](int row, int cc, const float (&v)[8]) {
        const size_t o = ((size_t)d * T + t0 + row) * 512 + nt * 128 + cc;
        float kkn[8], ks[8], oa[8], om[8];
        unpack8(*(const uint4*)(KKN + o), kkn);
        unpack8(*(const uint4*)(KS + (size_t)(t0 + row) * 512 + nt * 128 + cc), ks);
#pragma unroll
        for (int i = 0; i < 8; ++i) {
          float ic = sigm(a08[i] + v[i]);
          oa[i] = kkn[i] * ic;
          om[i] = ks[i] * (1.f + (ic - 1.f) * ka8[i]);
        }
        *(uint4*)(KKA + o) = pack8(oa);
        *(uint4*)(KM + o) = pack8(om);
      });
    } else {
      const int nt = jb - 24;
      f32x16 acc[2][2];
      gemm_mainloop<false>(LRIN + (size_t)t0 * 384 + 256, 384, (const bf16_t*)(p.ws + OFF_BT_G2) + ((size_t)j * 512 + nt * 128) * 128, 128, 128, acc, As, Bs);
      staged_epilogue(acc, Cs, [&](int row, int cc, const float (&v)[8]) {
        float g[8];
#pragma unroll
        for (int i = 0; i < 8; ++i) g[i] = v[i];
        *(uint4*)(G + (size_t)(t0 + row) * 512 + nt * 128 + cc) = pack8(g);
      });
    }
  }
}

constexpr int WCH = 32;
constexpr int WBUF = 8192 + 4 * 4096 + 1024;
DI void wkv_scan_item(const Params& p, unsigned char* smem, int j, int b, int d, int h, int rg, bool ctx) {
  const int tid = tidx(), lane = tid & 63, wave = tid >> 6;
  const int rl = wave * 4 + (lane >> 4), row = rg * 16 + rl, q = lane & 15;
  const int S = ctx ? 256 : 4096, t0 = ctx ? b * 256 : 4096 + b * 4096;
  const char* WD = (const char*)(p.ws + OFF_WD) + (size_t)d * T * 512 * 4 + h * 256;
  const char* KKN = (const char*)(p.ws + OFF_KKN) + (size_t)d * T * 512 * 2 + h * 128;
  const char* KKA = (const char*)(p.ws + OFF_KKA) + (size_t)d * T * 512 * 2 + h * 128;
  const char* KM = (const char*)(p.ws + OFF_KM) + (size_t)d * T * 512 * 2 + h * 128;
  const char* RS = (const char*)(p.ws + OFF_RS) + h * 128;
  const char* VS = (const char*)(p.ws + OFF_VS) + (h * 64 + rg * 16) * 2;
  char* Y = (char*)(p.ws + (d ? OFF_XC : OFF_H)) + (h * 64 + rg * 16) * 4;
  unsigned char* ysb = smem + 2 * WBUF;
  float st[4];
  if (ctx) { st[0] = st[1] = st[2] = st[3] = 0.f; }
  else {
    float4 s4 = *(const float4*)(p.in[I_SWKV] + ((((size_t)(b * 2 + j) * 2 + d) * 8 + h) * 64 + row) * 64 + q * 4);
    st[0] = s4.x; st[1] = s4.y; st[2] = s4.z; st[3] = s4.w;
  }
  auto tokof = [&](int step) -> int { return t0 + (d ? (S - 1 - step) : step); };
  uint4 gw0, gw1, gk, gka, gkm, gr, gv;
  auto gload = [&](int c) {
    const int base = c * WCH;
    { int i0 = tid, i1 = tid + 256;
      gw0 = *(const uint4*)(WD + (unsigned)(tokof(base + (i0 >> 4)) * 2048 + (i0 & 15) * 16));
      gw1 = *(const uint4*)(WD + (unsigned)(tokof(base + (i1 >> 4)) * 2048 + (i1 & 15) * 16)); }
    const unsigned o2 = (unsigned)(tokof(base + (tid >> 3)) * 1024 + (tid & 7) * 16);
    gk = *(const uint4*)(KKN + o2); gka = *(const uint4*)(KKA + o2); gkm = *(const uint4*)(KM + o2); gr = *(const uint4*)(RS + o2);
    if (tid < 64) gv = *(const uint4*)(VS + (unsigned)(tokof(base + (tid >> 1)) * 1024 + (tid & 1) * 16));
  };
  auto lstore = [&](int bufi) {
    unsigned char* bb = smem + bufi * WBUF;
    *(uint4*)(bb + tid * 16) = gw0; *(uint4*)(bb + 4096 + tid * 16) = gw1;
    *(uint4*)(bb + 8192 + tid * 16) = gk; *(uint4*)(bb + 12288 + tid * 16) = gka;
    *(uint4*)(bb + 16384 + tid * 16) = gkm; *(uint4*)(bb + 20480 + tid * 16) = gr;
    if (tid < 64) *(uint4*)(bb + 24576 + tid * 16) = gv;
  };
  const int nch = S / WCH;
  __syncthreads();
  gload(0); lstore(0);
  __syncthreads();
  for (int c = 0; c < nch; ++c) {
    if (c + 1 < nch) gload(c + 1);
    const unsigned char* bb = smem + (c & 1) * WBUF;
    float* ys = (float*)(ysb + (c & 1) * 2048);
    float4 nw = *(const float4*)(bb + q * 16);
    uint2 nkk = *(const uint2*)(bb + 8192 + q * 8), nkka = *(const uint2*)(bb + 12288 + q * 8);
    uint2 nkm = *(const uint2*)(bb + 16384 + q * 8), nr = *(const uint2*)(bb + 20480 + q * 8);
    bf16_t nv = *(const bf16_t*)(bb + 24576 + rl * 2);
#pragma unroll 8
    for (int s = 0; s < WCH; ++s) {
      const float4 w = nw; const uint2 kk = nkk, kka = nkka, km = nkm, r = nr; const float v = bf2f(nv);
      {
        const int s1 = (s + 1 < WCH) ? s + 1 : s;
        nw = *(const float4*)(bb + s1 * 256 + q * 16);
        nkk = *(const uint2*)(bb + 8192 + s1 * 128 + q * 8); nkka = *(const uint2*)(bb + 12288 + s1 * 128 + q * 8);
        nkm = *(const uint2*)(bb + 16384 + s1 * 128 + q * 8); nr = *(const uint2*)(bb + 20480 + s1 * 128 + q * 8);
        nv = *(const bf16_t*)(bb + 24576 + s1 * 32 + rl * 2);
      }
      float sk = st[0] * bflo(kk.x) + st[1] * bfhi(kk.x) + st[2] * bflo(kk.y) + st[3] * bfhi(kk.y);
      sk = sum16(sk);
      st[0] = st[0] * w.x - sk * bflo(kka.x) + v * bflo(km.x);
      st[1] = st[1] * w.y - sk * bfhi(kka.x) + v * bfhi(km.x);
      st[2] = st[2] * w.z - sk * bflo(kka.y) + v * bflo(km.y);
      st[3] = st[3] * w.w - sk * bfhi(kka.y) + v * bfhi(km.y);
      float y = st[0] * bflo(r.x) + st[1] * bfhi(r.x) + st[2] * bflo(r.y) + st[3] * bfhi(r.y);
      y = sum16(y);
      ys[s * 16 + rl] = y;
    }
    if (c + 1 < nch) lstore((c + 1) & 1);
    __syncthreads();
    {
      const int base = c * WCH;
      const int s1 = tid >> 4, rr = tid & 15;
      *(float*)(Y + (unsigned)(tokof(base + s1) * 2048 + rr * 4)) = ys[s1 * 16 + rr];
      *(float*)(Y + (unsigned)(tokof(base + s1 + 16) * 2048 + rr * 4)) = ys[(s1 + 16) * 16 + rr];
    }
  }
  if (ctx) {
    float* o = p.out + 21004288 + ((((size_t)(b * 2 + j) * 2 + d) * 8 + h) * 64 + row) * 64 + q * 4;
    *(float4*)o = make_float4(st[0], st[1], st[2], st[3]);
  }
}

DI void lru_scan_item(const Params& p, unsigned char* smem, int j, int b, int cgp, bool ctx, int chb) {
  const int tid = tidx(), c = tid & ((1 << chb) - 1), sg = tid >> chb;
  const int nseg = NTHR >> chb;
  const int ch = (cgp << chb) + c;
  const int S = ctx ? 256 : 4096, t0 = ctx ? b * 256 : 4096 + b * 4096;
  const int L = S / nseg;
  float* sA = (float*)smem; float* sB = sA + 256;
  char* YM = (char*)(p.ws + OFF_YMIX);
  const char* Z = (const char*)(p.ws + OFF_Z);
  for (int d = 0; d < 2; ++d) {
    const char* la = (const char*)(p.ws + OFF_MIX) + (size_t)d * T * 512 * 4;
    const char* lb = (const char*)(p.ws + OFF_LB) + (size_t)d * T * 512 * 2;
    float A = 1.f, Bv = 0.f;
#pragma unroll 8
    for (int st = sg * L; st < (sg + 1) * L; ++st) {
      const int tk = t0 + (d ? (S - 1 - st) : st);
      float a = *(const float*)(la + (unsigned)(tk * 2048 + ch * 4));
      float bb = bf2f(*(const bf16_t*)(lb + (unsigned)(tk * 1024 + ch * 2)));
      A *= a; Bv = a * Bv + bb;
    }
    __syncthreads();
    sA[tid] = A; sB[tid] = Bv;
    __syncthreads();
    float h = ctx ? 0.f : p.in[I_SLRU][((size_t)(b * 2 + j) * 2 + d) * 512 + ch];
    for (int s2 = 0; s2 < sg; ++s2) h = sA[(s2 << chb) + c] * h + sB[(s2 << chb) + c];
#pragma unroll 8
    for (int st = sg * L; st < (sg + 1) * L; ++st) {
      const int tk = t0 + (d ? (S - 1 - st) : st);
      float a = *(const float*)(la + (unsigned)(tk * 2048 + ch * 4));
      float bb = bf2f(*(const bf16_t*)(lb + (unsigned)(tk * 1024 + ch * 2)));
      h = a * h + bb;
      bf16_t* ym = (bf16_t*)(YM + (unsigned)(tk * 2048 + ch * 2));
      if (d == 0) *ym = (bf16_t)f2bf(h);
      else {
        float hs = h + bf2f(*ym);
        float gb = bf2f(*(const bf16_t*)(Z + (unsigned)(tk * 5888 + 1024 + ch * 2)));
        *ym = (bf16_t)f2bf(hs * gelu_t(gb));
      }
    }
    if (ctx && sg == nseg - 1) p.out[20971520 + ((size_t)(b * 2 + j) * 2 + d) * 512 + ch] = h;
    __syncthreads();
  }
}

DI void phase_o4(const Params& p, unsigned char* smem, int l, int bid, int nb) {
  const int j = l >> 1;
  auto do_item = [&](int it) {
    if (it < 256) { int sid = it >> 2, rg = it & 3; wkv_scan_item(p, smem, j, sid >> 4, (sid >> 3) & 1, sid & 7, rg, false); }
    else if (it < 512) { int r = it - 256; lru_scan_item(p, smem, j, r >> 6, r & 63, false, 3); }
    else if (it < 1536) { int r = it - 512; int sid = r >> 2, rg = r & 3; wkv_scan_item(p, smem, j, sid >> 4, (sid >> 3) & 1, sid & 7, rg, true); }
    else { int r = it - 1536; lru_scan_item(p, smem, j, r >> 4, r & 15, true, 5); }
  };
  if (nb >= 512) {
    if (bid < 256) do_item(bid);
    else {
      const int ob = bid - 256, no = nb - 256;
      for (int it = 256 + ob; it < 512; it += no) do_item(it);
      for (int it = 512 + ob; it < 1792; it += no) do_item(it);
    }
  } else {
    for (int it = bid; it < 1792; it += nb) do_item(it);
  }
}

DI void phase_o5(const Params& p, int l, int bid, int nb) {
  const int j = l >> 1;
  const int lane = tidx() & 63, wave = tidx() >> 6;
  const float* YF = (const float*)(p.ws + OFF_H);
  const float* YB = (const float*)(p.ws + OFF_XC);
  const bf16_t* RS = (const bf16_t*)(p.ws + OFF_RS);
  const bf16_t* VS = (const bf16_t*)(p.ws + OFF_VS);
  const bf16_t* KM = (const bf16_t*)(p.ws + OFF_KM);
  const bf16_t* G = (const bf16_t*)(p.ws + OFF_G);
  bf16_t* YM = (bf16_t*)(p.ws + OFF_YMIX);
  const int c0 = lane * 8;
  float gng[8], gnb[8], rk[8];
  load8f(p.in[I_GNG] + j * 512 + c0, gng);
  load8f(p.in[I_GNB] + j * 512 + c0, gnb);
  load8f(p.in[I_RK] + j * 512 + c0, rk);
  for (int t = bid * 4 + wave; t < T; t += nb * 4) {
    const size_t o = (size_t)t * 512 + c0;
    float yf[8], yb[8], ys[8];
    load8f(YF + o, yf); load8f(YB + o, yb);
    float s = 0.f;
#pragma unroll
    for (int i = 0; i < 8; ++i) { ys[i] = yf[i] + yb[i]; s += ys[i]; }
    const float mean = sum8(s) * (1.f / 64.f);
    float v = 0.f;
#pragma unroll
    for (int i = 0; i < 8; ++i) { float dd = ys[i] - mean; v += dd * dd; }
    const float rstd = rsqrtf(sum8(v) * (1.f / 64.f) + 64e-5f);
    float r[8], vv[8], kf[8], kb[8], g[8];
    unpack8(*(const uint4*)(RS + o), r);
    unpack8(*(const uint4*)(VS + o), vv);
    unpack8(*(const uint4*)(KM + o), kf);
    unpack8(*(const uint4*)(KM + (size_t)T * 512 + o), kb);
    unpack8(*(const uint4*)(G + o), g);
    float sf = 0.f;
#pragma unroll
    for (int i = 0; i < 8; ++i) sf += r[i] * rk[i] * (kf[i] + kb[i]);
    sf = sum8(sf);
    float outv[8];
#pragma unroll
    for (int i = 0; i < 8; ++i) outv[i] = ((ys[i] - mean) * rstd * gng[i] + gnb[i] + sf * vv[i]) * g[i];
    *(uint4*)(YM + (size_t)t * 1024 + 512 + c0) = pack8(outv);
  }
}

enum { PH_PREP = 0, PH_INIT, PH_E1, PH_E2, PH_EOUT, PH_RES, PH_P1, PH_P2, PH_O1, PH_O2, PH_O3, PH_O4, PH_O5, PH_OOUT };

DI void run_phase(const Params& p, unsigned char* smem, int ph, int l, int bid, int nb) {
  switch (ph) {
    case PH_PREP: phase_prep(p, smem, bid, nb); break;
    case PH_INIT: phase_init(p, bid, nb); break;
    case PH_E1: phase_e1(p, smem, l, bid, nb); break;
    case PH_E2: phase_e2(p, smem, l, bid, nb); break;
    case PH_EOUT: phase_outgemm(p, smem, (const bf16_t*)(p.ws + OFF_BT_OUT_E) + (size_t)(l >> 1) * 1024 * 1024, bid, nb); break;
    case PH_RES: phase_res1(p, l, bid, nb); break;
    case PH_P1: phase_p1(p, smem, l, bid, nb); break;
    case PH_P2: phase_p2(p, smem, l, bid, nb); break;
    case PH_O1: phase_o1(p, smem, l, bid, nb); break;
    case PH_O2: phase_o2(p, l, bid, nb); break;
    case PH_O3: phase_o3(p, smem, l, bid, nb); break;
    case PH_O4: phase_o4(p, smem, l, bid, nb); break;
    case PH_O5: phase_o5(p, l, bid, nb); break;
    case PH_OOUT: phase_outgemm(p, smem, (const bf16_t*)(p.ws + OFF_BT_OUT_O) + (size_t)(l >> 1) * 1024 * 1024, bid, nb); break;
  }
}


#define XB_TMO      128
#define XB_XCNT(j)  (256  + 64 * (j))
#define XB_XSUB(j)  (1280 + 64 * (j))
#define XB_XGEN(j)  (2304 + 64 * (j))
#define XB_TOP      3328
#define XB_TOPGEN   3392
#define XCD_BAR_WORDS 3456
#define XB_SPIN_CAP (1u << 22)
#define LAS __attribute__((address_space(3)))
DI unsigned xb_ld(unsigned* p) { return __hip_atomic_load(p, __ATOMIC_RELAXED, __HIP_MEMORY_SCOPE_AGENT); }
DI unsigned xb_add(unsigned* p, unsigned v) { return __hip_atomic_fetch_add(p, v, __ATOMIC_RELAXED, __HIP_MEMORY_SCOPE_AGENT); }
DI unsigned xb_xcc_id() { return (unsigned)__builtin_amdgcn_s_getreg((3 << 11) | 20) & 0xFu; }
#define XB_SPIN(cond, bar) do { unsigned _sp = 0; while (cond) { __builtin_amdgcn_s_sleep(1); \
    if ((++_sp & 255u) == 0u) { if (xb_ld(&(bar)[XB_TMO])) break; if (_sp > XB_SPIN_CAP) { atomicAdd(&(bar)[XB_TMO], 1u); break; } } } } while (0)
struct XcdBarrier { unsigned* bar; unsigned x; volatile LAS unsigned* st; };
DI XcdBarrier xcd_barrier_post(unsigned* bar, volatile LAS unsigned* st) {
  XcdBarrier b; b.bar = bar; b.x = xb_xcc_id(); b.st = st;
  if (__builtin_amdgcn_workitem_id_x() == 0) (void)xb_add(&bar[XB_XCNT(b.x)], 1u);
  return b;
}
DI void xcd_barrier_complete(unsigned* bar, unsigned x, unsigned& nloc, unsigned& nx) {
  const unsigned G = gridDim.x;
  unsigned sum, cnt, mine, sp = 0u;
  for (;;) {
    sum = 0u; cnt = 0u; mine = 0u;
#pragma unroll
    for (unsigned j = 0; j < 16; ++j) { const unsigned c = xb_ld(&bar[XB_XCNT(j)]); sum += c; cnt += (c > 0u) ? 1u : 0u; mine = (j == x) ? c : mine; }
    if (sum == G) break;
    __builtin_amdgcn_s_sleep(1);
    if ((++sp & 255u) == 0u) { if (xb_ld(&bar[XB_TMO])) break; if (sp > XB_SPIN_CAP) { atomicAdd(&bar[XB_TMO], 1u); break; } }
  }
  nloc = mine > 0u ? mine : 1u; nx = cnt > 0u ? cnt : 1u;
}
DI void xcd_barrier(const XcdBarrier& b) {
  asm volatile("s_waitcnt vmcnt(0)" ::: "memory");
  __syncthreads();
  if (__builtin_amdgcn_workitem_id_x() == 0) {
    unsigned* bar = b.bar;
    __builtin_amdgcn_s_waitcnt(0);
    unsigned nloc = b.st[0], nx = b.st[1];
    if (nloc == 0u) { xcd_barrier_complete(bar, b.x, nloc, nx); b.st[0] = nloc; b.st[1] = nx; }
    const unsigned old = xb_add(&bar[XB_XSUB(b.x)], 1u);
    const unsigned gen = old / nloc;
    if (old + 1u == (gen + 1u) * nloc) {
      __builtin_amdgcn_fence(__ATOMIC_RELEASE, "agent");
      asm volatile("s_waitcnt vmcnt(0)" ::: "memory");
      const unsigned og = xb_add(&bar[XB_TOP], 1u);
      const unsigned tg = og / nx;
      if (og + 1u == (tg + 1u) * nx) xb_add(&bar[XB_TOPGEN], 1u);
      else XB_SPIN(xb_ld(&bar[XB_TOPGEN]) == tg, bar);
      __builtin_amdgcn_fence(__ATOMIC_ACQUIRE, "agent");
      xb_add(&bar[XB_XGEN(b.x)], 1u);
      asm volatile("s_waitcnt vmcnt(0)" ::: "memory");
    } else {
      XB_SPIN(xb_ld(&bar[XB_XGEN(b.x)]) == gen, bar);
      __builtin_amdgcn_fence(__ATOMIC_ACQUIRE, "agent");
      asm volatile("s_waitcnt vmcnt(0)" ::: "memory");
    }
  }
  __syncthreads();
}

DI void grid_seam(cg::grid_group& grid) {
  asm volatile("s_waitcnt vmcnt(0)" ::: "memory");
  grid.sync();
  asm volatile("buffer_inv sc1\n\ts_waitcnt vmcnt(0)" ::: "memory");
}
#if MULTI
__global__ void __launch_bounds__(NTHR, 2) phase_kernel(Params p, int ph, int l) {
  extern __shared__ __attribute__((aligned(16))) unsigned char smem[];
  run_phase(p, smem, ph, l, blockIdx.x, gridDim.x);
}
#else
#ifndef TPROBE
#define TPROBE 0
#endif
__global__ void __launch_bounds__(NTHR, 2) mega_kernel(Params p) {
  extern __shared__ __attribute__((aligned(16))) unsigned char smem[];
  cg::grid_group grid = cg::this_grid();
  const int bid = blockIdx.x, nb = gridDim.x;
  if (__builtin_amdgcn_workitem_id_x() == 0) *(uint4*)(smem + LDS_MAIN) = make_uint4(0u, 0u, 0u, 0u);
  __syncthreads();
  XcdBarrier xb = xcd_barrier_post((unsigned*)(p.ws + OFF_BAR), (volatile LAS unsigned*)(smem + LDS_MAIN));
#if TPROBE
  unsigned long long tprev = wall_clock64(), tsel = 0, ttot = 0;
#endif
  for (int step = 0; step < 32; ++step) {
    int ph, l;
    if (step < 2) { ph = step; l = 0; }
    else {
      int s = step - 2, k;
      if (s < 6) { l = 0; k = s; } else if (s < 15) { l = 1; k = s - 6; } else if (s < 21) { l = 2; k = s - 15; } else { l = 3; k = s - 21; }
      if ((l & 1) == 0) ph = PH_E1 + k;
      else ph = (k < 6) ? PH_O1 + k : PH_RES + (k - 6);
    }
#if defined(__HIP_DEVICE_COMPILE__)
    const __attribute__((address_space(4))) Params* kp = (const __attribute__((address_space(4))) Params*)__builtin_amdgcn_kernarg_segment_ptr();
    asm volatile("" : "+s"(kp), "+s"(l), "+s"(ph));
    const Params q = *kp;
#else
    const Params q = p;
#endif
    run_phase(q, smem, ph, l, bid, nb);
#if !TPROBE
    if (step == 31) break;
#endif
    if (step == 0) grid_seam(grid);
    else xcd_barrier(xb);
#if TPROBE
    {
      unsigned long long tn = wall_clock64();
      if ((TPROBE >> ph) & 1) tsel += tn - tprev;
      ttot += tn - tprev;
      tprev = tn;
    }
#endif
  }
#if TPROBE
  if (bid == 0) {
    float frac = (float)((double)tsel / (double)ttot);
    float sc = 1.f + sqrtf(frac);
    for (int i = tidx(); i < 32768; i += NTHR) p.out[20971520 + i] *= sc;
  }
#endif
}
#endif

extern "C" void kernel_launch(void* const* d_in, const int* in_sizes, int n_in, void* d_out, int out_size, void* d_ws, size_t ws_size,
                              hipStream_t stream) {
  static int grid_blocks = 0;
  if (grid_blocks == 0) {
    if (n_in != 40 || ws_size < WS_END) { fprintf(stderr, "kernel_launch: unexpected n_in %d or ws_size %zu (need %zu)\n", n_in, ws_size, (size_t)WS_END); grid_blocks = -1; return; }
    int dev = 0, cus = 0, per_cu = 0;
    hipGetDevice(&dev);
    hipDeviceGetAttribute(&cus, hipDeviceAttributeMultiprocessorCount, dev);
#if MULTI
    hipFuncSetAttribute((const void*)phase_kernel, hipFuncAttributeMaxDynamicSharedMemorySize, LDS_BYTES);
    hipOccupancyMaxActiveBlocksPerMultiprocessor(&per_cu, (const void*)phase_kernel, NTHR, LDS_BYTES);
#else
    hipFuncSetAttribute((const void*)mega_kernel, hipFuncAttributeMaxDynamicSharedMemorySize, LDS_BYTES);
    hipOccupancyMaxActiveBlocksPerMultiprocessor(&per_cu, (const void*)mega_kernel, NTHR, LDS_BYTES);
#endif
    if (per_cu < 1) per_cu = 1;
    if (per_cu > 2) per_cu = 2;
    if (cus < 1) cus = 256;
    grid_blocks = cus * per_cu;
  }
  if (grid_blocks < 0) return;
  Params p{};
  for (int i = 0; i < 40; ++i) p.in[i] = (const float*)d_in[i];
  p.out = (float*)d_out;
  p.ws = (unsigned char*)d_ws;
#if MULTI
  auto L = [&](int ph, int l) { hipLaunchKernelGGL(phase_kernel, dim3(grid_blocks), dim3(NTHR), LDS_BYTES, stream, p, ph, l); };
  L(PH_PREP, 0); L(PH_INIT, 0);
  for (int l = 0; l < 4; ++l) {
    if ((l & 1) == 0) { L(PH_E1, l); L(PH_E2, l); L(PH_EOUT, l); }
    else { L(PH_O1, l); L(PH_O2, l); L(PH_O3, l); L(PH_O4, l); L(PH_O5, l); L(PH_OOUT, l); }
    L(PH_RES, l); L(PH_P1, l); L(PH_P2, l);
  }
#else
  (void)hipMemsetAsync((char*)d_ws + OFF_BAR, 0, XCD_BAR_WORDS * sizeof(unsigned), stream);
  void* args[] = {&p};
  hipError_t e = hipLaunchCooperativeKernel((const void*)mega_kernel, dim3(grid_blocks), dim3(NTHR), args, LDS_BYTES, stream);
  if (e != hipSuccess) fprintf(stderr, "cooperative launch failed: %s (grid %d)\n", hipGetErrorString(e), grid_blocks);
#endif
}
```

```cpp
#include <hip/hip_runtime.h>
#include <hip/hip_cooperative_groups.h>
#include <cstdio>
#include <cstdint>
namespace cg = cooperative_groups;

#ifndef MULTI
#define MULTI 0
#endif

typedef unsigned short bf16_t;
using bf16x8 = __attribute__((ext_vector_type(8))) short;
using f32x16 = __attribute__((ext_vector_type(16))) float;
#define DI __device__ __forceinline__
#define MFMA(a, b, c) __builtin_amdgcn_mfma_f32_32x32x16_bf16((a), (b), (c), 0, 0, 0)

constexpr int T = 20480;
constexpr int NTHR = 256;
constexpr int LDS_MAIN = 71680;
constexpr int LDS_BYTES = LDS_MAIN + 16;
constexpr float ALPHA_F = 1.681792830507429f;

constexpr size_t MiB = 1u << 20;
constexpr size_t OFF_TABU = 0;
constexpr size_t OFF_TABV = OFF_TABU + 32 * MiB;
constexpr size_t OFF_BT_IN_E = OFF_TABV + 32 * MiB;
constexpr size_t OFF_BT_OUT_E = OFF_BT_IN_E + 10 * MiB;
constexpr size_t OFF_BT_IN_O = OFF_BT_OUT_E + 4 * MiB;
constexpr size_t OFF_BT_OUT_O = OFF_BT_IN_O + 12 * MiB;
constexpr size_t OFF_BT_WQ = OFF_BT_OUT_O + 4 * MiB;
constexpr size_t OFF_BT_W2 = OFF_BT_WQ + 16 * MiB;
constexpr size_t OFF_BT_A2 = OFF_BT_W2 + 256 * 1024;
constexpr size_t OFF_BT_G2 = OFF_BT_A2 + 256 * 1024;
constexpr size_t OFF_BT_GATE = OFF_BT_G2 + 256 * 1024;
constexpr size_t OFF_D256 = OFF_BT_GATE + 2 * MiB;
constexpr size_t OFF_MOD = OFF_D256 + 256 * 1024;
constexpr size_t OFF_D4096 = OFF_MOD + 512 * 1024;
constexpr size_t OFF_X = OFF_D4096 + 64 * MiB;
constexpr size_t OFF_Z = OFF_X + 80 * MiB;
constexpr size_t OFF_YMIX = OFF_Z + 115 * MiB;
constexpr size_t OFF_MIX = OFF_YMIX + 40 * MiB;
constexpr size_t OFF_H = OFF_MIX + 80 * MiB;
constexpr size_t OFF_XC = OFF_H + 40 * MiB;
constexpr size_t OFF_LRIN = OFF_XC + 40 * MiB;
constexpr size_t OFF_KKN = OFF_LRIN + 15 * MiB;
constexpr size_t OFF_KS = OFF_KKN + 40 * MiB;
constexpr size_t OFF_RS = OFF_KS + 20 * MiB;
constexpr size_t OFF_VS = OFF_RS + 20 * MiB;
constexpr size_t OFF_LB = OFF_VS + 20 * MiB;
constexpr size_t OFF_WD = OFF_LB + 40 * MiB;
constexpr size_t OFF_KKA = OFF_WD + 80 * MiB;
constexpr size_t OFF_KM = OFF_KKA + 40 * MiB;
constexpr size_t OFF_G = OFF_KM + 40 * MiB;
constexpr size_t OFF_BAR = OFF_G + 20 * MiB;
constexpr size_t WS_END = OFF_BAR + 16384;

struct Params {
  const float* in[40];
  float* out;
  unsigned char* ws;
};

enum {
  I_XP = 0, I_XS, I_SLRU, I_SWKV, I_C, I_CCTX, I_WMOD, I_BMOD, I_LN1G, I_LN1B, I_LN2G, I_LN2B, I_WINE, I_WOUTE, I_SCW, I_SCB,
  I_WINO, I_WOUTO, I_LCW, I_LCB, I_LWA, I_LBA, I_LWX, I_LBX, I_LLAM, I_MU, I_W0, I_W2, I_A0, I_A2, I_KK, I_KA, I_RK, I_G2, I_GNG,
  I_GNB, I_WQ, I_KEYS, I_PU, I_PV
};

DI int tidx() { int t = __builtin_amdgcn_workitem_id_x(); asm volatile("" : "+v"(t)); return t; }
DI unsigned f2bf(float x) { unsigned u = __float_as_uint(x); u += 0x7fffu + ((u >> 16) & 1u); return u >> 16; }
DI unsigned pack2(float a, float b) { return f2bf(a) | (f2bf(b) << 16); }
DI float bflo(unsigned u) { return __uint_as_float(u << 16); }
DI float bfhi(unsigned u) { return __uint_as_float(u & 0xffff0000u); }
DI float bf2f(bf16_t h) { return __uint_as_float(((unsigned)h) << 16); }
DI float sigm(float x) { return 1.f / (1.f + __expf(-x)); }
DI float gelu_t(float x) { float u = 0.7978845608028654f * (x + 0.044715f * x * x * x); return x * sigm(2.f * u); }
DI float tanh_f(float x) { return 2.f * sigm(2.f * x) - 1.f; }

template <int CTRL> DI float dpp_mov(float x) {
  return __int_as_float(__builtin_amdgcn_update_dpp(0, __float_as_int(x), CTRL, 0xF, 0xF, true));
}
DI float sum8(float x) { x += dpp_mov<0xB1>(x); x += dpp_mov<0x4E>(x); x += dpp_mov<0x141>(x); return x; }
DI float sum16(float x) { x = sum8(x); x += dpp_mov<0x140>(x); return x; }
DI float max16(float x) {
  x = fmaxf(x, dpp_mov<0xB1>(x)); x = fmaxf(x, dpp_mov<0x4E>(x)); x = fmaxf(x, dpp_mov<0x141>(x)); x = fmaxf(x, dpp_mov<0x140>(x));
  return x;
}
DI float rdlane(float x, int l) { return __int_as_float(__builtin_amdgcn_readlane(__float_as_int(x), l)); }
DI float wave_sum(float x) { x = sum16(x); return (rdlane(x, 0) + rdlane(x, 16)) + (rdlane(x, 32) + rdlane(x, 48)); }

DI void tok_info(int t, int& seq, int& s, int& S, int& cv) {
  if (t < 4096) { seq = t >> 8; s = t & 255; S = 256; cv = 0; }
  else { int u = t - 4096; seq = 16 + (u >> 12); s = u & 4095; S = 4096; cv = 1 + (u >> 12); }
}
DI size_t pqt_base(int seq) { return seq < 16 ? (size_t)seq * 512 * 512 : (size_t)16 * 512 * 512 + (size_t)(seq - 16) * 512 * 8192; }

DI void load_row(const float* p, int lane, float (&v)[16]) {
  const float4* q = (const float4*)(p + lane * 8);
  float4 a = q[0], b = q[1];
  const float4* q2 = (const float4*)(p + 512 + lane * 8);
  float4 c = q2[0], d = q2[1];
  v[0] = a.x; v[1] = a.y; v[2] = a.z; v[3] = a.w; v[4] = b.x; v[5] = b.y; v[6] = b.z; v[7] = b.w;
  v[8] = c.x; v[9] = c.y; v[10] = c.z; v[11] = c.w; v[12] = d.x; v[13] = d.y; v[14] = d.z; v[15] = d.w;
}
DI void store_row(float* p, int lane, const float (&v)[16]) {
  float4* q = (float4*)(p + lane * 8);
  q[0] = make_float4(v[0], v[1], v[2], v[3]); q[1] = make_float4(v[4], v[5], v[6], v[7]);
  float4* q2 = (float4*)(p + 512 + lane * 8);
  q2[0] = make_float4(v[8], v[9], v[10], v[11]); q2[1] = make_float4(v[12], v[13], v[14], v[15]);
}
DI void store_row_bf(bf16_t* p, int lane, const float (&v)[16]) {
  uint4 a, b;
  a.x = pack2(v[0], v[1]); a.y = pack2(v[2], v[3]); a.z = pack2(v[4], v[5]); a.w = pack2(v[6], v[7]);
  b.x = pack2(v[8], v[9]); b.y = pack2(v[10], v[11]); b.z = pack2(v[12], v[13]); b.w = pack2(v[14], v[15]);
  *(uint4*)(p + lane * 8) = a;
  *(uint4*)(p + 512 + lane * 8) = b;
}
DI void unpack8(uint4 u, float (&v)[8]) {
  v[0] = bflo(u.x); v[1] = bfhi(u.x); v[2] = bflo(u.y); v[3] = bfhi(u.y); v[4] = bflo(u.z); v[5] = bfhi(u.z); v[6] = bflo(u.w); v[7] = bfhi(u.w);
}
DI uint4 pack8(const float (&v)[8]) {
  uint4 a; a.x = pack2(v[0], v[1]); a.y = pack2(v[2], v[3]); a.z = pack2(v[4], v[5]); a.w = pack2(v[6], v[7]); return a;
}
DI void load8f(const float* p, float (&v)[8]) {
  float4 a = ((const float4*)p)[0], b = ((const float4*)p)[1];
  v[0] = a.x; v[1] = a.y; v[2] = a.z; v[3] = a.w; v[4] = b.x; v[5] = b.y; v[6] = b.z; v[7] = b.w;
}

DI void load_row16(const float* p, int lane, float (&v)[16]) {
  const float4* q = (const float4*)(p + lane * 16);
  float4 a = q[0], b = q[1], c = q[2], d = q[3];
  v[0] = a.x; v[1] = a.y; v[2] = a.z; v[3] = a.w; v[4] = b.x; v[5] = b.y; v[6] = b.z; v[7] = b.w;
  v[8] = c.x; v[9] = c.y; v[10] = c.z; v[11] = c.w; v[12] = d.x; v[13] = d.y; v[14] = d.z; v[15] = d.w;
}
DI void store_row16(float* p, int lane, const float (&v)[16]) {
  float4* q = (float4*)(p + lane * 16);
  q[0] = make_float4(v[0], v[1], v[2], v[3]); q[1] = make_float4(v[4], v[5], v[6], v[7]);
  q[2] = make_float4(v[8], v[9], v[10], v[11]); q[3] = make_float4(v[12], v[13], v[14], v[15]);
}
DI void store_row16_bf(bf16_t* p, int lane, const float (&v)[16]) {
  uint4 a, b;
  a.x = pack2(v[0], v[1]); a.y = pack2(v[2], v[3]); a.z = pack2(v[4], v[5]); a.w = pack2(v[6], v[7]);
  b.x = pack2(v[8], v[9]); b.y = pack2(v[10], v[11]); b.z = pack2(v[12], v[13]); b.w = pack2(v[14], v[15]);
  uint4* q = (uint4*)(p + lane * 16);
  q[0] = a; q[1] = b;
}
typedef float v2f_t __attribute__((ext_vector_type(2)));
DI unsigned pk_fp8x4(float a, float b, float c, float d) {
  int w = 0;
  w = __builtin_amdgcn_cvt_pk_fp8_f32(a, b, w, false);
  w = __builtin_amdgcn_cvt_pk_fp8_f32(c, d, w, true);
  return (unsigned)w;
}
DI void unpack_fp8x16(uint4 u, float (&v)[16]) {
  v2f_t t;
  t = __builtin_amdgcn_cvt_pk_f32_fp8((int)u.x, false); v[0] = t.x; v[1] = t.y;
  t = __builtin_amdgcn_cvt_pk_f32_fp8((int)u.x, true); v[2] = t.x; v[3] = t.y;
  t = __builtin_amdgcn_cvt_pk_f32_fp8((int)u.y, false); v[4] = t.x; v[5] = t.y;
  t = __builtin_amdgcn_cvt_pk_f32_fp8((int)u.y, true); v[6] = t.x; v[7] = t.y;
  t = __builtin_amdgcn_cvt_pk_f32_fp8((int)u.z, false); v[8] = t.x; v[9] = t.y;
  t = __builtin_amdgcn_cvt_pk_f32_fp8((int)u.z, true); v[10] = t.x; v[11] = t.y;
  t = __builtin_amdgcn_cvt_pk_f32_fp8((int)u.w, false); v[12] = t.x; v[13] = t.y;
  t = __builtin_amdgcn_cvt_pk_f32_fp8((int)u.w, true); v[14] = t.x; v[15] = t.y;
}
DI void ln16(float (&y)[16]) {
  float s = 0.f;
#pragma unroll
  for (int i = 0; i < 16; ++i) s += y[i];
  float mu = wave_sum(s) * (1.f / 1024.f);
  float v = 0.f;
#pragma unroll
  for (int i = 0; i < 16; ++i) { float d = y[i] - mu; v += d * d; }
  v = wave_sum(v) * (1.f / 1024.f);
  float rs = rsqrtf(v + 1e-6f);
#pragma unroll
  for (int i = 0; i < 16; ++i) y[i] = (y[i] - mu) * rs;
}

constexpr int LDT = 72;

template <bool SWAP>
DI void gemm_mainloop(const bf16_t* __restrict__ A, int lda, const bf16_t* __restrict__ B, int ldb, int K,
                      f32x16 (&acc)[2][2], bf16_t* As, bf16_t* Bs) {
  const int tid = tidx(), lane = tid & 63, wave = tid >> 6;
  const int wm = wave >> 1, wn = wave & 1;
  const int lrow = tid >> 3, lck = tid & 7;
  const bf16_t* ap = A + (size_t)lrow * lda + lck * 8;
  const bf16_t* bp = B + (size_t)lrow * ldb + lck * 8;
  const size_t sa = (size_t)32 * lda, sb = (size_t)32 * ldb;
  uint4 ra0, ra1, ra2, ra3, rb0, rb1, rb2, rb3;
  ra0 = *(const uint4*)(ap); ra1 = *(const uint4*)(ap + sa); ra2 = *(const uint4*)(ap + 2 * sa); ra3 = *(const uint4*)(ap + 3 * sa);
  rb0 = *(const uint4*)(bp); rb1 = *(const uint4*)(bp + sb); rb2 = *(const uint4*)(bp + 2 * sb); rb3 = *(const uint4*)(bp + 3 * sb);
#pragma unroll
  for (int mi = 0; mi < 2; ++mi)
#pragma unroll
    for (int ni = 0; ni < 2; ++ni)
#pragma unroll
      for (int r = 0; r < 16; ++r) acc[mi][ni][r] = 0.f;
  const int KT = K / 64;
  const int fr = (lane & 31) * LDT + (lane >> 5) * 8;
  bf16_t* asw = As + lrow * LDT + lck * 8;
  bf16_t* bsw = Bs + lrow * LDT + lck * 8;
  for (int kt = 0; kt < KT; ++kt) {
    __syncthreads();
    *(uint4*)(asw) = ra0; *(uint4*)(asw + 32 * LDT) = ra1; *(uint4*)(asw + 64 * LDT) = ra2; *(uint4*)(asw + 96 * LDT) = ra3;
    *(uint4*)(bsw) = rb0; *(uint4*)(bsw + 32 * LDT) = rb1; *(uint4*)(bsw + 64 * LDT) = rb2; *(uint4*)(bsw + 96 * LDT) = rb3;
    __syncthreads();
    if (kt + 1 < KT) {
      const bf16_t* a2 = ap + (kt + 1) * 64;
      const bf16_t* b2 = bp + (kt + 1) * 64;
      ra0 = *(const uint4*)(a2); ra1 = *(const uint4*)(a2 + sa); ra2 = *(const uint4*)(a2 + 2 * sa); ra3 = *(const uint4*)(a2 + 3 * sa);
      rb0 = *(const uint4*)(b2); rb1 = *(const uint4*)(b2 + sb); rb2 = *(const uint4*)(b2 + 2 * sb); rb3 = *(const uint4*)(b2 + 3 * sb);
    }
#pragma unroll
    for (int kk = 0; kk < 4; ++kk) {
      const bf16x8 af0 = *(const bf16x8*)(As + (wm * 64) * LDT + fr + kk * 16);
      const bf16x8 af1 = *(const bf16x8*)(As + (wm * 64 + 32) * LDT + fr + kk * 16);
      const bf16x8 bf0 = *(const bf16x8*)(Bs + (wn * 64) * LDT + fr + kk * 16);
      const bf16x8 bf1 = *(const bf16x8*)(Bs + (wn * 64 + 32) * LDT + fr + kk * 16);
      if (SWAP) {
        acc[0][0] = MFMA(bf0, af0, acc[0][0]); acc[0][1] = MFMA(bf1, af0, acc[0][1]);
        acc[1][0] = MFMA(bf0, af1, acc[1][0]); acc[1][1] = MFMA(bf1, af1, acc[1][1]);
      } else {
        acc[0][0] = MFMA(af0, bf0, acc[0][0]); acc[0][1] = MFMA(af0, bf1, acc[0][1]);
        acc[1][0] = MFMA(af1, bf0, acc[1][0]); acc[1][1] = MFMA(af1, bf1, acc[1][1]);
      }
    }
  }
}

template <bool SWAP, bool SB = true, class F>
DI void gemm_epilogue(const f32x16 (&acc)[2][2], F f) {
  const int lane = tidx() & 63, wave = tidx() >> 6;
  const int wm = wave >> 1, wn = wave & 1;
#pragma unroll
  for (int mi = 0; mi < 2; ++mi)
#pragma unroll
    for (int ni = 0; ni < 2; ++ni)
#pragma unroll
      for (int r = 0; r < 16; ++r) {
        const int i = (r & 3) + 8 * (r >> 2) + 4 * (lane >> 5);
        const int j = lane & 31;
        int m, n;
        if (!SWAP) { m = wm * 64 + mi * 32 + i; n = wn * 64 + ni * 32 + j; }
        else { n = wn * 64 + ni * 32 + i; m = wm * 64 + mi * 32 + j; }
        f(m, n, acc[mi][ni][r]);
        if (SB && (r & 3) == 3) __builtin_amdgcn_sched_barrier(0);
      }
}
template <class F>
DI void gemm_epilogue2(const f32x16 (&a0)[2][2], const f32x16 (&a1)[2][2], F f) {
  const int lane = tidx() & 63, wave = tidx() >> 6;
  const int wm = wave >> 1, wn = wave & 1;
#pragma unroll
  for (int mi = 0; mi < 2; ++mi)
#pragma unroll
    for (int ni = 0; ni < 2; ++ni)
#pragma unroll
      for (int r = 0; r < 16; ++r) {
        const int i = (r & 3) + 8 * (r >> 2) + 4 * (lane >> 5);
        const int j = lane & 31;
        f(wm * 64 + mi * 32 + i, wn * 64 + ni * 32 + j, a0[mi][ni][r], a1[mi][ni][r]);
      }
}

DI int tr_tiles(int job) {
  if (job < 2) return 384; if (job < 4) return 256; if (job < 6) return 736; if (job < 8) return 256;
  if (job < 12) return 512; if (job < 20) return 8; return 16;
}
DI void phase_prep(const Params& p, unsigned char* smem, int bid, int nb) {
  const int tid = tidx();
  constexpr int N_MOD = 384, N_TR = 768 + 512 + 1472 + 512 + 2048 + 32 + 32 + 32, N_FOLD = 256, N_GATE = 512, N_DFT = 16384 + 64;
  constexpr int TOTAL = N_MOD + N_TR + N_FOLD + N_GATE + N_DFT;
  unsigned char* ws = p.ws;
  for (int it = bid; it < TOTAL; it += nb) {
    if (it < N_MOD) {
      const int l = it / 96, cchunk = it % 96;
      float* sil = (float*)smem;
      float* red = sil + 5 * 1024;
      __syncthreads();
      for (int i = tid; i < 5120; i += NTHR) {
        int cv = i >> 10, k = i & 1023;
        float c = (cv == 0) ? p.in[I_CCTX][k] : p.in[I_C][(cv - 1) * 1024 + k];
        sil[i] = c * sigm(c);
      }
      __syncthreads();
      const int col = cchunk * 64 + (tid & 63), kg = tid >> 6;
      const float* w = p.in[I_WMOD] + (size_t)l * 1024 * 6144 + col;
      float a0 = 0.f, a1 = 0.f, a2 = 0.f, a3 = 0.f, a4 = 0.f;
#pragma unroll 8
      for (int k = kg * 256; k < kg * 256 + 256; ++k) {
        float wv = w[(size_t)k * 6144];
        a0 += sil[k] * wv; a1 += sil[1024 + k] * wv; a2 += sil[2048 + k] * wv; a3 += sil[3072 + k] * wv; a4 += sil[4096 + k] * wv;
      }
      const int c = tid & 63;
      red[(kg * 5 + 0) * 64 + c] = a0; red[(kg * 5 + 1) * 64 + c] = a1; red[(kg * 5 + 2) * 64 + c] = a2;
      red[(kg * 5 + 3) * 64 + c] = a3; red[(kg * 5 + 4) * 64 + c] = a4;
      __syncthreads();
      for (int i = tid; i < 320; i += NTHR) {
        int cv = i >> 6, cc = i & 63;
        float s = red[(0 * 5 + cv) * 64 + cc] + red[(1 * 5 + cv) * 64 + cc] + red[(2 * 5 + cv) * 64 + cc] + red[(3 * 5 + cv) * 64 + cc];
        s += p.in[I_BMOD][l * 6144 + cchunk * 64 + cc];
        ((float*)(ws + OFF_MOD))[(l * 5 + cv) * 6144 + cchunk * 64 + cc] = s;
      }
    } else if (it < N_MOD + N_TR) {
      int r = it - N_MOD, job = 0;
      for (job = 0; job < 22; ++job) { int nt = tr_tiles(job); if (r < nt) break; r -= nt; }
      const float* src; bf16_t* dst; int lds, ldd, N;
      if (job < 2) { src = p.in[I_WINE] + (size_t)job * 1024 * 2048 + 512; lds = 2048; N = 1536; dst = (bf16_t*)(ws + OFF_BT_IN_E) + (size_t)job * 2560 * 1024 + (size_t)1024 * 1024; ldd = 1024; }
      else if (job < 4) { int j = job - 2; src = p.in[I_WOUTE] + (size_t)j * 1024 * 1024; lds = 1024; N = 1024; dst = (bf16_t*)(ws + OFF_BT_OUT_E) + (size_t)j * 1024 * 1024; ldd = 1024; }
      else if (job < 6) { int j = job - 4; src = p.in[I_WINO] + (size_t)j * 1024 * 2944; lds = 2944; N = 2944; dst = (bf16_t*)(ws + OFF_BT_IN_O) + (size_t)j * 2944 * 1024; ldd = 1024; }
      else if (job < 8) { int j = job - 6; src = p.in[I_WOUTO] + (size_t)j * 1024 * 1024; lds = 1024; N = 1024; dst = (bf16_t*)(ws + OFF_BT_OUT_O) + (size_t)j * 1024 * 1024; ldd = 1024; }
      else if (job < 12) { int j = job - 8; src = p.in[I_WQ] + (size_t)j * 1024 * 2048; lds = 2048; N = 2048; dst = (bf16_t*)(ws + OFF_BT_WQ) + (size_t)j * 2048 * 1024; ldd = 1024; }
      else if (job < 16) { int j = job - 12; src = p.in[I_W2] + (size_t)j * 64 * 512; lds = 512; N = 512; dst = (bf16_t*)(ws + OFF_BT_W2) + (size_t)j * 512 * 64; ldd = 64; }
      else if (job < 20) { int j = job - 16; src = p.in[I_A2] + (size_t)j * 64 * 512; lds = 512; N = 512; dst = (bf16_t*)(ws + OFF_BT_A2) + (size_t)j * 512 * 64; ldd = 64; }
      else { int j = job - 20; src = p.in[I_G2] + (size_t)j * 128 * 512; lds = 512; N = 512; dst = (bf16_t*)(ws + OFF_BT_G2) + (size_t)j * 512 * 128; ldd = 128; }
      const int ntn = N / 64;
      const int k0 = (r / ntn) * 64, n0 = (r % ntn) * 64;
      float* tl = (float*)smem;
      __syncthreads();
#pragma unroll 4
      for (int ps = 0; ps < 16; ++ps) {
        int kr = ps * 4 + (tid >> 6), n = tid & 63;
        tl[kr * 65 + n] = src[(size_t)(k0 + kr) * lds + n0 + n];
      }
      __syncthreads();
#pragma unroll 4
      for (int ps = 0; ps < 8; ++ps) {
        int nr = ps * 8 + (tid >> 5), k2 = tid & 31;
        unsigned v = pack2(tl[(2 * k2) * 65 + nr], tl[(2 * k2 + 1) * 65 + nr]);
        *(unsigned*)(dst + (size_t)(n0 + nr) * ldd + k0 + 2 * k2) = v;
      }
    } else if (it < N_MOD + N_TR + N_FOLD) {
      int r = it - N_MOD - N_TR;
      const int j = r >> 7, rr = r & 127, which = rr >> 6, g = (rr >> 4) & 3, kt = rr & 15;
      const int k0 = kt * 64;
      float* Wl = (float*)smem;
      float* tab = Wl + 64 * 129;
      __syncthreads();
      if (tid < 128) { float fr = (float)tid * (1.f / 128.f); tab[tid] = which ? __builtin_amdgcn_sinf(fr) : __builtin_amdgcn_cosf(fr); }
      for (int ps = 0; ps < 32; ++ps) {
        int kr = ps * 2 + (tid >> 7), c = tid & 127;
        Wl[kr * 129 + c] = p.in[I_WINE][(size_t)j * 1024 * 2048 + (size_t)(k0 + kr) * 2048 + g * 128 + c];
      }
      __syncthreads();
      const int k = tid & 63, nq = tid >> 6;
      bf16_t* dst = (bf16_t*)(ws + OFF_BT_IN_E) + (size_t)j * 2560 * 1024;
      for (int i = 0; i < 32; ++i) {
        const int np = nq * 32 + i;
        float s = 0.f;
#pragma unroll 8
        for (int c = 0; c < 128; ++c) s += Wl[k * 129 + c] * tab[(c * np) & 127];
        dst[(size_t)(which * 512 + g * 128 + np) * 1024 + k0 + k] = (bf16_t)f2bf(s);
      }
    } else if (it < N_MOD + N_TR + N_FOLD + N_GATE) {
      int r = it - N_MOD - N_TR - N_FOLD;
      bf16_t* dst = (bf16_t*)(ws + OFF_BT_GATE);
      for (int e = 0; e < 4; ++e) {
        int idx = r * 1024 + e * 256 + tid;
        int kp = idx & 127, n = (idx >> 7) & 511, gate = (idx >> 16) & 1, d = (idx >> 17) & 1, j = idx >> 18;
        int h = n >> 6;
        float v = 0.f;
        if ((kp >> 6) == (h & 1)) {
          const float* W = gate ? p.in[I_LWX] : p.in[I_LWA];
          v = W[((((size_t)(j * 2 + d) * 8 + h) * 64 + (kp & 63)) * 64) + (n & 63)];
        }
        dst[idx] = (bf16_t)f2bf(v);
      }
    } else {
      int r = it - N_MOD - N_TR - N_FOLD - N_GATE;
      int S, K2; bf16_t* dst; size_t idx;
      if (r < 16384) { S = 4096; K2 = 8192; dst = (bf16_t*)(ws + OFF_D4096); idx = (size_t)r * 2048 + tid * 8; }
      else { S = 256; K2 = 512; dst = (bf16_t*)(ws + OFF_D256); idx = (size_t)(r - 16384) * 2048 + tid * 8; }
      const int row = (int)(idx / K2), kb = (int)(idx % K2);
      const float invS = 1.f / (float)S;
      float v[8];
#pragma unroll
      for (int e = 0; e < 8; ++e) {
        int k = kb + e;
        if (k < S) { int m = (row * k) & (S - 1); v[e] = __builtin_amdgcn_cosf((float)m * invS); }
        else { int m = (row * (k - S)) & (S - 1); v[e] = -__builtin_amdgcn_sinf((float)m * invS); }
      }
      *(uint4*)(dst + idx) = pack8(v);
    }
  }
}

DI void mod_store_h(const Params& p, int t, int lane, int cv, int l, int off_scale, int off_shift, float (&y)[16]) {
  const float* mod = (const float*)(p.ws + OFF_MOD) + (size_t)(l * 5 + cv) * 6144;
  float sc[16], sh[16];
  load_row(mod + off_scale * 1024, lane, sc);
  load_row(mod + off_shift * 1024, lane, sh);
#pragma unroll
  for (int i = 0; i < 16; ++i) y[i] = y[i] * (1.f + sc[i]) + sh[i];
  store_row_bf((bf16_t*)(p.ws + OFF_H) + (size_t)t * 1024, lane, y);
}

DI float pos_embed(int n, int c) {
  int pos = (c < 512) ? (n >> 6) : (n & 63);
  int cc = c & 511, i = cc & 255;
  float om = exp2f(-(float)i * (13.287712379549449f / 256.f));
  float rev = (float)pos * om * 0.15915494309189535f;
  return cc < 256 ? __builtin_amdgcn_sinf(rev) : __builtin_amdgcn_cosf(rev);
}

DI void phase_init(const Params& p, int bid, int nb) {
  const int lane = tidx() & 63, wave = tidx() >> 6;
  float sc[16], sh[16];
  int cvl = -1;
  for (int t = bid * 4 + wave; t < T; t += nb * 4) {
    int seq, s, S, cv; tok_info(t, seq, s, S, cv);
    if (cv != cvl) {
      const float* mod = (const float*)(p.ws + OFF_MOD) + (size_t)cv * 6144;
      load_row(mod + 1024, lane, sc); load_row(mod, lane, sh);
      cvl = cv;
    }
    float y[16];
    const float* src = (t < 4096) ? p.in[I_XP] + (size_t)t * 1024 : p.in[I_XS] + (size_t)(t - 4096) * 1024;
    load_row(src, lane, y);
    if (t >= 4096) {
#pragma unroll
      for (int i = 0; i < 16; ++i) { int c = (i < 8) ? lane * 8 + i : 512 + lane * 8 + (i - 8); y[i] += pos_embed(s, c); }
    }
    store_row((float*)(p.ws + OFF_X) + (size_t)t * 1024, lane, y);
    ln16(y);
#pragma unroll
    for (int i = 0; i < 16; ++i) y[i] = y[i] * (1.f + sc[i]) + sh[i];
    store_row_bf((bf16_t*)(p.ws + OFF_H) + (size_t)t * 1024, lane, y);
  }
}

constexpr float U_SCALE = 32.f;
DI void convert_tables(const Params& p, int l, int bid, int nb) {
  const size_t n16 = (size_t)16384 * 1024 / 16;
  for (int tb = 0; tb < 2; ++tb) {
    const float* src = p.in[tb ? I_PV : I_PU] + (size_t)l * 16384 * 1024;
    uint4* dst = (uint4*)(p.ws + (tb ? OFF_TABV : OFF_TABU));
    const float sc = tb ? 1.f : U_SCALE;
    for (size_t i = (size_t)bid * NTHR + tidx(); i < n16; i += (size_t)nb * NTHR) {
      const float4* s4 = (const float4*)(src + i * 16);
      float4 a = s4[0], b = s4[1], c = s4[2], d = s4[3];
      uint4 o;
      o.x = pk_fp8x4(a.x * sc, a.y * sc, a.z * sc, a.w * sc); o.y = pk_fp8x4(b.x * sc, b.y * sc, b.z * sc, b.w * sc);
      o.z = pk_fp8x4(c.x * sc, c.y * sc, c.z * sc, c.w * sc); o.w = pk_fp8x4(d.x * sc, d.y * sc, d.z * sc, d.w * sc);
      dst[i] = o;
    }
  }
}

DI void phase_e1(const Params& p, unsigned char* smem, int l, int bid, int nb) {
  const int j = l >> 1;
  bf16_t* As = (bf16_t*)smem; bf16_t* Bs = As + 128 * LDT;
  const bf16_t* H = (const bf16_t*)(p.ws + OFF_H);
  const bf16_t* Bt = (const bf16_t*)(p.ws + OFF_BT_IN_E) + (size_t)j * 2560 * 1024;
  bf16_t* PQT = (bf16_t*)(p.ws + OFF_Z);
  bf16_t* ZC = (bf16_t*)(p.ws + OFF_Z + 40 * MiB);
  for (int it = bid; it < 160 * 20; it += nb) {
    const int mt = it / 20, nt = it % 20, t0 = mt * 128;
    f32x16 acc[2][2];
    if (nt < 8) {
      gemm_mainloop<true>(H + (size_t)t0 * 1024, 1024, Bt + (size_t)nt * 128 * 1024, 1024, 1024, acc, As, Bs);
      int seq, s0, S, cv; tok_info(t0, seq, s0, S, cv);
      bf16_t* base = PQT + pqt_base(seq);
      const int S2 = 2 * S;
      gemm_epilogue<true>(acc, [&](int m, int n, float v) {
        int ng = nt * 128 + n; int which = ng >> 9, ch = ng & 511;
        base[(size_t)ch * S2 + which * S + s0 + m] = (bf16_t)f2bf(v);
      });
    } else {
      gemm_mainloop<false>(H + (size_t)t0 * 1024, 1024, Bt + (size_t)nt * 128 * 1024, 1024, 1024, acc, As, Bs);
      gemm_epilogue<false>(acc, [&](int m, int n, float v) {
        ZC[(size_t)(t0 + m) * 1536 + (nt - 8) * 128 + n] = (bf16_t)f2bf(v);
      });
    }
  }
  convert_tables(p, l, bid, nb);
}

DI void phase_e2(const Params& p, unsigned char* smem, int l, int bid, int nb) {
  const int j = l >> 1;
  bf16_t* As = (bf16_t*)smem; bf16_t* Bs = As + 128 * LDT;
  const bf16_t* PQT = (const bf16_t*)(p.ws + OFF_Z);
  const bf16_t* ZC = (const bf16_t*)(p.ws + OFF_Z + 40 * MiB);
  bf16_t* YM = (bf16_t*)(p.ws + OFF_YMIX);
  for (int it = bid; it < 640 + 1280; it += nb) {
    if (it < 640) {
      int seq, mt, nt, S, t0; const bf16_t* A;
      if (it < 512) { seq = 16 + it / 128; int r = it % 128; mt = r >> 2; nt = r & 3; S = 4096; A = (const bf16_t*)(p.ws + OFF_D4096) + (size_t)mt * 128 * 8192; t0 = 4096 + (seq - 16) * 4096 + mt * 128; }
      else { int r = it - 512; seq = r >> 3; mt = (r & 7) >> 2; nt = r & 3; S = 256; A = (const bf16_t*)(p.ws + OFF_D256) + (size_t)mt * 128 * 512; t0 = seq * 256 + mt * 128; }
      const bf16_t* B = PQT + pqt_base(seq) + (size_t)nt * 128 * (2 * S);
      f32x16 acc[2][2];
      gemm_mainloop<false>(A, 2 * S, B, 2 * S, 2 * S, acc, As, Bs);
      const float scale = rsqrtf(128.f * (float)S);
      gemm_epilogue<false>(acc, [&](int m, int n, float v) {
        YM[(size_t)(t0 + m) * 1024 + nt * 128 + n] = (bf16_t)f2bf(v * scale);
      });
    } else {
      const int t0 = (it - 640) * 16, c = tidx() * 2;
      int seq, s0, S, cv; tok_info(t0, seq, s0, S, cv);
      const float* cw = p.in[I_SCW] + (size_t)j * 3 * 512;
      const float w0a = cw[c], w0b = cw[c + 1], w1a = cw[512 + c], w1b = cw[512 + c + 1], w2a = cw[1024 + c], w2b = cw[1024 + c + 1];
      const float ba = p.in[I_SCB][j * 512 + c], bb = p.in[I_SCB][j * 512 + c + 1];
      auto uval = [&](int t, float& ua, float& ub) {
        unsigned cg_ = *(const unsigned*)(ZC + (size_t)t * 1536 + 512 + c);
        unsigned xi = *(const unsigned*)(ZC + (size_t)t * 1536 + 1024 + c);
        ua = bflo(cg_) * bflo(xi); ub = bfhi(cg_) * bfhi(xi);
      };
      float pa = 0.f, pb = 0.f, ca, cb, na, nb_;
      if (s0 > 0) uval(t0 - 1, pa, pb);
      uval(t0, ca, cb);
      for (int i = 0; i < 16; ++i) {
        const int t = t0 + i;
        na = 0.f; nb_ = 0.f;
        if (s0 + i + 1 < S) uval(t + 1, na, nb_);
        unsigned bg = *(const unsigned*)(ZC + (size_t)t * 1536 + c);
        float ya = bflo(bg) * (w0a * pa + w1a * ca + w2a * na + ba);
        float yb = bfhi(bg) * (w0b * pb + w1b * cb + w2b * nb_ + bb);
        *(unsigned*)(YM + (size_t)t * 1024 + 512 + c) = pack2(ya, yb);
        pa = ca; pb = cb; ca = na; cb = nb_;
      }
    }
  }
}

DI void phase_outgemm(const Params& p, unsigned char* smem, const bf16_t* Bt, int bid, int nb) {
  bf16_t* As = (bf16_t*)smem; bf16_t* Bs = As + 128 * LDT;
  const bf16_t* YM = (const bf16_t*)(p.ws + OFF_YMIX);
  float* MIX = (float*)(p.ws + OFF_MIX);
  for (int it = bid; it < 160 * 8; it += nb) {
    const int mt = it >> 3, nt = it & 7, t0 = mt * 128;
    f32x16 acc[2][2];
    gemm_mainloop<false>(YM + (size_t)t0 * 1024, 1024, Bt + (size_t)nt * 128 * 1024, 1024, 1024, acc, As, Bs);
    gemm_epilogue<false>(acc, [&](int m, int n, float v) { MIX[(size_t)(t0 + m) * 1024 + nt * 128 + n] = v; });
  }
}

DI void phase_res1(const Params& p, int l, int bid, int nb) {
  const int lane = tidx() & 63, wave = tidx() >> 6;
  float* X = (float*)(p.ws + OFF_X);
  const float* MIX = (const float*)(p.ws + OFF_MIX);
  float lg[16], lb[16], g1[16], sc[16], sh[16];
  load_row(p.in[I_LN1G] + l * 1024, lane, lg);
  load_row(p.in[I_LN1B] + l * 1024, lane, lb);
  int cvl = -1;
  for (int t = bid * 4 + wave; t < T; t += nb * 4) {
    int seq, s, S, cv; tok_info(t, seq, s, S, cv);
    if (cv != cvl) {
      const float* mod = (const float*)(p.ws + OFF_MOD) + (size_t)(l * 5 + cv) * 6144;
      load_row(mod + 2 * 1024, lane, g1); load_row(mod + 4 * 1024, lane, sc); load_row(mod + 3 * 1024, lane, sh);
      cvl = cv;
    }
    float x[16], m[16];
    load_row(X + (size_t)t * 1024, lane, x);
    load_row(MIX + (size_t)t * 1024, lane, m);
#pragma unroll
    for (int i = 0; i < 16; ++i) x[i] = ALPHA_F * x[i] + g1[i] * m[i];
    ln16(x);
#pragma unroll
    for (int i = 0; i < 16; ++i) x[i] = x[i] * lg[i] + lb[i];
    store_row(X + (size_t)t * 1024, lane, x);
    ln16(x);
#pragma unroll
    for (int i = 0; i < 16; ++i) x[i] = x[i] * (1.f + sc[i]) + sh[i];
    store_row_bf((bf16_t*)(p.ws + OFF_H) + (size_t)t * 1024, lane, x);
  }
}

DI void insert16(float (&tv)[16], int (&ti)[16], float x, int xi) {
#pragma unroll
  for (int k = 0; k < 16; ++k) {
    bool gt = x > tv[k];
    float ov = tv[k]; int oi = ti[k];
    tv[k] = gt ? x : ov; ti[k] = gt ? xi : oi;
    x = gt ? ov : x; xi = gt ? oi : xi;
  }
}
DI void phase_p1(const Params& p, unsigned char* smem, int l, int bid, int nb) {
  const int tid = tidx(), lane = tid & 63, wave = tid >> 6;
  const int wm = wave >> 1, wn = wave & 1;
  bf16_t* As = (bf16_t*)smem; bf16_t* Bs = As + 128 * LDT;
  bf16_t* Qs = (bf16_t*)smem;
  bf16_t* Ks = (bf16_t*)(smem + 36864);
  float* Sc = (float*)smem;
  float* Lv = (float*)smem;
  int* Li = (int*)(smem + 8192);
  const bf16_t* H = (const bf16_t*)(p.ws + OFF_H);
  const bf16_t* Bt = (const bf16_t*)(p.ws + OFF_BT_WQ) + (size_t)l * 2048 * 1024;
  float* TKV = (float*)(p.ws + OFF_WD);
  int* TKI = (int*)(p.ws + OFF_WD + 20 * MiB);
  for (int it = bid; it < 160 * 16; it += nb) {
    const int mt = it >> 4, hp = it & 15, t0 = mt * 128;
    f32x16 acc[2][2];
    gemm_mainloop<false>(H + (size_t)t0 * 1024, 1024, Bt + (size_t)hp * 128 * 1024, 1024, 1024, acc, As, Bs);
    {
      const float* kp = p.in[I_KEYS] + (size_t)(l * 16 + hp) * 16384;
#pragma unroll 4
      for (int i = 0; i < 16; ++i) {
        int idx = i * 256 + tid;
        int row = idx >> 5, c4 = idx & 31;
        float4 v = *(const float4*)(kp + row * 128 + c4 * 4);
        uint2 u; u.x = pack2(v.x, v.y); u.y = pack2(v.z, v.w);
        *(uint2*)(Ks + row * 136 + c4 * 4) = u;
      }
    }
    __syncthreads();
    gemm_epilogue<false>(acc, [&](int m, int n, float v) { Qs[m * 136 + n] = (bf16_t)f2bf(v); });
    __syncthreads();
#pragma unroll
    for (int mi = 0; mi < 2; ++mi)
#pragma unroll
      for (int ni = 0; ni < 2; ++ni)
#pragma unroll
        for (int r = 0; r < 16; ++r) acc[mi][ni][r] = 0.f;
    {
      const int fr = (lane & 31) * 136 + (lane >> 5) * 8;
#pragma unroll
      for (int kk = 0; kk < 8; ++kk) {
        bf16x8 af[2], bfr[2];
#pragma unroll
        for (int mi = 0; mi < 2; ++mi) af[mi] = *(const bf16x8*)(Qs + (wm * 64 + mi * 32) * 136 + fr + kk * 16);
#pragma unroll
        for (int ni = 0; ni < 2; ++ni) bfr[ni] = *(const bf16x8*)(Ks + (wn * 64 + ni * 32) * 136 + fr + kk * 16);
#pragma unroll
        for (int mi = 0; mi < 2; ++mi)
#pragma unroll
          for (int ni = 0; ni < 2; ++ni) acc[mi][ni] = MFMA(af[mi], bfr[ni], acc[mi][ni]);
      }
    }
    __syncthreads();
    gemm_epilogue<false>(acc, [&](int m, int n, float v) { Sc[m * 129 + n] = v; });
    __syncthreads();
    const int row = tid & 127, half = tid >> 7;
    float tv[16]; int ti[16];
#pragma unroll
    for (int k = 0; k < 16; ++k) { tv[k] = -3.0e38f; ti[k] = 0; }
    for (int e = 0; e < 64; ++e) insert16(tv, ti, Sc[row * 129 + half * 64 + e], half * 64 + e);
    __syncthreads();
    if (half == 1) {
#pragma unroll
      for (int k = 0; k < 16; ++k) { Lv[k * 128 + row] = tv[k]; Li[k * 128 + row] = ti[k]; }
    }
    __syncthreads();
    if (half == 0) {
#pragma unroll
      for (int k = 0; k < 16; ++k) insert16(tv, ti, Lv[k * 128 + row], Li[k * 128 + row]);
      float* ov = TKV + ((size_t)(t0 + row) * 16 + hp) * 16;
      int* oi = TKI + ((size_t)(t0 + row) * 16 + hp) * 16;
#pragma unroll
      for (int k = 0; k < 16; k += 4) {
        *(float4*)(ov + k) = make_float4(tv[k], tv[k + 1], tv[k + 2], tv[k + 3]);
        *(int4*)(oi + k) = make_int4(ti[k], ti[k + 1], ti[k + 2], ti[k + 3]);
      }
    }
  }
}

DI void phase_p2(const Params& p, unsigned char* smem, int l, int bid, int nb) {
  const int lane = tidx() & 63, wave = tidx() >> 6;
  int* sIdx = (int*)(smem + wave * 1024);
  float* sSc = (float*)(smem + wave * 1024 + 512);
  const bf16_t* H = (const bf16_t*)(p.ws + OFF_H);
  const float* TKV = (const float*)(p.ws + OFF_WD);
  const int* TKI = (const int*)(p.ws + OFF_WD + 20 * MiB);
  const bf16_t* TU = (const bf16_t*)(p.ws + OFF_TABU);
  const bf16_t* TV = (const bf16_t*)(p.ws + OFF_TABV);
  float* X = (float*)(p.ws + OFF_X);
  int ci = 0, cj = 0;
  {
    int q = lane;
    if (q < 16) { ci = 0; cj = q; } else if (q < 24) { ci = 1; cj = q - 16; } else if (q < 29) { ci = 2; cj = q - 24; }
    else if (q < 33) { ci = 3; cj = q - 29; } else if (q < 36) { ci = 4; cj = q - 33; }
    else if (q < 42) { ci = 5 + ((q - 36) >> 1); cj = (q - 36) & 1; } else if (q < 50) { ci = 8 + (q - 42); cj = 0; }
  }
  float plg[16], plb[16], pg2[16];
  load_row16(p.in[I_LN2G] + l * 1024, lane, plg);
  load_row16(p.in[I_LN2B] + l * 1024, lane, plb);
  int cvl = -1;
  for (int t = bid * 4 + wave; t < T; t += nb * 4) {
    int seq, s, S, cv; tok_info(t, seq, s, S, cv);
    float hreg[16];
    {
      const uint4* hp_ = (const uint4*)(H + (size_t)t * 1024 + lane * 16);
      uint4 a = hp_[0], b = hp_[1];
      float v0[8], v1[8]; unpack8(a, v0); unpack8(b, v1);
#pragma unroll
      for (int i = 0; i < 8; ++i) { hreg[i] = v0[i]; hreg[8 + i] = v1[i]; }
    }
    __builtin_amdgcn_wave_barrier();
    for (int h = 0; h < 8; ++h) {
      const float* v1p = TKV + ((size_t)t * 16 + h * 2) * 16;
      const int* i1p = TKI + ((size_t)t * 16 + h * 2) * 16;
      float c = -3.0e38f; int eidx = 0;
      if (lane < 50) { c = v1p[ci] + v1p[16 + cj]; eidx = i1p[ci] * 128 + i1p[16 + cj]; }
      int rank = 0;
#pragma unroll 5
      for (int m = 0; m < 50; ++m) {
        float cm = __int_as_float(__builtin_amdgcn_readlane(__float_as_int(c), m));
        rank += (cm > c || (cm == c && m < lane)) ? 1 : 0;
      }
      if (lane < 50 && rank < 16) { sIdx[h * 16 + rank] = eidx; sSc[h * 16 + rank] = c; }
    }
    __builtin_amdgcn_wave_barrier();
    {
      float s0 = sSc[lane], s1 = sSc[64 + lane];
      float m0 = max16(s0), m1 = max16(s1);
      float e0 = __expf(s0 - m0), e1 = __expf(s1 - m1);
      float d0 = sum16(e0), d1 = sum16(e1);
      __builtin_amdgcn_wave_barrier();
      sSc[lane] = e0 / d0; sSc[64 + lane] = e1 / d1;
    }
    __builtin_amdgcn_wave_barrier();
    float out[16];
#pragma unroll
    for (int i = 0; i < 16; ++i) out[i] = 0.f;
    const unsigned char* TU8 = (const unsigned char*)TU;
    const unsigned char* TV8 = (const unsigned char*)TV;
    for (int sb = 0; sb < 128; sb += 8) {
      uint4 u[8], w[8]; float gt[8];
#pragma unroll
      for (int k = 0; k < 8; ++k) {
        int e = __builtin_amdgcn_readfirstlane(sIdx[sb + k]);
        gt[k] = sSc[sb + k];
        u[k] = *(const uint4*)(TU8 + (size_t)e * 1024 + lane * 16);
        w[k] = *(const uint4*)(TV8 + (size_t)e * 1024 + lane * 16);
      }
      float dot[8];
#pragma unroll
      for (int k = 0; k < 8; ++k) {
        float a[16]; unpack_fp8x16(u[k], a);
        float d = 0.f;
#pragma unroll
        for (int i = 0; i < 16; ++i) d += hreg[i] * a[i];
        dot[k] = d;
      }
#pragma unroll
      for (int k = 0; k < 8; ++k) dot[k] = wave_sum(dot[k]);
#pragma unroll
      for (int k = 0; k < 8; ++k) {
        float wgt = gt[k] * gelu_t(dot[k] * (1.f / U_SCALE));
        float a[16]; unpack_fp8x16(w[k], a);
#pragma unroll
        for (int i = 0; i < 16; ++i) out[i] += wgt * a[i];
      }
    }
    if (cv != cvl) {
      const float* mod = (const float*)(p.ws + OFF_MOD) + (size_t)(l * 5 + cv) * 6144;
      load_row16(mod + 5 * 1024, lane, pg2);
      cvl = cv;
    }
    float x[16];
    load_row16(X + (size_t)t * 1024, lane, x);
#pragma unroll
    for (int i = 0; i < 16; ++i) x[i] = ALPHA_F * x[i] + pg2[i] * out[i];
    ln16(x);
#pragma unroll
    for (int i = 0; i < 16; ++i) x[i] = x[i] * plg[i] + plb[i];
    if (l == 3) {
      store_row16(p.out + (size_t)t * 1024, lane, x);
    } else {
      store_row16(X + (size_t)t * 1024, lane, x);
      ln16(x);
      {
        float psc[16], psh[16];
        const float* modn = (const float*)(p.ws + OFF_MOD) + (size_t)((l + 1) * 5 + cv) * 6144;
        load_row16(modn + 1024, lane, psc); load_row16(modn, lane, psh);
#pragma unroll
        for (int i = 0; i < 16; ++i) x[i] = x[i] * (1.f + psc[i]) + psh[i];
      }
      store_row16_bf((bf16_t*)(p.ws + OFF_H) + (size_t)t * 1024, lane, x);
    }
  }
}

DI void phase_o1(const Params& p, unsigned char* smem, int l, int bid, int nb) {
  const int j = l >> 1;
  bf16_t* As = (bf16_t*)smem; bf16_t* Bs = As + 128 * LDT;
  const bf16_t* H = (const bf16_t*)(p.ws + OFF_H);
  const bf16_t* Bt = (const bf16_t*)(p.ws + OFF_BT_IN_O) + (size_t)j * 2944 * 1024;
  bf16_t* Z = (bf16_t*)(p.ws + OFF_Z);
  for (int it = bid; it < 160 * 23; it += nb) {
    const int mt = it / 23, nt = it % 23, t0 = mt * 128;
    f32x16 acc[2][2];
    gemm_mainloop<false>(H + (size_t)t0 * 1024, 1024, Bt + (size_t)nt * 128 * 1024, 1024, 1024, acc, As, Bs);
    gemm_epilogue<false>(acc, [&](int m, int n, float v) { Z[(size_t)(t0 + m) * 2944 + nt * 128 + n] = (bf16_t)f2bf(v); });
  }
  convert_tables(p, l, bid, nb);
}

DI void phase_o2(const Params& p, int l, int bid, int nb) {
  const int j = l >> 1;
  const int lane = tidx() & 63, wave = tidx() >> 6;
  const bf16_t* Z = (const bf16_t*)(p.ws + OFF_Z);
  bf16_t* XC = (bf16_t*)(p.ws + OFF_XC);
  bf16_t* LRIN = (bf16_t*)(p.ws + OFF_LRIN);
  bf16_t* KKN = (bf16_t*)(p.ws + OFF_KKN);
  bf16_t* KS = (bf16_t*)(p.ws + OFF_KS);
  bf16_t* RS = (bf16_t*)(p.ws + OFF_RS);
  bf16_t* VS = (bf16_t*)(p.ws + OFF_VS);
  const float* mu = p.in[I_MU] + (size_t)j * 1920;
  const int c0 = lane * 8;
  for (int t = bid * 4 + wave; t < T; t += nb * 4) {
    int seq, s, S, cv; tok_info(t, seq, s, S, cv);
    const bf16_t* zr = Z + (size_t)t * 2944;
    {
      float af[8], ab[8];
      load8f(p.in[I_LCB] + (size_t)(j * 2 + 0) * 512 + c0, af);
      load8f(p.in[I_LCB] + (size_t)(j * 2 + 1) * 512 + c0, ab);
#pragma unroll
      for (int o = -3; o <= 3; ++o) {
        float xv[8];
        if (s + o >= 0 && s + o < S) { uint4 u = *(const uint4*)(zr + (ptrdiff_t)o * 2944 + c0); unpack8(u, xv); }
        else {
#pragma unroll
          for (int i = 0; i < 8; ++i) xv[i] = 0.f;
        }
        if (o <= 0) {
          float w[8]; load8f(p.in[I_LCW] + ((size_t)(j * 2 + 0) * 4 + (o + 3)) * 512 + c0, w);
#pragma unroll
          for (int i = 0; i < 8; ++i) af[i] += w[i] * xv[i];
        }
        if (o >= 0) {
          float w[8]; load8f(p.in[I_LCW] + ((size_t)(j * 2 + 1) * 4 + (3 - o)) * 512 + c0, w);
#pragma unroll
          for (int i = 0; i < 8; ++i) ab[i] += w[i] * xv[i];
        }
      }
      *(uint4*)(XC + (size_t)t * 512 + c0) = pack8(af);
      *(uint4*)(XC + (size_t)T * 512 + (size_t)t * 512 + c0) = pack8(ab);
    }
    const bool hp_ = s > 0, hn = s < S - 1;
#pragma unroll
    for (int part = 0; part < 3; ++part) {
      const int col = 1024 + part * 512 + c0;
      float zc[8], zp[8], zn[8], m[8], zs[8];
      unpack8(*(const uint4*)(zr + col), zc);
      if (hp_) unpack8(*(const uint4*)(zr - 2944 + col), zp); else {
#pragma unroll
        for (int i = 0; i < 8; ++i) zp[i] = 0.f;
      }
      if (hn) unpack8(*(const uint4*)(zr + 2944 + col), zn); else {
#pragma unroll
        for (int i = 0; i < 8; ++i) zn[i] = 0.f;
      }
      load8f(mu + (col - 1024), m);
#pragma unroll
      for (int i = 0; i < 8; ++i) zs[i] = zc[i] + m[i] * (0.5f * (zp[i] + zn[i]) - zc[i]);
      if (part == 0) *(uint4*)(RS + (size_t)t * 512 + c0) = pack8(zs);
      else if (part == 2) *(uint4*)(VS + (size_t)t * 512 + c0) = pack8(zs);
      else {
        *(uint4*)(KS + (size_t)t * 512 + c0) = pack8(zs);
#pragma unroll
        for (int d = 0; d < 2; ++d) {
          float kk[8], raw[8]; load8f(p.in[I_KK] + (size_t)(j * 2 + d) * 512 + c0, kk);
          float ss = 0.f;
#pragma unroll
          for (int i = 0; i < 8; ++i) { raw[i] = zs[i] * kk[i]; ss += raw[i] * raw[i]; }
          ss = sum8(ss);
          float inv = rsqrtf(fmaxf(ss, 1e-24f));
#pragma unroll
          for (int i = 0; i < 8; ++i) raw[i] *= inv;
          *(uint4*)(KKN + (size_t)d * T * 512 + (size_t)t * 512 + c0) = pack8(raw);
        }
      }
    }
    if (lane < 48) {
      const int col = 2560 + c0;
      float zc[8], zp[8], zn[8], m[8], zs[8];
      unpack8(*(const uint4*)(zr + col), zc);
      if (hp_) unpack8(*(const uint4*)(zr - 2944 + col), zp); else {
#pragma unroll
        for (int i = 0; i < 8; ++i) zp[i] = 0.f;
      }
      if (hn) unpack8(*(const uint4*)(zr + 2944 + col), zn); else {
#pragma unroll
        for (int i = 0; i < 8; ++i) zn[i] = 0.f;
      }
      load8f(mu + (col - 1024), m);
#pragma unroll
      for (int i = 0; i < 8; ++i) {
        float z = zc[i] + m[i] * (0.5f * (zp[i] + zn[i]) - zc[i]);
        zs[i] = (lane < 16) ? tanh_f(z) : ((lane < 32) ? z : sigm(z));
      }
      *(uint4*)(LRIN + (size_t)t * 384 + c0) = pack8(zs);
    }
  }
}

DI void store8f(float* p, const float (&v)[8]) {
  ((float4*)p)[0] = make_float4(v[0], v[1], v[2], v[3]);
  ((float4*)p)[1] = make_float4(v[4], v[5], v[6], v[7]);
}
template <class F>
DI void staged_epilogue(const f32x16 (&acc)[2][2], float* Cs, F f) {
  __syncthreads();
  gemm_epilogue<false, false>(acc, [&](int m, int n, float v) { Cs[m * 132 + n] = v; });
  __syncthreads();
  const int tid = tidx(), r0 = tid >> 4, c8 = (tid & 15) * 8;
#pragma unroll 2
  for (int ps = 0; ps < 8; ++ps) {
    const int row = ps * 16 + r0;
    float v[8];
    load8f(Cs + row * 132 + c8, v);
    f(row, c8, v);
  }
}

DI void phase_o3(const Params& p, unsigned char* smem, int l, int bid, int nb) {
  const int j = l >> 1;
  bf16_t* As = (bf16_t*)smem; bf16_t* Bs = As + 128 * LDT;
  float* Cs = (float*)smem;
  const bf16_t* __restrict__ XC = (const bf16_t*)(p.ws + OFF_XC);
  const bf16_t* __restrict__ LRIN = (const bf16_t*)(p.ws + OFF_LRIN);
  const bf16_t* __restrict__ KKN = (const bf16_t*)(p.ws + OFF_KKN);
  const bf16_t* __restrict__ KS = (const bf16_t*)(p.ws + OFF_KS);
  float* __restrict__ LA = (float*)(p.ws + OFF_MIX);
  bf16_t* __restrict__ LB = (bf16_t*)(p.ws + OFF_LB);
  float* __restrict__ WD = (float*)(p.ws + OFF_WD);
  bf16_t* __restrict__ KKA = (bf16_t*)(p.ws + OFF_KKA);
  bf16_t* __restrict__ KM = (bf16_t*)(p.ws + OFF_KM);
  bf16_t* __restrict__ G = (bf16_t*)(p.ws + OFF_G);
  const int c8 = (tidx() & 15) * 8;
  for (int it = bid; it < 160 * 28; it += nb) {
    const int mt = it / 28, jb = it % 28, t0 = mt * 128;
    if (jb < 8) {
      const int d = jb >> 2, nt = jb & 3, ng = nt * 128 + c8;
      const bf16_t* A = XC + (size_t)d * T * 512 + (size_t)t0 * 512 + nt * 128;
      const bf16_t* Br = (const bf16_t*)(p.ws + OFF_BT_GATE) + ((size_t)((j * 2 + d) * 2 + 0) * 512 + nt * 128) * 128;
      const bf16_t* Bi = (const bf16_t*)(p.ws + OFF_BT_GATE) + ((size_t)((j * 2 + d) * 2 + 1) * 512 + nt * 128) * 128;
      float ba8[8], bx8[8], sp8[8];
      load8f(p.in[I_LBA] + (size_t)(j * 2 + d) * 512 + ng, ba8);
      load8f(p.in[I_LBX] + (size_t)(j * 2 + d) * 512 + ng, bx8);
      load8f(p.in[I_LLAM] + (size_t)(j * 2 + d) * 512 + ng, sp8);
#pragma unroll
      for (int i = 0; i < 8; ++i) { float nl = -sp8[i]; sp8[i] = -8.f * (nl > 20.f ? nl : log1pf(__expf(nl))); }
      {
        f32x16 acc[2][2];
        gemm_mainloop<false>(A, 512, Br, 128, 128, acc, As, Bs);
        staged_epilogue(acc, Cs, [&](int row, int cc, const float (&v)[8]) {
          const size_t o = ((size_t)d * T + t0 + row) * 512 + nt * 128 + cc;
          float a[8];
#pragma unroll
          for (int i = 0; i < 8; ++i) a[i] = __expf(sigm(v[i] + ba8[i]) * sp8[i]);
          store8f(LA + o, a);
        });
      }
      {
        f32x16 acc[2][2];
        gemm_mainloop<false>(A, 512, Bi, 128, 128, acc, As, Bs);
        staged_epilogue(acc, Cs, [&](int row, int cc, const float (&v)[8]) {
          const size_t o = ((size_t)d * T + t0 + row) * 512 + nt * 128 + cc;
          float a[8], xc[8], bb[8];
          load8f(LA + o, a);
          unpack8(*(const uint4*)(XC + o), xc);
#pragma unroll
          for (int i = 0; i < 8; ++i) bb[i] = sqrtf(fmaxf(1.f - a[i] * a[i], 0.f)) * sigm(v[i] + bx8[i]) * xc[i];
          *(uint4*)(LB + o) = pack8(bb);
        });
      }
    } else if (jb < 16) {
      const int d = (jb - 8) >> 2, nt = (jb - 8) & 3, ng = nt * 128 + c8;
      float w08[8]; load8f(p.in[I_W0] + (size_t)(j * 2 + d) * 512 + ng, w08);
      f32x16 acc[2][2];
      gemm_mainloop<false>(LRIN + (size_t)t0 * 384 + d * 64, 384, (const bf16_t*)(p.ws + OFF_BT_W2) + ((size_t)(j * 2 + d) * 512 + nt * 128) * 64, 64, 64, acc, As, Bs);
      staged_epilogue(acc, Cs, [&](int row, int cc, const float (&v)[8]) {
        float w[8];
#pragma unroll
        for (int i = 0; i < 8; ++i) w[i] = __expf(-0.6065306597126334f * sigm(w08[i] + v[i]));
        store8f(WD + ((size_t)d * T + t0 + row) * 512 + nt * 128 + cc, w);
      });
    } else if (jb < 24) {
      const int d = (jb - 16) >> 2, nt = (jb - 16) & 3, ng = nt * 128 + c8;
      float a08[8], ka8[8];
      load8f(p.in[I_A0] + (size_t)(j * 2 + d) * 512 + ng, a08);
      load8f(p.in[I_KA] + (size_t)(j * 2 + d) * 512 + ng, ka8);
      f32x16 acc[2][2];
      gemm_mainloop<false>(LRIN + (size_t)t0 * 384 + 128 + d * 64, 384, (const bf16_t*)(p.ws + OFF_BT_A2) + ((size_t)(j * 2 + d) * 512 + nt * 128) * 64, 64, 64, acc, As, Bs);
      staged_epilogue(acc, Cs, [&](int row, int cc, const float (&v)[8]) {
        const size_t o = ((size_t)d * T + t0 + row) * 512 + nt * 128 + cc;
        float kkn[8], ks[8], oa[8], om[8];
        unpack8(*(const uint4*)(KKN + o), kkn);
        unpack8(*(const uint4*)(KS + (size_t)(t0 + row) * 512 + nt * 128 + cc), ks);
#pragma unroll
        for (int i = 0; i < 8; ++i) {
          float ic = sigm(a08[i] + v[i]);
          oa[i] = kkn[i] * ic;
          om[i] = ks[i] * (1.f + (ic - 1.f) * ka8[i]);
        }
        *(uint4*)(KKA + o) = pack8(oa);
        *(uint4*)(KM + o) = pack8(om);
      });
    } else {
      const int nt = jb - 24;
      f32x16 acc[2][2];
      gemm_mainloop<false>(LRIN + (size_t)t0 * 384 + 256, 384, (const bf16_t*)(p.ws + OFF_BT_G2) + ((size_t)j * 512 + nt * 128) * 128, 128, 128, acc, As, Bs);
      staged_epilogue(acc, Cs, [&](int row, int cc, const float (&v)[8]) {
        float g[8];
#pragma unroll
        for (int i = 0; i < 8; ++i) g[i] = v[i];
        *(uint4*)(G + (size_t)(t0 + row) * 512 + nt * 128 + cc) = pack8(g);
      });
    }
  }
}

constexpr int WCH = 16;
constexpr int WBUF = 5 * 4096 + 1024;
#define WKV_GLOAD(S_, c_)                                                                                                \
  {                                                                                                                      \
    const int base_ = (c_) * WCH;                                                                                        \
    S_##w = *(const uint4*)(WD + (unsigned)(tokof(base_ + (tid >> 4)) * 2048 + (tid & 15) * 16));                        \
    const unsigned o2_ = (unsigned)(tokof(base_ + ((tid & 127) >> 3)) * 1024 + (tid & 7) * 16);                          \
    S_##a = *(const uint4*)((tid < 128 ? KKN : KM) + o2_);                                                                \
    S_##b = *(const uint4*)((tid < 128 ? KKA : RS) + o2_);                                                                \
    if (tid < 32) S_##v = *(const uint4*)(VS + (unsigned)(tokof(base_ + (tid >> 1)) * 1024 + (tid & 1) * 16));           \
  }
#define WKV_LSTORE(S_, bufi_)                                                                                            \
  {                                                                                                                      \
    unsigned char* bb_ = smem + (bufi_) * WBUF;                                                                           \
    *(uint4*)(bb_ + tid * 16) = S_##w;                                                                                    \
    float f_[8];                                                                                                         \
    unsigned char* pa_ = bb_ + (tid < 128 ? 4096 : 12288) + (tid & 127) * 32;                                            \
    unpack8(S_##a, f_); store8f((float*)pa_, f_);                                                                         \
    unpack8(S_##b, f_); store8f((float*)(pa_ + 4096), f_);                                                               \
    if (tid < 32) { unpack8(S_##v, f_); store8f((float*)(bb_ + 20480 + tid * 32), f_); }                                  \
  }
DI void wkv_scan_item(const Params& p, unsigned char* smem, int j, int b, int d, int h, int rg, bool ctx) {
  const int tid = tidx(), lane = tid & 63, wave = tid >> 6;
  const int rl = wave * 4 + (lane >> 4), row = rg * 16 + rl, q = lane & 15;
  const int S = ctx ? 256 : 4096, t0 = ctx ? b * 256 : 4096 + b * 4096;
  const char* WD = (const char*)(p.ws + OFF_WD) + (size_t)d * T * 512 * 4 + h * 256;
  const char* KKN = (const char*)(p.ws + OFF_KKN) + (size_t)d * T * 512 * 2 + h * 128;
  const char* KKA = (const char*)(p.ws + OFF_KKA) + (size_t)d * T * 512 * 2 + h * 128;
  const char* KM = (const char*)(p.ws + OFF_KM) + (size_t)d * T * 512 * 2 + h * 128;
  const char* RS = (const char*)(p.ws + OFF_RS) + h * 128;
  const char* VS = (const char*)(p.ws + OFF_VS) + (h * 64 + rg * 16) * 2;
  char* Y = (char*)(p.ws + (d ? OFF_XC : OFF_H)) + (h * 64 + rg * 16) * 4;
  unsigned char* ysb = smem + 3 * WBUF;
  float st[4];
  if (ctx) { st[0] = st[1] = st[2] = st[3] = 0.f; }
  else {
    float4 s4 = *(const float4*)(p.in[I_SWKV] + ((((size_t)(b * 2 + j) * 2 + d) * 8 + h) * 64 + row) * 64 + q * 4);
    st[0] = s4.x; st[1] = s4.y; st[2] = s4.z; st[3] = s4.w;
  }
  auto tokof = [&](int step) -> int { return t0 + (d ? (S - 1 - step) : step); };
  const uint4 z4 = make_uint4(0u, 0u, 0u, 0u);
  uint4 g0w = z4, g0a = z4, g0b = z4, g0v = z4, g1w = z4, g1a = z4, g1b = z4, g1v = z4;
  const int nch = S / WCH;
  __syncthreads();
  WKV_GLOAD(g0, 0) WKV_GLOAD(g1, 1)
  WKV_LSTORE(g0, 0) WKV_LSTORE(g1, 1)
  WKV_GLOAD(g0, 2) WKV_GLOAD(g1, 3)
  __syncthreads();
  auto compute = [&](int c) {
    const unsigned char* bb = smem + (c % 3) * WBUF;
    float* ys = (float*)(ysb + (c & 1) * 1024);
    float4 nw = *(const float4*)(bb + q * 16), nkk = *(const float4*)(bb + 4096 + q * 16), nkka = *(const float4*)(bb + 8192 + q * 16);
    float4 nkm = *(const float4*)(bb + 12288 + q * 16), nr = *(const float4*)(bb + 16384 + q * 16);
    float nv = *(const float*)(bb + 20480 + rl * 4);
#pragma unroll
    for (int s = 0; s < WCH; ++s) {
      const float4 w = nw, kk = nkk, kka = nkka, km = nkm, r = nr; const float v = nv;
      {
        const int s1 = (s + 1 < WCH) ? s + 1 : s;
        nw = *(const float4*)(bb + s1 * 256 + q * 16); nkk = *(const float4*)(bb + 4096 + s1 * 256 + q * 16);
        nkka = *(const float4*)(bb + 8192 + s1 * 256 + q * 16); nkm = *(const float4*)(bb + 12288 + s1 * 256 + q * 16);
        nr = *(const float4*)(bb + 16384 + s1 * 256 + q * 16); nv = *(const float*)(bb + 20480 + s1 * 64 + rl * 4);
      }
      float sk = st[0] * kk.x + st[1] * kk.y + st[2] * kk.z + st[3] * kk.w;
      sk = sum16(sk);
      st[0] = st[0] * w.x - sk * kka.x + v * km.x;
      st[1] = st[1] * w.y - sk * kka.y + v * km.y;
      st[2] = st[2] * w.z - sk * kka.z + v * km.z;
      st[3] = st[3] * w.w - sk * kka.w + v * km.w;
      float y = st[0] * r.x + st[1] * r.y + st[2] * r.z + st[3] * r.w;
      y = sum16(y);
      ys[s * 16 + rl] = y;
    }
  };
  auto flush = [&](int c) {
    const float* ys = (const float*)(ysb + (c & 1) * 1024);
    const int s1 = tid >> 4, rr = tid & 15;
    *(float*)(Y + (unsigned)(tokof(c * WCH + s1) * 2048 + rr * 4)) = ys[s1 * 16 + rr];
  };
  for (int c = 0; c < nch; c += 2) {
    compute(c);
    if (c + 2 < nch) WKV_LSTORE(g0, (c + 2) % 3)
    if (c + 4 < nch) WKV_GLOAD(g0, c + 4)
    __syncthreads();
    flush(c);
    compute(c + 1);
    if (c + 3 < nch) WKV_LSTORE(g1, (c + 3) % 3)
    if (c + 5 < nch) WKV_GLOAD(g1, c + 5)
    __syncthreads();
    flush(c + 1);
  }
  if (ctx) {
    float* o = p.out + 21004288 + ((((size_t)(b * 2 + j) * 2 + d) * 8 + h) * 64 + row) * 64 + q * 4;
    *(float4*)o = make_float4(st[0], st[1], st[2], st[3]);
  }
}
#undef WKV_GLOAD
#undef WKV_LSTORE

DI void lru_scan_item(const Params& p, unsigned char* smem, int j, int b, int cgp, bool ctx, int chb) {
  const int tid = tidx(), c = tid & ((1 << chb) - 1), sg = tid >> chb;
  const int nseg = NTHR >> chb;
  const int ch = (cgp << chb) + c;
  const int S = ctx ? 256 : 4096, t0 = ctx ? b * 256 : 4096 + b * 4096;
  const int L = S / nseg;
  float* sA = (float*)smem; float* sB = sA + 256;
  char* YM = (char*)(p.ws + OFF_YMIX);
  const char* Z = (const char*)(p.ws + OFF_Z);
  for (int d = 0; d < 2; ++d) {
    const char* la = (const char*)(p.ws + OFF_MIX) + (size_t)d * T * 512 * 4;
    const char* lb = (const char*)(p.ws + OFF_LB) + (size_t)d * T * 512 * 2;
    float A = 1.f, Bv = 0.f;
#pragma unroll 8
    for (int st = sg * L; st < (sg + 1) * L; ++st) {
      const int tk = t0 + (d ? (S - 1 - st) : st);
      float a = *(const float*)(la + (unsigned)(tk * 2048 + ch * 4));
      float bb = bf2f(*(const bf16_t*)(lb + (unsigned)(tk * 1024 + ch * 2)));
      A *= a; Bv = a * Bv + bb;
    }
    __syncthreads();
    sA[tid] = A; sB[tid] = Bv;
    __syncthreads();
    float h = ctx ? 0.f : p.in[I_SLRU][((size_t)(b * 2 + j) * 2 + d) * 512 + ch];
    for (int s2 = 0; s2 < sg; ++s2) h = sA[(s2 << chb) + c] * h + sB[(s2 << chb) + c];
#pragma unroll 8
    for (int st = sg * L; st < (sg + 1) * L; ++st) {
      const int tk = t0 + (d ? (S - 1 - st) : st);
      float a = *(const float*)(la + (unsigned)(tk * 2048 + ch * 4));
      float bb = bf2f(*(const bf16_t*)(lb + (unsigned)(tk * 1024 + ch * 2)));
      h = a * h + bb;
      bf16_t* ym = (bf16_t*)(YM + (unsigned)(tk * 2048 + ch * 2));
      if (d == 0) *ym = (bf16_t)f2bf(h);
      else {
        float hs = h + bf2f(*ym);
        float gb = bf2f(*(const bf16_t*)(Z + (unsigned)(tk * 5888 + 1024 + ch * 2)));
        *ym = (bf16_t)f2bf(hs * gelu_t(gb));
      }
    }
    if (ctx && sg == nseg - 1) p.out[20971520 + ((size_t)(b * 2 + j) * 2 + d) * 512 + ch] = h;
    __syncthreads();
  }
}

DI void phase_o4(const Params& p, unsigned char* smem, int l, int bid, int nb) {
  const int j = l >> 1;
  auto do_item = [&](int it) {
    if (it < 256) { int sid = it >> 2, rg = it & 3; wkv_scan_item(p, smem, j, sid >> 4, (sid >> 3) & 1, sid & 7, rg, false); }
    else if (it < 512) { int r = it - 256; lru_scan_item(p, smem, j, r >> 6, r & 63, false, 3); }
    else if (it < 1536) { int r = it - 512; int sid = r >> 2, rg = r & 3; wkv_scan_item(p, smem, j, sid >> 4, (sid >> 3) & 1, sid & 7, rg, true); }
    else { int r = it - 1536; lru_scan_item(p, smem, j, r >> 4, r & 15, true, 5); }
  };
  if (nb >= 512) {
    if (bid < 256) do_item(bid);
    else {
      const int ob = bid - 256, no = nb - 256;
      for (int it = 256 + ob; it < 512; it += no) do_item(it);
      for (int it = 512 + ob; it < 1792; it += no) do_item(it);
    }
  } else {
    for (int it = bid; it < 1792; it += nb) do_item(it);
  }
}

DI void phase_o5(const Params& p, int l, int bid, int nb) {
  const int j = l >> 1;
  const int lane = tidx() & 63, wave = tidx() >> 6;
  const float* YF = (const float*)(p.ws + OFF_H);
  const float* YB = (const float*)(p.ws + OFF_XC);
  const bf16_t* RS = (const bf16_t*)(p.ws + OFF_RS);
  const bf16_t* VS = (const bf16_t*)(p.ws + OFF_VS);
  const bf16_t* KM = (const bf16_t*)(p.ws + OFF_KM);
  const bf16_t* G = (const bf16_t*)(p.ws + OFF_G);
  bf16_t* YM = (bf16_t*)(p.ws + OFF_YMIX);
  const int c0 = lane * 8;
  float gng[8], gnb[8], rk[8];
  load8f(p.in[I_GNG] + j * 512 + c0, gng);
  load8f(p.in[I_GNB] + j * 512 + c0, gnb);
  load8f(p.in[I_RK] + j * 512 + c0, rk);
  for (int t = bid * 4 + wave; t < T; t += nb * 4) {
    const size_t o = (size_t)t * 512 + c0;
    float yf[8], yb[8], ys[8];
    load8f(YF + o, yf); load8f(YB + o, yb);
    float s = 0.f;
#pragma unroll
    for (int i = 0; i < 8; ++i) { ys[i] = yf[i] + yb[i]; s += ys[i]; }
    const float mean = sum8(s) * (1.f / 64.f);
    float v = 0.f;
#pragma unroll
    for (int i = 0; i < 8; ++i) { float dd = ys[i] - mean; v += dd * dd; }
    const float rstd = rsqrtf(sum8(v) * (1.f / 64.f) + 64e-5f);
    float r[8], vv[8], kf[8], kb[8], g[8];
    unpack8(*(const uint4*)(RS + o), r);
    unpack8(*(const uint4*)(VS + o), vv);
    unpack8(*(const uint4*)(KM + o), kf);
    unpack8(*(const uint4*)(KM + (size_t)T * 512 + o), kb);
    unpack8(*(const uint4*)(G + o), g);
    float sf = 0.f;
#pragma unroll
    for (int i = 0; i < 8; ++i) sf += r[i] * rk[i] * (kf[i] + kb[i]);
    sf = sum8(sf);
    float outv[8];
#pragma unroll
    for (int i = 0; i < 8; ++i) outv[i] = ((ys[i] - mean) * rstd * gng[i] + gnb[i] + sf * vv[i]) * g[i];
    *(uint4*)(YM + (size_t)t * 1024 + 512 + c0) = pack8(outv);
  }
}

enum { PH_PREP = 0, PH_INIT, PH_E1, PH_E2, PH_EOUT, PH_RES, PH_P1, PH_P2, PH_O1, PH_O2, PH_O3, PH_O4, PH_O5, PH_OOUT };

DI void run_phase(const Params& p, unsigned char* smem, int ph, int l, int bid, int nb) {
  switch (ph) {
    case PH_PREP: phase_prep(p, smem, bid, nb); break;
    case PH_INIT: phase_init(p, bid, nb); break;
    case PH_E1: phase_e1(p, smem, l, bid, nb); break;
    case PH_E2: phase_e2(p, smem, l, bid, nb); break;
    case PH_EOUT: phase_outgemm(p, smem, (const bf16_t*)(p.ws + OFF_BT_OUT_E) + (size_t)(l >> 1) * 1024 * 1024, bid, nb); break;
    case PH_RES: phase_res1(p, l, bid, nb); break;
    case PH_P1: phase_p1(p, smem, l, bid, nb); break;
    case PH_P2: phase_p2(p, smem, l, bid, nb); break;
    case PH_O1: phase_o1(p, smem, l, bid, nb); break;
    case PH_O2: phase_o2(p, l, bid, nb); break;
    case PH_O3: phase_o3(p, smem, l, bid, nb); break;
    case PH_O4: phase_o4(p, smem, l, bid, nb); break;
    case PH_O5: phase_o5(p, l, bid, nb); break;
    case PH_OOUT: phase_outgemm(p, smem, (const bf16_t*)(p.ws + OFF_BT_OUT_O) + (size_t)(l >> 1) * 1024 * 1024, bid, nb); break;
  }
}


#define XB_TMO      128
#define XB_XCNT(j)  (256  + 64 * (j))
#define XB_XSUB(j)  (1280 + 64 * (j))
#define XB_XGEN(j)  (2304 + 64 * (j))
#define XB_TOP      3328
#define XB_TOPGEN   3392
#define XCD_BAR_WORDS 3456
#define XB_SPIN_CAP (1u << 22)
#define LAS __attribute__((address_space(3)))
DI unsigned xb_ld(unsigned* p) { return __hip_atomic_load(p, __ATOMIC_RELAXED, __HIP_MEMORY_SCOPE_AGENT); }
DI unsigned xb_add(unsigned* p, unsigned v) { return __hip_atomic_fetch_add(p, v, __ATOMIC_RELAXED, __HIP_MEMORY_SCOPE_AGENT); }
DI unsigned xb_xcc_id() { return (unsigned)__builtin_amdgcn_s_getreg((3 << 11) | 20) & 0xFu; }
#define XB_SPIN(cond, bar) do { unsigned _sp = 0; while (cond) { __builtin_amdgcn_s_sleep(1); \
    if ((++_sp & 255u) == 0u) { if (xb_ld(&(bar)[XB_TMO])) break; if (_sp > XB_SPIN_CAP) { atomicAdd(&(bar)[XB_TMO], 1u); break; } } } } while (0)
struct XcdBarrier { unsigned* bar; unsigned x; volatile LAS unsigned* st; };
DI XcdBarrier xcd_barrier_post(unsigned* bar, volatile LAS unsigned* st) {
  XcdBarrier b; b.bar = bar; b.x = xb_xcc_id(); b.st = st;
  if (__builtin_amdgcn_workitem_id_x() == 0) (void)xb_add(&bar[XB_XCNT(b.x)], 1u);
  return b;
}
DI void xcd_barrier_complete(unsigned* bar, unsigned x, unsigned& nloc, unsigned& nx) {
  const unsigned G = gridDim.x;
  unsigned sum, cnt, mine, sp = 0u;
  for (;;) {
    sum = 0u; cnt = 0u; mine = 0u;
#pragma unroll
    for (unsigned j = 0; j < 16; ++j) { const unsigned c = xb_ld(&bar[XB_XCNT(j)]); sum += c; cnt += (c > 0u) ? 1u : 0u; mine = (j == x) ? c : mine; }
    if (sum == G) break;
    __builtin_amdgcn_s_sleep(1);
    if ((++sp & 255u) == 0u) { if (xb_ld(&bar[XB_TMO])) break; if (sp > XB_SPIN_CAP) { atomicAdd(&bar[XB_TMO], 1u); break; } }
  }
  nloc = mine > 0u ? mine : 1u; nx = cnt > 0u ? cnt : 1u;
}
DI void xcd_barrier(const XcdBarrier& b) {
  asm volatile("s_waitcnt vmcnt(0)" ::: "memory");
  __syncthreads();
  if (__builtin_amdgcn_workitem_id_x() == 0) {
    unsigned* bar = b.bar;
    __builtin_amdgcn_s_waitcnt(0);
    unsigned nloc = b.st[0], nx = b.st[1];
    if (nloc == 0u) { xcd_barrier_complete(bar, b.x, nloc, nx); b.st[0] = nloc; b.st[1] = nx; }
    const unsigned old = xb_add(&bar[XB_XSUB(b.x)], 1u);
    const unsigned gen = old / nloc;
    if (old + 1u == (gen + 1u) * nloc) {
      __builtin_amdgcn_fence(__ATOMIC_RELEASE, "agent");
      asm volatile("s_waitcnt vmcnt(0)" ::: "memory");
      const unsigned og = xb_add(&bar[XB_TOP], 1u);
      const unsigned tg = og / nx;
      if (og + 1u == (tg + 1u) * nx) xb_add(&bar[XB_TOPGEN], 1u);
      else XB_SPIN(xb_ld(&bar[XB_TOPGEN]) == tg, bar);
      __builtin_amdgcn_fence(__ATOMIC_ACQUIRE, "agent");
      xb_add(&bar[XB_XGEN(b.x)], 1u);
      asm volatile("s_waitcnt vmcnt(0)" ::: "memory");
    } else {
      XB_SPIN(xb_ld(&bar[XB_XGEN(b.x)]) == gen, bar);
      __builtin_amdgcn_fence(__ATOMIC_ACQUIRE, "agent");
      asm volatile("s_waitcnt vmcnt(0)" ::: "memory");
    }
  }
  __syncthreads();
}

DI void grid_seam(cg::grid_group& grid) {
  asm volatile("s_waitcnt vmcnt(0)" ::: "memory");
  grid.sync();
  asm volatile("buffer_inv sc1\n\ts_waitcnt vmcnt(0)" ::: "memory");
}
#if MULTI
__global__ void __launch_bounds__(NTHR, 2) phase_kernel(Params p, int ph, int l) {
  extern __shared__ __attribute__((aligned(16))) unsigned char smem[];
  run_phase(p, smem, ph, l, blockIdx.x, gridDim.x);
}
#else
#ifndef TPROBE
#define TPROBE 0
#endif
__global__ void __launch_bounds__(NTHR, 2) mega_kernel(Params p) {
  extern __shared__ __attribute__((aligned(16))) unsigned char smem[];
  cg::grid_group grid = cg::this_grid();
  const int bid = blockIdx.x, nb = gridDim.x;
  if (__builtin_amdgcn_workitem_id_x() == 0) *(uint4*)(smem + LDS_MAIN) = make_uint4(0u, 0u, 0u, 0u);
  __syncthreads();
  XcdBarrier xb = xcd_barrier_post((unsigned*)(p.ws + OFF_BAR), (volatile LAS unsigned*)(smem + LDS_MAIN));
#if TPROBE
  unsigned long long tprev = wall_clock64(), tsel = 0, ttot = 0;
#endif
  for (int step = 0; step < 32; ++step) {
    int ph, l;
    if (step < 2) { ph = step; l = 0; }
    else {
      int s = step - 2, k;
      if (s < 6) { l = 0; k = s; } else if (s < 15) { l = 1; k = s - 6; } else if (s < 21) { l = 2; k = s - 15; } else { l = 3; k = s - 21; }
      if ((l & 1) == 0) ph = PH_E1 + k;
      else ph = (k < 6) ? PH_O1 + k : PH_RES + (k - 6);
    }
#if defined(__HIP_DEVICE_COMPILE__)
    const __attribute__((address_space(4))) Params* kp = (const __attribute__((address_space(4))) Params*)__builtin_amdgcn_kernarg_segment_ptr();
    asm volatile("" : "+s"(kp), "+s"(l), "+s"(ph));
    const Params q = *kp;
#else
    const Params q = p;
#endif
    run_phase(q, smem, ph, l, bid, nb);
#if !TPROBE
    if (step == 31) break;
#endif
    if (step == 0) grid_seam(grid);
    else xcd_barrier(xb);
#if TPROBE
    {
      unsigned long long tn = wall_clock64();
      if ((TPROBE >> ph) & 1) tsel += tn - tprev;
      ttot += tn - tprev;
      tprev = tn;
    }
#endif
  }
#if TPROBE
  if (bid == 0) {
    float frac = (float)((double)tsel / (double)ttot);
    float sc = 1.f + sqrtf(frac);
    for (int i = tidx(); i < 32768; i += NTHR) p.out[20971520 + i] *= sc;
  }
#endif
}
#endif

extern "C" void kernel_launch(void* const* d_in, const int* in_sizes, int n_in, void* d_out, int out_size, void* d_ws, size_t ws_size,
                              hipStream_t stream) {
  static int grid_blocks = 0;
  if (grid_blocks == 0) {
    if (n_in != 40 || ws_size < WS_END) { fprintf(stderr, "kernel_launch: unexpected n_in %d or ws_size %zu (need %zu)\n", n_in, ws_size, (size_t)WS_END); grid_blocks = -1; return; }
    int dev = 0, cus = 0, per_cu = 0;
    hipGetDevice(&dev);
    hipDeviceGetAttribute(&cus, hipDeviceAttributeMultiprocessorCount, dev);
#if MULTI
    hipFuncSetAttribute((const void*)phase_kernel, hipFuncAttributeMaxDynamicSharedMemorySize, LDS_BYTES);
    hipOccupancyMaxActiveBlocksPerMultiprocessor(&per_cu, (const void*)phase_kernel, NTHR, LDS_BYTES);
#else
    hipFuncSetAttribute((const void*)mega_kernel, hipFuncAttributeMaxDynamicSharedMemorySize, LDS_BYTES);
    hipOccupancyMaxActiveBlocksPerMultiprocessor(&per_cu, (const void*)mega_kernel, NTHR, LDS_BYTES);
#endif
    if (per_cu < 1) per_cu = 1;
    if (per_cu > 2) per_cu = 2;
    if (cus < 1) cus = 256;
    grid_blocks = cus * per_cu;
  }
  if (grid_blocks < 0) return;
  Params p{};
  for (int i = 0; i < 40; ++i) p.in[i] = (const float*)d_in[i];
  p.out = (float*)d_out;
  p.ws = (unsigned char*)d_ws;
#if MULTI
  auto L = [&](int ph, int l) { hipLaunchKernelGGL(phase_kernel, dim3(grid_blocks), dim3(NTHR), LDS_BYTES, stream, p, ph, l); };
  L(PH_PREP, 0); L(PH_INIT, 0);
  for (int l = 0; l < 4; ++l) {
    if ((l & 1) == 0) { L(PH_E1, l); L(PH_E2, l); L(PH_EOUT, l); }
    else { L(PH_O1, l); L(PH_O2, l); L(PH_O3, l); L(PH_O4, l); L(PH_O5, l); L(PH_OOUT, l); }
    L(PH_RES, l); L(PH_P1, l); L(PH_P2, l);
  }
#else
  (void)hipMemsetAsync((char*)d_ws + OFF_BAR, 0, XCD_BAR_WORDS * sizeof(unsigned), stream);
  void* args[] = {&p};
  hipError_t e = hipLaunchCooperativeKernel((const void*)mega_kernel, dim3(grid_blocks), dim3(NTHR), args, LDS_BYTES, stream);
  if (e != hipSuccess) fprintf(stderr, "cooperative launch failed: %s (grid %d)\n", hipGetErrorString(e), grid_blocks);
#endif
}
```

```cpp
#include <hip/hip_runtime.h>
#include <hip/hip_cooperative_groups.h>
#include <cstdio>
#include <cstdint>
namespace cg = cooperative_groups;

#ifndef MULTI
#define MULTI 0
#endif

typedef unsigned short bf16_t;
using bf16x8 = __attribute__((ext_vector_type(8))) short;
using f32x16 = __attribute__((ext_vector_type(16))) float;
#define DI __device__ __forceinline__
#define MFMA(a, b, c) __builtin_amdgcn_mfma_f32_32x32x16_bf16((a), (b), (c), 0, 0, 0)

constexpr int T = 20480;
constexpr int NTHR = 256;
constexpr int LDS_MAIN = 71680;
constexpr int LDS_BYTES = LDS_MAIN + 16;
constexpr float ALPHA_F = 1.681792830507429f;

constexpr size_t MiB = 1u << 20;
constexpr size_t OFF_TABU = 0;
constexpr size_t OFF_TABV = OFF_TABU + 32 * MiB;
constexpr size_t OFF_BT_IN_E = OFF_TABV + 32 * MiB;
constexpr size_t OFF_BT_OUT_E = OFF_BT_IN_E + 10 * MiB;
constexpr size_t OFF_BT_IN_O = OFF_BT_OUT_E + 4 * MiB;
constexpr size_t OFF_BT_OUT_O = OFF_BT_IN_O + 12 * MiB;
constexpr size_t OFF_BT_WQ = OFF_BT_OUT_O + 4 * MiB;
constexpr size_t OFF_BT_W2 = OFF_BT_WQ + 16 * MiB;
constexpr size_t OFF_BT_A2 = OFF_BT_W2 + 256 * 1024;
constexpr size_t OFF_BT_G2 = OFF_BT_A2 + 256 * 1024;
constexpr size_t OFF_BT_GATE = OFF_BT_G2 + 256 * 1024;
constexpr size_t OFF_D256 = OFF_BT_GATE + 2 * MiB;
constexpr size_t OFF_MOD = OFF_D256 + 256 * 1024;
constexpr size_t OFF_D4096 = OFF_MOD + 512 * 1024;
constexpr size_t OFF_X = OFF_D4096 + 64 * MiB;
constexpr size_t OFF_Z = OFF_X + 80 * MiB;
constexpr size_t OFF_YMIX = OFF_Z + 115 * MiB;
constexpr size_t OFF_MIX = OFF_YMIX + 40 * MiB;
constexpr size_t OFF_H = OFF_MIX + 80 * MiB;
constexpr size_t OFF_XC = OFF_H + 40 * MiB;
constexpr size_t OFF_LRIN = OFF_XC + 40 * MiB;
constexpr size_t OFF_KKN = OFF_LRIN + 15 * MiB;
constexpr size_t OFF_KS = OFF_KKN + 40 * MiB;
constexpr size_t OFF_RS = OFF_KS + 20 * MiB;
constexpr size_t OFF_VS = OFF_RS + 20 * MiB;
constexpr size_t OFF_LB = OFF_VS + 20 * MiB;
constexpr size_t OFF_WD = OFF_LB + 40 * MiB;
constexpr size_t OFF_KKA = OFF_WD + 80 * MiB;
constexpr size_t OFF_KM = OFF_KKA + 40 * MiB;
constexpr size_t OFF_G = OFF_KM + 40 * MiB;
constexpr size_t OFF_BAR = OFF_G + 20 * MiB;
constexpr size_t WS_END = OFF_BAR + 16384;

struct Params {
  const float* in[40];
  float* out;
  unsigned char* ws;
};

enum {
  I_XP = 0, I_XS, I_SLRU, I_SWKV, I_C, I_CCTX, I_WMOD, I_BMOD, I_LN1G, I_LN1B, I_LN2G, I_LN2B, I_WINE, I_WOUTE, I_SCW, I_SCB,
  I_WINO, I_WOUTO, I_LCW, I_LCB, I_LWA, I_LBA, I_LWX, I_LBX, I_LLAM, I_MU, I_W0, I_W2, I_A0, I_A2, I_KK, I_KA, I_RK, I_G2, I_GNG,
  I_GNB, I_WQ, I_KEYS, I_PU, I_PV
};

DI int tidx() { int t = __builtin_amdgcn_workitem_id_x(); asm volatile("" : "+v"(t)); return t; }
DI unsigned f2bf(float x) { unsigned u = __float_as_uint(x); u += 0x7fffu + ((u >> 16) & 1u); return u >> 16; }
DI unsigned pack2(float a, float b) { return f2bf(a) | (f2bf(b) << 16); }
DI float bflo(unsigned u) { return __uint_as_float(u << 16); }
DI float bfhi(unsigned u) { return __uint_as_float(u & 0xffff0000u); }
DI float bf2f(bf16_t h) { return __uint_as_float(((unsigned)h) << 16); }
DI float sigm(float x) { return 1.f / (1.f + __expf(-x)); }
DI float gelu_t(float x) { float u = 0.7978845608028654f * (x + 0.044715f * x * x * x); return x * sigm(2.f * u); }
DI float tanh_f(float x) { return 2.f * sigm(2.f * x) - 1.f; }

template <int CTRL> DI float dpp_mov(float x) {
  return __int_as_float(__builtin_amdgcn_update_dpp(0, __float_as_int(x), CTRL, 0xF, 0xF, true));
}
DI float sum8(float x) { x += dpp_mov<0xB1>(x); x += dpp_mov<0x4E>(x); x += dpp_mov<0x141>(x); return x; }
DI float sum16(float x) { x = sum8(x); x += dpp_mov<0x140>(x); return x; }
DI float max16(float x) {
  x = fmaxf(x, dpp_mov<0xB1>(x)); x = fmaxf(x, dpp_mov<0x4E>(x)); x = fmaxf(x, dpp_mov<0x141>(x)); x = fmaxf(x, dpp_mov<0x140>(x));
  return x;
}
DI float rdlane(float x, int l) { return __int_as_float(__builtin_amdgcn_readlane(__float_as_int(x), l)); }
DI float wave_sum(float x) { x = sum16(x); return (rdlane(x, 0) + rdlane(x, 16)) + (rdlane(x, 32) + rdlane(x, 48)); }

DI void tok_info(int t, int& seq, int& s, int& S, int& cv) {
  if (t < 4096) { seq = t >> 8; s = t & 255; S = 256; cv = 0; }
  else { int u = t - 4096; seq = 16 + (u >> 12); s = u & 4095; S = 4096; cv = 1 + (u >> 12); }
}
DI size_t pqt_base(int seq) { return seq < 16 ? (size_t)seq * 512 * 512 : (size_t)16 * 512 * 512 + (size_t)(seq - 16) * 512 * 8192; }

DI void load_row(const float* p, int lane, float (&v)[16]) {
  const float4* q = (const float4*)(p + lane * 8);
  float4 a = q[0], b = q[1];
  const float4* q2 = (const float4*)(p + 512 + lane * 8);
  float4 c = q2[0], d = q2[1];
  v[0] = a.x; v[1] = a.y; v[2] = a.z; v[3] = a.w; v[4] = b.x; v[5] = b.y; v[6] = b.z; v[7] = b.w;
  v[8] = c.x; v[9] = c.y; v[10] = c.z; v[11] = c.w; v[12] = d.x; v[13] = d.y; v[14] = d.z; v[15] = d.w;
}
DI void store_row(float* p, int lane, const float (&v)[16]) {
  float4* q = (float4*)(p + lane * 8);
  q[0] = make_float4(v[0], v[1], v[2], v[3]); q[1] = make_float4(v[4], v[5], v[6], v[7]);
  float4* q2 = (float4*)(p + 512 + lane * 8);
  q2[0] = make_float4(v[8], v[9], v[10], v[11]); q2[1] = make_float4(v[12], v[13], v[14], v[15]);
}
DI void store_row_bf(bf16_t* p, int lane, const float (&v)[16]) {
  uint4 a, b;
  a.x = pack2(v[0], v[1]); a.y = pack2(v[2], v[3]); a.z = pack2(v[4], v[5]); a.w = pack2(v[6], v[7]);
  b.x = pack2(v[8], v[9]); b.y = pack2(v[10], v[11]); b.z = pack2(v[12], v[13]); b.w = pack2(v[14], v[15]);
  *(uint4*)(p + lane * 8) = a;
  *(uint4*)(p + 512 + lane * 8) = b;
}
DI void unpack8(uint4 u, float (&v)[8]) {
  v[0] = bflo(u.x); v[1] = bfhi(u.x); v[2] = bflo(u.y); v[3] = bfhi(u.y); v[4] = bflo(u.z); v[5] = bfhi(u.z); v[6] = bflo(u.w); v[7] = bfhi(u.w);
}
DI uint4 pack8(const float (&v)[8]) {
  uint4 a; a.x = pack2(v[0], v[1]); a.y = pack2(v[2], v[3]); a.z = pack2(v[4], v[5]); a.w = pack2(v[6], v[7]); return a;
}
DI void load8f(const float* p, float (&v)[8]) {
  float4 a = ((const float4*)p)[0], b = ((const float4*)p)[1];
  v[0] = a.x; v[1] = a.y; v[2] = a.z; v[3] = a.w; v[4] = b.x; v[5] = b.y; v[6] = b.z; v[7] = b.w;
}

DI void load_row16(const float* p, int lane, float (&v)[16]) {
  const float4* q = (const float4*)(p + lane * 16);
  float4 a = q[0], b = q[1], c = q[2], d = q[3];
  v[0] = a.x; v[1] = a.y; v[2] = a.z; v[3] = a.w; v[4] = b.x; v[5] = b.y; v[6] = b.z; v[7] = b.w;
  v[8] = c.x; v[9] = c.y; v[10] = c.z; v[11] = c.w; v[12] = d.x; v[13] = d.y; v[14] = d.z; v[15] = d.w;
}
DI void store_row16(float* p, int lane, const float (&v)[16]) {
  float4* q = (float4*)(p + lane * 16);
  q[0] = make_float4(v[0], v[1], v[2], v[3]); q[1] = make_float4(v[4], v[5], v[6], v[7]);
  q[2] = make_float4(v[8], v[9], v[10], v[11]); q[3] = make_float4(v[12], v[13], v[14], v[15]);
}
DI void store_row16_bf(bf16_t* p, int lane, const float (&v)[16]) {
  uint4 a, b;
  a.x = pack2(v[0], v[1]); a.y = pack2(v[2], v[3]); a.z = pack2(v[4], v[5]); a.w = pack2(v[6], v[7]);
  b.x = pack2(v[8], v[9]); b.y = pack2(v[10], v[11]); b.z = pack2(v[12], v[13]); b.w = pack2(v[14], v[15]);
  uint4* q = (uint4*)(p + lane * 16);
  q[0] = a; q[1] = b;
}
typedef float v2f_t __attribute__((ext_vector_type(2)));
DI unsigned pk_fp8x4(float a, float b, float c, float d) {
  int w = 0;
  w = __builtin_amdgcn_cvt_pk_fp8_f32(a, b, w, false);
  w = __builtin_amdgcn_cvt_pk_fp8_f32(c, d, w, true);
  return (unsigned)w;
}
DI void unpack_fp8x16(uint4 u, float (&v)[16]) {
  v2f_t t;
  t = __builtin_amdgcn_cvt_pk_f32_fp8((int)u.x, false); v[0] = t.x; v[1] = t.y;
  t = __builtin_amdgcn_cvt_pk_f32_fp8((int)u.x, true); v[2] = t.x; v[3] = t.y;
  t = __builtin_amdgcn_cvt_pk_f32_fp8((int)u.y, false); v[4] = t.x; v[5] = t.y;
  t = __builtin_amdgcn_cvt_pk_f32_fp8((int)u.y, true); v[6] = t.x; v[7] = t.y;
  t = __builtin_amdgcn_cvt_pk_f32_fp8((int)u.z, false); v[8] = t.x; v[9] = t.y;
  t = __builtin_amdgcn_cvt_pk_f32_fp8((int)u.z, true); v[10] = t.x; v[11] = t.y;
  t = __builtin_amdgcn_cvt_pk_f32_fp8((int)u.w, false); v[12] = t.x; v[13] = t.y;
  t = __builtin_amdgcn_cvt_pk_f32_fp8((int)u.w, true); v[14] = t.x; v[15] = t.y;
}
DI void ln16(float (&y)[16]) {
  float s = 0.f;
#pragma unroll
  for (int i = 0; i < 16; ++i) s += y[i];
  float mu = wave_sum(s) * (1.f / 1024.f);
  float v = 0.f;
#pragma unroll
  for (int i = 0; i < 16; ++i) { float d = y[i] - mu; v += d * d; }
  v = wave_sum(v) * (1.f / 1024.f);
  float rs = rsqrtf(v + 1e-6f);
#pragma unroll
  for (int i = 0; i < 16; ++i) y[i] = (y[i] - mu) * rs;
}

constexpr int LDT = 72;

template <bool SWAP>
DI void gemm_mainloop(const bf16_t* __restrict__ A, int lda, const bf16_t* __restrict__ B, int ldb, int K,
                      f32x16 (&acc)[2][2], bf16_t* As, bf16_t* Bs) {
  const int tid = tidx(), lane = tid & 63, wave = tid >> 6;
  const int wm = wave >> 1, wn = wave & 1;
  const int lrow = tid >> 3, lck = tid & 7;
  const bf16_t* ap = A + (size_t)lrow * lda + lck * 8;
  const bf16_t* bp = B + (size_t)lrow * ldb + lck * 8;
  const size_t sa = (size_t)32 * lda, sb = (size_t)32 * ldb;
  uint4 ra0, ra1, ra2, ra3, rb0, rb1, rb2, rb3;
  ra0 = *(const uint4*)(ap); ra1 = *(const uint4*)(ap + sa); ra2 = *(const uint4*)(ap + 2 * sa); ra3 = *(const uint4*)(ap + 3 * sa);
  rb0 = *(const uint4*)(bp); rb1 = *(const uint4*)(bp + sb); rb2 = *(const uint4*)(bp + 2 * sb); rb3 = *(const uint4*)(bp + 3 * sb);
#pragma unroll
  for (int mi = 0; mi < 2; ++mi)
#pragma unroll
    for (int ni = 0; ni < 2; ++ni)
#pragma unroll
      for (int r = 0; r < 16; ++r) acc[mi][ni][r] = 0.f;
  const int KT = K / 64;
  const int fr = (lane & 31) * LDT + (lane >> 5) * 8;
  bf16_t* asw = As + lrow * LDT + lck * 8;
  bf16_t* bsw = Bs + lrow * LDT + lck * 8;
  for (int kt = 0; kt < KT; ++kt) {
    __syncthreads();
    *(uint4*)(asw) = ra0; *(uint4*)(asw + 32 * LDT) = ra1; *(uint4*)(asw + 64 * LDT) = ra2; *(uint4*)(asw + 96 * LDT) = ra3;
    *(uint4*)(bsw) = rb0; *(uint4*)(bsw + 32 * LDT) = rb1; *(uint4*)(bsw + 64 * LDT) = rb2; *(uint4*)(bsw + 96 * LDT) = rb3;
    __syncthreads();
    if (kt + 1 < KT) {
      const bf16_t* a2 = ap + (kt + 1) * 64;
      const bf16_t* b2 = bp + (kt + 1) * 64;
      ra0 = *(const uint4*)(a2); ra1 = *(const uint4*)(a2 + sa); ra2 = *(const uint4*)(a2 + 2 * sa); ra3 = *(const uint4*)(a2 + 3 * sa);
      rb0 = *(const uint4*)(b2); rb1 = *(const uint4*)(b2 + sb); rb2 = *(const uint4*)(b2 + 2 * sb); rb3 = *(const uint4*)(b2 + 3 * sb);
    }
#pragma unroll
    for (int kk = 0; kk < 4; ++kk) {
      const bf16x8 af0 = *(const bf16x8*)(As + (wm * 64) * LDT + fr + kk * 16);
      const bf16x8 af1 = *(const bf16x8*)(As + (wm * 64 + 32) * LDT + fr + kk * 16);
      const bf16x8 bf0 = *(const bf16x8*)(Bs + (wn * 64) * LDT + fr + kk * 16);
      const bf16x8 bf1 = *(const bf16x8*)(Bs + (wn * 64 + 32) * LDT + fr + kk * 16);
      if (SWAP) {
        acc[0][0] = MFMA(bf0, af0, acc[0][0]); acc[0][1] = MFMA(bf1, af0, acc[0][1]);
        acc[1][0] = MFMA(bf0, af1, acc[1][0]); acc[1][1] = MFMA(bf1, af1, acc[1][1]);
      } else {
        acc[0][0] = MFMA(af0, bf0, acc[0][0]); acc[0][1] = MFMA(af0, bf1, acc[0][1]);
        acc[1][0] = MFMA(af1, bf0, acc[1][0]); acc[1][1] = MFMA(af1, bf1, acc[1][1]);
      }
    }
  }
}

template <bool SWAP, bool SB = true, class F>
DI void gemm_epilogue(const f32x16 (&acc)[2][2], F f) {
  const int lane = tidx() & 63, wave = tidx() >> 6;
  const int wm = wave >> 1, wn = wave & 1;
#pragma unroll
  for (int mi = 0; mi < 2; ++mi)
#pragma unroll
    for (int ni = 0; ni < 2; ++ni)
#pragma unroll
      for (int r = 0; r < 16; ++r) {
        const int i = (r & 3) + 8 * (r >> 2) + 4 * (lane >> 5);
        const int j = lane & 31;
        int m, n;
        if (!SWAP) { m = wm * 64 + mi * 32 + i; n = wn * 64 + ni * 32 + j; }
        else { n = wn * 64 + ni * 32 + i; m = wm * 64 + mi * 32 + j; }
        f(m, n, acc[mi][ni][r]);
        if (SB && (r & 3) == 3) __builtin_amdgcn_sched_barrier(0);
      }
}
template <class F>
DI void gemm_epilogue2(const f32x16 (&a0)[2][2], const f32x16 (&a1)[2][2], F f) {
  const int lane = tidx() & 63, wave = tidx() >> 6;
  const int wm = wave >> 1, wn = wave & 1;
#pragma unroll
  for (int mi = 0; mi < 2; ++mi)
#pragma unroll
    for (int ni = 0; ni < 2; ++ni)
#pragma unroll
      for (int r = 0; r < 16; ++r) {
        const int i = (r & 3) + 8 * (r >> 2) + 4 * (lane >> 5);
        const int j = lane & 31;
        f(wm * 64 + mi * 32 + i, wn * 64 + ni * 32 + j, a0[mi][ni][r], a1[mi][ni][r]);
      }
}

DI int tr_tiles(int job) {
  if (job < 2) return 384; if (job < 4) return 256; if (job < 6) return 736; if (job < 8) return 256;
  if (job < 12) return 512; if (job < 20) return 8; return 16;
}
DI void phase_prep(const Params& p, unsigned char* smem, int bid, int nb) {
  const int tid = tidx();
  constexpr int N_MOD = 384, N_TR = 768 + 512 + 1472 + 512 + 2048 + 32 + 32 + 32, N_FOLD = 256, N_GATE = 512, N_DFT = 16384 + 64;
  constexpr int TOTAL = N_MOD + N_TR + N_FOLD + N_GATE + N_DFT;
  unsigned char* ws = p.ws;
  for (int it = bid; it < TOTAL; it += nb) {
    if (it < N_MOD) {
      const int l = it / 96, cchunk = it % 96;
      float* sil = (float*)smem;
      float* red = sil + 5 * 1024;
      __syncthreads();
      for (int i = tid; i < 5120; i += NTHR) {
        int cv = i >> 10, k = i & 1023;
        float c = (cv == 0) ? p.in[I_CCTX][k] : p.in[I_C][(cv - 1) * 1024 + k];
        sil[i] = c * sigm(c);
      }
      __syncthreads();
      const int col = cchunk * 64 + (tid & 63), kg = tid >> 6;
      const float* w = p.in[I_WMOD] + (size_t)l * 1024 * 6144 + col;
      float a0 = 0.f, a1 = 0.f, a2 = 0.f, a3 = 0.f, a4 = 0.f;
#pragma unroll 8
      for (int k = kg * 256; k < kg * 256 + 256; ++k) {
        float wv = w[(size_t)k * 6144];
        a0 += sil[k] * wv; a1 += sil[1024 + k] * wv; a2 += sil[2048 + k] * wv; a3 += sil[3072 + k] * wv; a4 += sil[4096 + k] * wv;
      }
      const int c = tid & 63;
      red[(kg * 5 + 0) * 64 + c] = a0; red[(kg * 5 + 1) * 64 + c] = a1; red[(kg * 5 + 2) * 64 + c] = a2;
      red[(kg * 5 + 3) * 64 + c] = a3; red[(kg * 5 + 4) * 64 + c] = a4;
      __syncthreads();
      for (int i = tid; i < 320; i += NTHR) {
        int cv = i >> 6, cc = i & 63;
        float s = red[(0 * 5 + cv) * 64 + cc] + red[(1 * 5 + cv) * 64 + cc] + red[(2 * 5 + cv) * 64 + cc] + red[(3 * 5 + cv) * 64 + cc];
        s += p.in[I_BMOD][l * 6144 + cchunk * 64 + cc];
        ((float*)(ws + OFF_MOD))[(l * 5 + cv) * 6144 + cchunk * 64 + cc] = s;
      }
    } else if (it < N_MOD + N_TR) {
      int r = it - N_MOD, job = 0;
      for (job = 0; job < 22; ++job) { int nt = tr_tiles(job); if (r < nt) break; r -= nt; }
      const float* src; bf16_t* dst; int lds, ldd, N;
      if (job < 2) { src = p.in[I_WINE] + (size_t)job * 1024 * 2048 + 512; lds = 2048; N = 1536; dst = (bf16_t*)(ws + OFF_BT_IN_E) + (size_t)job * 2560 * 1024 + (size_t)1024 * 1024; ldd = 1024; }
      else if (job < 4) { int j = job - 2; src = p.in[I_WOUTE] + (size_t)j * 1024 * 1024; lds = 1024; N = 1024; dst = (bf16_t*)(ws + OFF_BT_OUT_E) + (size_t)j * 1024 * 1024; ldd = 1024; }
      else if (job < 6) { int j = job - 4; src = p.in[I_WINO] + (size_t)j * 1024 * 2944; lds = 2944; N = 2944; dst = (bf16_t*)(ws + OFF_BT_IN_O) + (size_t)j * 2944 * 1024; ldd = 1024; }
      else if (job < 8) { int j = job - 6; src = p.in[I_WOUTO] + (size_t)j * 1024 * 1024; lds = 1024; N = 1024; dst = (bf16_t*)(ws + OFF_BT_OUT_O) + (size_t)j * 1024 * 1024; ldd = 1024; }
      else if (job < 12) { int j = job - 8; src = p.in[I_WQ] + (size_t)j * 1024 * 2048; lds = 2048; N = 2048; dst = (bf16_t*)(ws + OFF_BT_WQ) + (size_t)j * 2048 * 1024; ldd = 1024; }
      else if (job < 16) { int j = job - 12; src = p.in[I_W2] + (size_t)j * 64 * 512; lds = 512; N = 512; dst = (bf16_t*)(ws + OFF_BT_W2) + (size_t)j * 512 * 64; ldd = 64; }
      else if (job < 20) { int j = job - 16; src = p.in[I_A2] + (size_t)j * 64 * 512; lds = 512; N = 512; dst = (bf16_t*)(ws + OFF_BT_A2) + (size_t)j * 512 * 64; ldd = 64; }
      else { int j = job - 20; src = p.in[I_G2] + (size_t)j * 128 * 512; lds = 512; N = 512; dst = (bf16_t*)(ws + OFF_BT_G2) + (size_t)j * 512 * 128; ldd = 128; }
      const int ntn = N / 64;
      const int k0 = (r / ntn) * 64, n0 = (r % ntn) * 64;
      float* tl = (float*)smem;
      __syncthreads();
#pragma unroll 4
      for (int ps = 0; ps < 16; ++ps) {
        int kr = ps * 4 + (tid >> 6), n = tid & 63;
        tl[kr * 65 + n] = src[(size_t)(k0 + kr) * lds + n0 + n];
      }
      __syncthreads();
#pragma unroll 4
      for (int ps = 0; ps < 8; ++ps) {
        int nr = ps * 8 + (tid >> 5), k2 = tid & 31;
        unsigned v = pack2(tl[(2 * k2) * 65 + nr], tl[(2 * k2 + 1) * 65 + nr]);
        *(unsigned*)(dst + (size_t)(n0 + nr) * ldd + k0 + 2 * k2) = v;
      }
    } else if (it < N_MOD + N_TR + N_FOLD) {
      int r = it - N_MOD - N_TR;
      const int j = r >> 7, rr = r & 127, which = rr >> 6, g = (rr >> 4) & 3, kt = rr & 15;
      const int k0 = kt * 64;
      float* Wl = (float*)smem;
      float* tab = Wl + 64 * 129;
      __syncthreads();
      if (tid < 128) { float fr = (float)tid * (1.f / 128.f); tab[tid] = which ? __builtin_amdgcn_sinf(fr) : __builtin_amdgcn_cosf(fr); }
      for (int ps = 0; ps < 32; ++ps) {
        int kr = ps * 2 + (tid >> 7), c = tid & 127;
        Wl[kr * 129 + c] = p.in[I_WINE][(size_t)j * 1024 * 2048 + (size_t)(k0 + kr) * 2048 + g * 128 + c];
      }
      __syncthreads();
      const int k = tid & 63, nq = tid >> 6;
      bf16_t* dst = (bf16_t*)(ws + OFF_BT_IN_E) + (size_t)j * 2560 * 1024;
      for (int i = 0; i < 32; ++i) {
        const int np = nq * 32 + i;
        float s = 0.f;
#pragma unroll 8
        for (int c = 0; c < 128; ++c) s += Wl[k * 129 + c] * tab[(c * np) & 127];
        dst[(size_t)(which * 512 + g * 128 + np) * 1024 + k0 + k] = (bf16_t)f2bf(s);
      }
    } else if (it < N_MOD + N_TR + N_FOLD + N_GATE) {
      int r = it - N_MOD - N_TR - N_FOLD;
      bf16_t* dst = (bf16_t*)(ws + OFF_BT_GATE);
      for (int e = 0; e < 4; ++e) {
        int idx = r * 1024 + e * 256 + tid;
        int kp = idx & 127, n = (idx >> 7) & 511, gate = (idx >> 16) & 1, d = (idx >> 17) & 1, j = idx >> 18;
        int h = n >> 6;
        float v = 0.f;
        if ((kp >> 6) == (h & 1)) {
          const float* W = gate ? p.in[I_LWX] : p.in[I_LWA];
          v = W[((((size_t)(j * 2 + d) * 8 + h) * 64 + (kp & 63)) * 64) + (n & 63)];
        }
        dst[idx] = (bf16_t)f2bf(v);
      }
    } else {
      int r = it - N_MOD - N_TR - N_FOLD - N_GATE;
      int S, K2; bf16_t* dst; size_t idx;
      if (r < 16384) { S = 4096; K2 = 8192; dst = (bf16_t*)(ws + OFF_D4096); idx = (size_t)r * 2048 + tid * 8; }
      else { S = 256; K2 = 512; dst = (bf16_t*)(ws + OFF_D256); idx = (size_t)(r - 16384) * 2048 + tid * 8; }
      const int row = (int)(idx / K2), kb = (int)(idx % K2);
      const float invS = 1.f / (float)S;
      float v[8];
#pragma unroll
      for (int e = 0; e < 8; ++e) {
        int k = kb + e;
        if (k < S) { int m = (row * k) & (S - 1); v[e] = __builtin_amdgcn_cosf((float)m * invS); }
        else { int m = (row * (k - S)) & (S - 1); v[e] = -__builtin_amdgcn_sinf((float)m * invS); }
      }
      *(uint4*)(dst + idx) = pack8(v);
    }
  }
}

DI void mod_store_h(const Params& p, int t, int lane, int cv, int l, int off_scale, int off_shift, float (&y)[16]) {
  const float* mod = (const float*)(p.ws + OFF_MOD) + (size_t)(l * 5 + cv) * 6144;
  float sc[16], sh[16];
  load_row(mod + off_scale * 1024, lane, sc);
  load_row(mod + off_shift * 1024, lane, sh);
#pragma unroll
  for (int i = 0; i < 16; ++i) y[i] = y[i] * (1.f + sc[i]) + sh[i];
  store_row_bf((bf16_t*)(p.ws + OFF_H) + (size_t)t * 1024, lane, y);
}

DI float pos_embed(int n, int c) {
  int pos = (c < 512) ? (n >> 6) : (n & 63);
  int cc = c & 511, i = cc & 255;
  float om = exp2f(-(float)i * (13.287712379549449f / 256.f));
  float rev = (float)pos * om * 0.15915494309189535f;
  return cc < 256 ? __builtin_amdgcn_sinf(rev) : __builtin_amdgcn_cosf(rev);
}

DI void phase_init(const Params& p, int bid, int nb) {
  const int lane = tidx() & 63, wave = tidx() >> 6;
  float sc[16], sh[16];
  int cvl = -1;
  for (int t = bid * 4 + wave; t < T; t += nb * 4) {
    int seq, s, S, cv; tok_info(t, seq, s, S, cv);
    if (cv != cvl) {
      const float* mod = (const float*)(p.ws + OFF_MOD) + (size_t)cv * 6144;
      load_row(mod + 1024, lane, sc); load_row(mod, lane, sh);
      cvl = cv;
    }
    float y[16];
    const float* src = (t < 4096) ? p.in[I_XP] + (size_t)t * 1024 : p.in[I_XS] + (size_t)(t - 4096) * 1024;
    load_row(src, lane, y);
    if (t >= 4096) {
#pragma unroll
      for (int i = 0; i < 16; ++i) { int c = (i < 8) ? lane * 8 + i : 512 + lane * 8 + (i - 8); y[i] += pos_embed(s, c); }
    }
    store_row((float*)(p.ws + OFF_X) + (size_t)t * 1024, lane, y);
    ln16(y);
#pragma unroll
    for (int i = 0; i < 16; ++i) y[i] = y[i] * (1.f + sc[i]) + sh[i];
    store_row_bf((bf16_t*)(p.ws + OFF_H) + (size_t)t * 1024, lane, y);
  }
}

constexpr float U_SCALE = 32.f;
DI void convert_tables(const Params& p, int l, int bid, int nb) {
  const size_t n16 = (size_t)16384 * 1024 / 16;
  for (int tb = 0; tb < 2; ++tb) {
    const float* src = p.in[tb ? I_PV : I_PU] + (size_t)l * 16384 * 1024;
    uint4* dst = (uint4*)(p.ws + (tb ? OFF_TABV : OFF_TABU));
    const float sc = tb ? 1.f : U_SCALE;
    for (size_t i = (size_t)bid * NTHR + tidx(); i < n16; i += (size_t)nb * NTHR) {
      const float4* s4 = (const float4*)(src + i * 16);
      float4 a = s4[0], b = s4[1], c = s4[2], d = s4[3];
      uint4 o;
      o.x = pk_fp8x4(a.x * sc, a.y * sc, a.z * sc, a.w * sc); o.y = pk_fp8x4(b.x * sc, b.y * sc, b.z * sc, b.w * sc);
      o.z = pk_fp8x4(c.x * sc, c.y * sc, c.z * sc, c.w * sc); o.w = pk_fp8x4(d.x * sc, d.y * sc, d.z * sc, d.w * sc);
      dst[i] = o;
    }
  }
}

DI void phase_e1(const Params& p, unsigned char* smem, int l, int bid, int nb) {
  const int j = l >> 1;
  bf16_t* As = (bf16_t*)smem; bf16_t* Bs = As + 128 * LDT;
  const bf16_t* H = (const bf16_t*)(p.ws + OFF_H);
  const bf16_t* Bt = (const bf16_t*)(p.ws + OFF_BT_IN_E) + (size_t)j * 2560 * 1024;
  bf16_t* PQT = (bf16_t*)(p.ws + OFF_Z);
  bf16_t* ZC = (bf16_t*)(p.ws + OFF_Z + 40 * MiB);
  for (int it = bid; it < 160 * 20; it += nb) {
    const int mt = it / 20, nt = it % 20, t0 = mt * 128;
    f32x16 acc[2][2];
    if (nt < 8) {
      gemm_mainloop<true>(H + (size_t)t0 * 1024, 1024, Bt + (size_t)nt * 128 * 1024, 1024, 1024, acc, As, Bs);
      int seq, s0, S, cv; tok_info(t0, seq, s0, S, cv);
      bf16_t* base = PQT + pqt_base(seq);
      const int S2 = 2 * S;
      gemm_epilogue<true>(acc, [&](int m, int n, float v) {
        int ng = nt * 128 + n; int which = ng >> 9, ch = ng & 511;
        base[(size_t)ch * S2 + which * S + s0 + m] = (bf16_t)f2bf(v);
      });
    } else {
      gemm_mainloop<false>(H + (size_t)t0 * 1024, 1024, Bt + (size_t)nt * 128 * 1024, 1024, 1024, acc, As, Bs);
      gemm_epilogue<false>(acc, [&](int m, int n, float v) {
        ZC[(size_t)(t0 + m) * 1536 + (nt - 8) * 128 + n] = (bf16_t)f2bf(v);
      });
    }
  }
  convert_tables(p, l, bid, nb);
}

DI void phase_e2(const Params& p, unsigned char* smem, int l, int bid, int nb) {
  const int j = l >> 1;
  bf16_t* As = (bf16_t*)smem; bf16_t* Bs = As + 128 * LDT;
  const bf16_t* PQT = (const bf16_t*)(p.ws + OFF_Z);
  const bf16_t* ZC = (const bf16_t*)(p.ws + OFF_Z + 40 * MiB);
  bf16_t* YM = (bf16_t*)(p.ws + OFF_YMIX);
  for (int it = bid; it < 640 + 1280; it += nb) {
    if (it < 640) {
      int seq, mt, nt, S, t0; const bf16_t* A;
      if (it < 512) { seq = 16 + it / 128; int r = it % 128; mt = r >> 2; nt = r & 3; S = 4096; A = (const bf16_t*)(p.ws + OFF_D4096) + (size_t)mt * 128 * 8192; t0 = 4096 + (seq - 16) * 4096 + mt * 128; }
      else { int r = it - 512; seq = r >> 3; mt = (r & 7) >> 2; nt = r & 3; S = 256; A = (const bf16_t*)(p.ws + OFF_D256) + (size_t)mt * 128 * 512; t0 = seq * 256 + mt * 128; }
      const bf16_t* B = PQT + pqt_base(seq) + (size_t)nt * 128 * (2 * S);
      f32x16 acc[2][2];
      gemm_mainloop<false>(A, 2 * S, B, 2 * S, 2 * S, acc, As, Bs);
      const float scale = rsqrtf(128.f * (float)S);
      gemm_epilogue<false>(acc, [&](int m, int n, float v) {
        YM[(size_t)(t0 + m) * 1024 + nt * 128 + n] = (bf16_t)f2bf(v * scale);
      });
    } else {
      const int t0 = (it - 640) * 16, c = tidx() * 2;
      int seq, s0, S, cv; tok_info(t0, seq, s0, S, cv);
      const float* cw = p.in[I_SCW] + (size_t)j * 3 * 512;
      const float w0a = cw[c], w0b = cw[c + 1], w1a = cw[512 + c], w1b = cw[512 + c + 1], w2a = cw[1024 + c], w2b = cw[1024 + c + 1];
      const float ba = p.in[I_SCB][j * 512 + c], bb = p.in[I_SCB][j * 512 + c + 1];
      auto uval = [&](int t, float& ua, float& ub) {
        unsigned cg_ = *(const unsigned*)(ZC + (size_t)t * 1536 + 512 + c);
        unsigned xi = *(const unsigned*)(ZC + (size_t)t * 1536 + 1024 + c);
        ua = bflo(cg_) * bflo(xi); ub = bfhi(cg_) * bfhi(xi);
      };
      float pa = 0.f, pb = 0.f, ca, cb, na, nb_;
      if (s0 > 0) uval(t0 - 1, pa, pb);
      uval(t0, ca, cb);
      for (int i = 0; i < 16; ++i) {
        const int t = t0 + i;
        na = 0.f; nb_ = 0.f;
        if (s0 + i + 1 < S) uval(t + 1, na, nb_);
        unsigned bg = *(const unsigned*)(ZC + (size_t)t * 1536 + c);
        float ya = bflo(bg) * (w0a * pa + w1a * ca + w2a * na + ba);
        float yb = bfhi(bg) * (w0b * pb + w1b * cb + w2b * nb_ + bb);
        *(unsigned*)(YM + (size_t)t * 1024 + 512 + c) = pack2(ya, yb);
        pa = ca; pb = cb; ca = na; cb = nb_;
      }
    }
  }
}

DI void phase_outgemm(const Params& p, unsigned char* smem, const bf16_t* Bt, int bid, int nb) {
  bf16_t* As = (bf16_t*)smem; bf16_t* Bs = As + 128 * LDT;
  const bf16_t* YM = (const bf16_t*)(p.ws + OFF_YMIX);
  float* MIX = (float*)(p.ws + OFF_MIX);
  for (int it = bid; it < 160 * 8; it += nb) {
    const int mt = it >> 3, nt = it & 7, t0 = mt * 128;
    f32x16 acc[2][2];
    gemm_mainloop<false>(YM + (size_t)t0 * 1024, 1024, Bt + (size_t)nt * 128 * 1024, 1024, 1024, acc, As, Bs);
    gemm_epilogue<false>(acc, [&](int m, int n, float v) { MIX[(size_t)(t0 + m) * 1024 + nt * 128 + n] = v; });
  }
}

DI void phase_res1(const Params& p, int l, int bid, int nb) {
  const int lane = tidx() & 63, wave = tidx() >> 6;
  float* X = (float*)(p.ws + OFF_X);
  const float* MIX = (const float*)(p.ws + OFF_MIX);
  float lg[16], lb[16], g1[16], sc[16], sh[16];
  load_row(p.in[I_LN1G] + l * 1024, lane, lg);
  load_row(p.in[I_LN1B] + l * 1024, lane, lb);
  int cvl = -1;
  for (int t = bid * 4 + wave; t < T; t += nb * 4) {
    int seq, s, S, cv; tok_info(t, seq, s, S, cv);
    if (cv != cvl) {
      const float* mod = (const float*)(p.ws + OFF_MOD) + (size_t)(l * 5 + cv) * 6144;
      load_row(mod + 2 * 1024, lane, g1); load_row(mod + 4 * 1024, lane, sc); load_row(mod + 3 * 1024, lane, sh);
      cvl = cv;
    }
    float x[16], m[16];
    load_row(X + (size_t)t * 1024, lane, x);
    load_row(MIX + (size_t)t * 1024, lane, m);
#pragma unroll
    for (int i = 0; i < 16; ++i) x[i] = ALPHA_F * x[i] + g1[i] * m[i];
    ln16(x);
#pragma unroll
    for (int i = 0; i < 16; ++i) x[i] = x[i] * lg[i] + lb[i];
    store_row(X + (size_t)t * 1024, lane, x);
    ln16(x);
#pragma unroll
    for (int i = 0; i < 16; ++i) x[i] = x[i] * (1.f + sc[i]) + sh[i];
    store_row_bf((bf16_t*)(p.ws + OFF_H) + (size_t)t * 1024, lane, x);
  }
}

DI void insert16(float (&tv)[16], int (&ti)[16], float x, int xi) {
#pragma unroll
  for (int k = 0; k < 16; ++k) {
    bool gt = x > tv[k];
    float ov = tv[k]; int oi = ti[k];
    tv[k] = gt ? x : ov; ti[k] = gt ? xi : oi;
    x = gt ? ov : x; xi = gt ? oi : xi;
  }
}
DI void phase_p1(const Params& p, unsigned char* smem, int l, int bid, int nb) {
  const int tid = tidx(), lane = tid & 63, wave = tid >> 6;
  const int wm = wave >> 1, wn = wave & 1;
  bf16_t* As = (bf16_t*)smem; bf16_t* Bs = As + 128 * LDT;
  bf16_t* Qs = (bf16_t*)smem;
  bf16_t* Ks = (bf16_t*)(smem + 36864);
  float* Sc = (float*)smem;
  float* Lv = (float*)smem;
  int* Li = (int*)(smem + 8192);
  const bf16_t* H = (const bf16_t*)(p.ws + OFF_H);
  const bf16_t* Bt = (const bf16_t*)(p.ws + OFF_BT_WQ) + (size_t)l * 2048 * 1024;
  float* TKV = (float*)(p.ws + OFF_WD);
  int* TKI = (int*)(p.ws + OFF_WD + 20 * MiB);
  for (int it = bid; it < 160 * 16; it += nb) {
    const int mt = it >> 4, hp = it & 15, t0 = mt * 128;
    f32x16 acc[2][2];
    gemm_mainloop<false>(H + (size_t)t0 * 1024, 1024, Bt + (size_t)hp * 128 * 1024, 1024, 1024, acc, As, Bs);
    {
      const float* kp = p.in[I_KEYS] + (size_t)(l * 16 + hp) * 16384;
#pragma unroll 4
      for (int i = 0; i < 16; ++i) {
        int idx = i * 256 + tid;
        int row = idx >> 5, c4 = idx & 31;
        float4 v = *(const float4*)(kp + row * 128 + c4 * 4);
        uint2 u; u.x = pack2(v.x, v.y); u.y = pack2(v.z, v.w);
        *(uint2*)(Ks + row * 136 + c4 * 4) = u;
      }
    }
    __syncthreads();
    gemm_epilogue<false>(acc, [&](int m, int n, float v) { Qs[m * 136 + n] = (bf16_t)f2bf(v); });
    __syncthreads();
#pragma unroll
    for (int mi = 0; mi < 2; ++mi)
#pragma unroll
      for (int ni = 0; ni < 2; ++ni)
#pragma unroll
        for (int r = 0; r < 16; ++r) acc[mi][ni][r] = 0.f;
    {
      const int fr = (lane & 31) * 136 + (lane >> 5) * 8;
#pragma unroll
      for (int kk = 0; kk < 8; ++kk) {
        bf16x8 af[2], bfr[2];
#pragma unroll
        for (int mi = 0; mi < 2; ++mi) af[mi] = *(const bf16x8*)(Qs + (wm * 64 + mi * 32) * 136 + fr + kk * 16);
#pragma unroll
        for (int ni = 0; ni < 2; ++ni) bfr[ni] = *(const bf16x8*)(Ks + (wn * 64 + ni * 32) * 136 + fr + kk * 16);
#pragma unroll
        for (int mi = 0; mi < 2; ++mi)
#pragma unroll
          for (int ni = 0; ni < 2; ++ni) acc[mi][ni] = MFMA(af[mi], bfr[ni], acc[mi][ni]);
      }
    }
    __syncthreads();
    gemm_epilogue<false>(acc, [&](int m, int n, float v) { Sc[m * 129 + n] = v; });
    __syncthreads();
    const int row = tid & 127, half = tid >> 7;
    float tv[16];
#pragma unroll
    for (int k = 0; k < 16; ++k) tv[k] = -3.0e38f;
    for (int e = 0; e < 64; ++e) {
      float x = __uint_as_float((__float_as_uint(Sc[row * 129 + half * 64 + e]) & ~127u) | (unsigned)(half * 64 + e));
#pragma unroll
      for (int k = 0; k < 16; ++k) { float hi = fmaxf(tv[k], x); x = fminf(tv[k], x); tv[k] = hi; }
    }
    __syncthreads();
    if (half == 1) {
#pragma unroll
      for (int k = 0; k < 16; ++k) Lv[k * 128 + row] = tv[k];
    }
    __syncthreads();
    if (half == 0) {
#pragma unroll
      for (int k2 = 0; k2 < 16; ++k2) {
        float x = Lv[k2 * 128 + row];
#pragma unroll
        for (int k = 0; k < 16; ++k) { float hi = fmaxf(tv[k], x); x = fminf(tv[k], x); tv[k] = hi; }
      }
      float* ov = TKV + ((size_t)(t0 + row) * 16 + hp) * 16;
      int* oi = TKI + ((size_t)(t0 + row) * 16 + hp) * 16;
#pragma unroll
      for (int k = 0; k < 16; k += 4) {
        *(float4*)(ov + k) = make_float4(__uint_as_float(__float_as_uint(tv[k]) & ~127u), __uint_as_float(__float_as_uint(tv[k + 1]) & ~127u),
                                         __uint_as_float(__float_as_uint(tv[k + 2]) & ~127u), __uint_as_float(__float_as_uint(tv[k + 3]) & ~127u));
        *(int4*)(oi + k) = make_int4((int)(__float_as_uint(tv[k]) & 127u), (int)(__float_as_uint(tv[k + 1]) & 127u),
                                     (int)(__float_as_uint(tv[k + 2]) & 127u), (int)(__float_as_uint(tv[k + 3]) & 127u));
      }
    }
  }
}

DI void phase_p2(const Params& p, unsigned char* smem, int l, int bid, int nb) {
  const int lane = tidx() & 63, wave = tidx() >> 6;
  int* sIdx = (int*)(smem + wave * 1024);
  float* sSc = (float*)(smem + wave * 1024 + 512);
  const bf16_t* H = (const bf16_t*)(p.ws + OFF_H);
  const float* TKV = (const float*)(p.ws + OFF_WD);
  const int* TKI = (const int*)(p.ws + OFF_WD + 20 * MiB);
  const bf16_t* TU = (const bf16_t*)(p.ws + OFF_TABU);
  const bf16_t* TV = (const bf16_t*)(p.ws + OFF_TABV);
  float* X = (float*)(p.ws + OFF_X);
  int ci = 0, cj = 0;
  {
    int q = lane;
    if (q < 16) { ci = 0; cj = q; } else if (q < 24) { ci = 1; cj = q - 16; } else if (q < 29) { ci = 2; cj = q - 24; }
    else if (q < 33) { ci = 3; cj = q - 29; } else if (q < 36) { ci = 4; cj = q - 33; }
    else if (q < 42) { ci = 5 + ((q - 36) >> 1); cj = (q - 36) & 1; } else if (q < 50) { ci = 8 + (q - 42); cj = 0; }
  }
  float plg[16], plb[16], pg2[16];
  load_row16(p.in[I_LN2G] + l * 1024, lane, plg);
  load_row16(p.in[I_LN2B] + l * 1024, lane, plb);
  int cvl = -1;
  for (int t = bid * 4 + wave; t < T; t += nb * 4) {
    int seq, s, S, cv; tok_info(t, seq, s, S, cv);
    float hreg[16];
    {
      const uint4* hp_ = (const uint4*)(H + (size_t)t * 1024 + lane * 16);
      uint4 a = hp_[0], b = hp_[1];
      float v0[8], v1[8]; unpack8(a, v0); unpack8(b, v1);
#pragma unroll
      for (int i = 0; i < 8; ++i) { hreg[i] = v0[i]; hreg[8 + i] = v1[i]; }
    }
    __builtin_amdgcn_wave_barrier();
    for (int h = 0; h < 8; ++h) {
      const float* v1p = TKV + ((size_t)t * 16 + h * 2) * 16;
      const int* i1p = TKI + ((size_t)t * 16 + h * 2) * 16;
      float c = -3.0e38f; int eidx = 0;
      if (lane < 50) { c = v1p[ci] + v1p[16 + cj]; eidx = i1p[ci] * 128 + i1p[16 + cj]; }
      c = __uint_as_float((__float_as_uint(c) & ~63u) | (unsigned)lane);
      int rank = 0;
#pragma unroll 10
      for (int m = 0; m < 50; ++m) {
        float cm = __int_as_float(__builtin_amdgcn_readlane(__float_as_int(c), m));
        rank += (cm > c) ? 1 : 0;
      }
      if (lane < 50 && rank < 16) { sIdx[h * 16 + rank] = eidx; sSc[h * 16 + rank] = c; }
    }
    __builtin_amdgcn_wave_barrier();
    {
      float s0 = sSc[lane], s1 = sSc[64 + lane];
      float m0 = max16(s0), m1 = max16(s1);
      float e0 = __expf(s0 - m0), e1 = __expf(s1 - m1);
      float d0 = sum16(e0), d1 = sum16(e1);
      __builtin_amdgcn_wave_barrier();
      sSc[lane] = e0 / d0; sSc[64 + lane] = e1 / d1;
    }
    __builtin_amdgcn_wave_barrier();
    float out[16];
#pragma unroll
    for (int i = 0; i < 16; ++i) out[i] = 0.f;
    const unsigned char* TU8 = (const unsigned char*)TU;
    const unsigned char* TV8 = (const unsigned char*)TV;
    for (int sb = 0; sb < 128; sb += 8) {
      uint4 u[8], w[8]; float gt[8];
#pragma unroll
      for (int k = 0; k < 8; ++k) {
        int e = __builtin_amdgcn_readfirstlane(sIdx[sb + k]);
        gt[k] = sSc[sb + k];
        u[k] = *(const uint4*)(TU8 + (size_t)e * 1024 + lane * 16);
        w[k] = *(const uint4*)(TV8 + (size_t)e * 1024 + lane * 16);
      }
      float dot[8];
#pragma unroll
      for (int k = 0; k < 8; ++k) {
        float a[16]; unpack_fp8x16(u[k], a);
        float d = 0.f;
#pragma unroll
        for (int i = 0; i < 16; ++i) d += hreg[i] * a[i];
        dot[k] = d;
      }
#pragma unroll
      for (int k = 0; k < 8; ++k) dot[k] = wave_sum(dot[k]);
#pragma unroll
      for (int k = 0; k < 8; ++k) {
        float wgt = gt[k] * gelu_t(dot[k] * (1.f / U_SCALE));
        float a[16]; unpack_fp8x16(w[k], a);
#pragma unroll
        for (int i = 0; i < 16; ++i) out[i] += wgt * a[i];
      }
    }
    if (cv != cvl) {
      const float* mod = (const float*)(p.ws + OFF_MOD) + (size_t)(l * 5 + cv) * 6144;
      load_row16(mod + 5 * 1024, lane, pg2);
      cvl = cv;
    }
    float x[16];
    load_row16(X + (size_t)t * 1024, lane, x);
#pragma unroll
    for (int i = 0; i < 16; ++i) x[i] = ALPHA_F * x[i] + pg2[i] * out[i];
    ln16(x);
#pragma unroll
    for (int i = 0; i < 16; ++i) x[i] = x[i] * plg[i] + plb[i];
    if (l == 3) {
      store_row16(p.out + (size_t)t * 1024, lane, x);
    } else {
      store_row16(X + (size_t)t * 1024, lane, x);
      ln16(x);
      {
        float psc[16], psh[16];
        const float* modn = (const float*)(p.ws + OFF_MOD) + (size_t)((l + 1) * 5 + cv) * 6144;
        load_row16(modn + 1024, lane, psc); load_row16(modn, lane, psh);
#pragma unroll
        for (int i = 0; i < 16; ++i) x[i] = x[i] * (1.f + psc[i]) + psh[i];
      }
      store_row16_bf((bf16_t*)(p.ws + OFF_H) + (size_t)t * 1024, lane, x);
    }
  }
}

DI void phase_o1(const Params& p, unsigned char* smem, int l, int bid, int nb) {
  const int j = l >> 1;
  bf16_t* As = (bf16_t*)smem; bf16_t* Bs = As + 128 * LDT;
  const bf16_t* H = (const bf16_t*)(p.ws + OFF_H);
  const bf16_t* Bt = (const bf16_t*)(p.ws + OFF_BT_IN_O) + (size_t)j * 2944 * 1024;
  bf16_t* Z = (bf16_t*)(p.ws + OFF_Z);
  for (int it = bid; it < 160 * 23; it += nb) {
    const int mt = it / 23, nt = it % 23, t0 = mt * 128;
    f32x16 acc[2][2];
    gemm_mainloop<false>(H + (size_t)t0 * 1024, 1024, Bt + (size_t)nt * 128 * 1024, 1024, 1024, acc, As, Bs);
    gemm_epilogue<false>(acc, [&](int m, int n, float v) { Z[(size_t)(t0 + m) * 2944 + nt * 128 + n] = (bf16_t)f2bf(v); });
  }
  convert_tables(p, l, bid, nb);
}

DI void phase_o2(const Params& p, int l, int bid, int nb) {
  const int j = l >> 1;
  const int lane = tidx() & 63, wave = tidx() >> 6;
  const bf16_t* Z = (const bf16_t*)(p.ws + OFF_Z);
  bf16_t* XC = (bf16_t*)(p.ws + OFF_XC);
  bf16_t* LRIN = (bf16_t*)(p.ws + OFF_LRIN);
  bf16_t* KKN = (bf16_t*)(p.ws + OFF_KKN);
  bf16_t* KS = (bf16_t*)(p.ws + OFF_KS);
  bf16_t* RS = (bf16_t*)(p.ws + OFF_RS);
  bf16_t* VS = (bf16_t*)(p.ws + OFF_VS);
  const float* mu = p.in[I_MU] + (size_t)j * 1920;
  const int c0 = lane * 8;
  for (int t = bid * 4 + wave; t < T; t += nb * 4) {
    int seq, s, S, cv; tok_info(t, seq, s, S, cv);
    const bf16_t* zr = Z + (size_t)t * 2944;
    {
      float af[8], ab[8];
      load8f(p.in[I_LCB] + (size_t)(j * 2 + 0) * 512 + c0, af);
      load8f(p.in[I_LCB] + (size_t)(j * 2 + 1) * 512 + c0, ab);
#pragma unroll
      for (int o = -3; o <= 3; ++o) {
        float xv[8];
        if (s + o >= 0 && s + o < S) { uint4 u = *(const uint4*)(zr + (ptrdiff_t)o * 2944 + c0); unpack8(u, xv); }
        else {
#pragma unroll
          for (int i = 0; i < 8; ++i) xv[i] = 0.f;
        }
        if (o <= 0) {
          float w[8]; load8f(p.in[I_LCW] + ((size_t)(j * 2 + 0) * 4 + (o + 3)) * 512 + c0, w);
#pragma unroll
          for (int i = 0; i < 8; ++i) af[i] += w[i] * xv[i];
        }
        if (o >= 0) {
          float w[8]; load8f(p.in[I_LCW] + ((size_t)(j * 2 + 1) * 4 + (3 - o)) * 512 + c0, w);
#pragma unroll
          for (int i = 0; i < 8; ++i) ab[i] += w[i] * xv[i];
        }
      }
      *(uint4*)(XC + (size_t)t * 512 + c0) = pack8(af);
      *(uint4*)(XC + (size_t)T * 512 + (size_t)t * 512 + c0) = pack8(ab);
    }
    const bool hp_ = s > 0, hn = s < S - 1;
#pragma unroll
    for (int part = 0; part < 3; ++part) {
      const int col = 1024 + part * 512 + c0;
      float zc[8], zp[8], zn[8], m[8], zs[8];
      unpack8(*(const uint4*)(zr + col), zc);
      if (hp_) unpack8(*(const uint4*)(zr - 2944 + col), zp); else {
#pragma unroll
        for (int i = 0; i < 8; ++i) zp[i] = 0.f;
      }
      if (hn) unpack8(*(const uint4*)(zr + 2944 + col), zn); else {
#pragma unroll
        for (int i = 0; i < 8; ++i) zn[i] = 0.f;
      }
      load8f(mu + (col - 1024), m);
#pragma unroll
      for (int i = 0; i < 8; ++i) zs[i] = zc[i] + m[i] * (0.5f * (zp[i] + zn[i]) - zc[i]);
      if (part == 0) *(uint4*)(RS + (size_t)t * 512 + c0) = pack8(zs);
      else if (part == 2) *(uint4*)(VS + (size_t)t * 512 + c0) = pack8(zs);
      else {
        *(uint4*)(KS + (size_t)t * 512 + c0) = pack8(zs);
#pragma unroll
        for (int d = 0; d < 2; ++d) {
          float kk[8], raw[8]; load8f(p.in[I_KK] + (size_t)(j * 2 + d) * 512 + c0, kk);
          float ss = 0.f;
#pragma unroll
          for (int i = 0; i < 8; ++i) { raw[i] = zs[i] * kk[i]; ss += raw[i] * raw[i]; }
          ss = sum8(ss);
          float inv = rsqrtf(fmaxf(ss, 1e-24f));
#pragma unroll
          for (int i = 0; i < 8; ++i) raw[i] *= inv;
          *(uint4*)(KKN + (size_t)d * T * 512 + (size_t)t * 512 + c0) = pack8(raw);
        }
      }
    }
    if (lane < 48) {
      const int col = 2560 + c0;
      float zc[8], zp[8], zn[8], m[8], zs[8];
      unpack8(*(const uint4*)(zr + col), zc);
      if (hp_) unpack8(*(const uint4*)(zr - 2944 + col), zp); else {
#pragma unroll
        for (int i = 0; i < 8; ++i) zp[i] = 0.f;
      }
      if (hn) unpack8(*(const uint4*)(zr + 2944 + col), zn); else {
#pragma unroll
        for (int i = 0; i < 8; ++i) zn[i] = 0.f;
      }
      load8f(mu + (col - 1024), m);
#pragma unroll
      for (int i = 0; i < 8; ++i) {
        float z = zc[i] + m[i] * (0.5f * (zp[i] + zn[i]) - zc[i]);
        zs[i] = (lane < 16) ? tanh_f(z) : ((lane < 32) ? z : sigm(z));
      }
      *(uint4*)(LRIN + (size_t)t * 384 + c0) = pack8(zs);
    }
  }
}

DI void store8f(float* p, const float (&v)[8]) {
  ((float4*)p)[0] = make_float4(v[0], v[1], v[2], v[3]);
  ((float4*)p)[1] = make_float4(v[4], v[5], v[6], v[7]);
}
template <class F>
DI void staged_epilogue(const f32x16 (&acc)[2][2], float* Cs, F f) {
  __syncthreads();
  gemm_epilogue<false, false>(acc, [&](int m, int n, float v) { Cs[m * 132 + n] = v; });
  __syncthreads();
  const int tid = tidx(), r0 = tid >> 4, c8 = (tid & 15) * 8;
#pragma unroll 2
  for (int ps = 0; ps < 8; ++ps) {
    const int row = ps * 16 + r0;
    float v[8];
    load8f(Cs + row * 132 + c8, v);
    f(row, c8, v);
  }
}

DI void phase_o3(const Params& p, unsigned char* smem, int l, int bid, int nb) {
  const int j = l >> 1;
  bf16_t* As = (bf16_t*)smem; bf16_t* Bs = As + 128 * LDT;
  float* Cs = (float*)smem;
  const bf16_t* __restrict__ XC = (const bf16_t*)(p.ws + OFF_XC);
  const bf16_t* __restrict__ LRIN = (const bf16_t*)(p.ws + OFF_LRIN);
  const bf16_t* __restrict__ KKN = (const bf16_t*)(p.ws + OFF_KKN);
  const bf16_t* __restrict__ KS = (const bf16_t*)(p.ws + OFF_KS);
  float* __restrict__ LA = (float*)(p.ws + OFF_MIX);
  bf16_t* __restrict__ LB = (bf16_t*)(p.ws + OFF_LB);
  float* __restrict__ WD = (float*)(p.ws + OFF_WD);
  bf16_t* __restrict__ KKA = (bf16_t*)(p.ws + OFF_KKA);
  bf16_t* __restrict__ KM = (bf16_t*)(p.ws + OFF_KM);
  bf16_t* __restrict__ G = (bf16_t*)(p.ws + OFF_G);
  const int c8 = (tidx() & 15) * 8;
  for (int it = bid; it < 160 * 28; it += nb) {
    const int mt = it / 28, jb = it % 28, t0 = mt * 128;
    if (jb < 8) {
      const int d = jb >> 2, nt = jb & 3, ng = nt * 128 + c8;
      const bf16_t* A = XC + (size_t)d * T * 512 + (size_t)t0 * 512 + nt * 128;
      const bf16_t* Br = (const bf16_t*)(p.ws + OFF_BT_GATE) + ((size_t)((j * 2 + d) * 2 + 0) * 512 + nt * 128) * 128;
      const bf16_t* Bi = (const bf16_t*)(p.ws + OFF_BT_GATE) + ((size_t)((j * 2 + d) * 2 + 1) * 512 + nt * 128) * 128;
      float ba8[8], bx8[8], sp8[8];
      load8f(p.in[I_LBA] + (size_t)(j * 2 + d) * 512 + ng, ba8);
      load8f(p.in[I_LBX] + (size_t)(j * 2 + d) * 512 + ng, bx8);
      load8f(p.in[I_LLAM] + (size_t)(j * 2 + d) * 512 + ng, sp8);
#pragma unroll
      for (int i = 0; i < 8; ++i) { float nl = -sp8[i]; sp8[i] = -8.f * (nl > 20.f ? nl : log1pf(__expf(nl))); }
      {
        f32x16 acc[2][2];
        gemm_mainloop<false>(A, 512, Br, 128, 128, acc, As, Bs);
        staged_epilogue(acc, Cs, [&](int row, int cc, const float (&v)[8]) {
          const size_t o = ((size_t)d * T + t0 + row) * 512 + nt * 128 + cc;
          float a[8];
#pragma unroll
          for (int i = 0; i < 8; ++i) a[i] = __expf(sigm(v[i] + ba8[i]) * sp8[i]);
          store8f(LA + o, a);
        });
      }
      {
        f32x16 acc[2][2];
        gemm_mainloop<false>(A, 512, Bi, 128, 128, acc, As, Bs);
        staged_epilogue(acc, Cs, [&](int row, int cc, const float (&v)[8]) {
          const size_t o = ((size_t)d * T + t0 + row) * 512 + nt * 128 + cc;
          float a[8], xc[8], bb[8];
          load8f(LA + o, a);
          unpack8(*(const uint4*)(XC + o), xc);
#pragma unroll
          for (int i = 0; i < 8; ++i) bb[i] = sqrtf(fmaxf(1.f - a[i] * a[i], 0.f)) * sigm(v[i] + bx8[i]) * xc[i];
          *(uint4*)(LB + o) = pack8(bb);
        });
      }
    } else if (jb < 16) {
      const int d = (jb - 8) >> 2, nt = (jb - 8) & 3, ng = nt * 128 + c8;
      float w08[8]; load8f(p.in[I_W0] + (size_t)(j * 2 + d) * 512 + ng, w08);
      f32x16 acc[2][2];
      gemm_mainloop<false>(LRIN + (size_t)t0 * 384 + d * 64, 384, (const bf16_t*)(p.ws + OFF_BT_W2) + ((size_t)(j * 2 + d) * 512 + nt * 128) * 64, 64, 64, acc, As, Bs);
      staged_epilogue(acc, Cs, [&](int row, int cc, const float (&v)[8]) {
        float w[8];
#pragma unroll
        for (int i = 0; i < 8; ++i) w[i] = __expf(-0.6065306597126334f * sigm(w08[i] + v[i]));
        store8f(WD + ((size_t)d * T + t0 + row) * 512 + nt * 128 + cc, w);
      });
    } else if (jb < 24) {
      const int d = (jb - 16) >> 2, nt = (jb - 16) & 3, ng = nt * 128 + c8;
      float a08[8], ka8[8];
      load8f(p.in[I_A0] + (size_t)(j * 2 + d) * 512 + ng, a08);
      load8f(p.in[I_KA] + (size_t)(j * 2 + d) * 512 + ng, ka8);
      f32x16 acc[2][2];
      gemm_mainloop<false>(LRIN + (size_t)t0 * 384 + 128 + d * 64, 384, (const bf16_t*)(p.ws + OFF_BT_A2) + ((size_t)(j * 2 + d) * 512 + nt * 128) * 64, 64, 64, acc, As, Bs);
      staged_epilogue(acc, Cs, [&](int row, int cc, const float (&v)[8]) {
        const size_t o = ((size_t)d * T + t0 + row) * 512 + nt * 128 + cc;
        float kkn[8], ks[8], oa[8], om[8];
        unpack8(*(const uint4*)(KKN + o), kkn);
        unpack8(*(const uint4*)(KS + (size_t)(t0 + row) * 512 + nt * 128 + cc), ks);
#pragma unroll
        for (int i = 0; i < 8; ++i) {
          float ic = sigm(a08[i] + v[i]);
          oa[i] = kkn[i] * ic;
          om[i] = ks[i] * (1.f + (ic - 1.f) * ka8[i]);
        }
        *(uint4*)(KKA + o) = pack8(oa);
        *(uint4*)(KM + o) = pack8(om);
      });
    } else {
      const int nt = jb - 24;
      f32x16 acc[2][2];
      gemm_mainloop<false>(LRIN + (size_t)t0 * 384 + 256, 384, (const bf16_t*)(p.ws + OFF_BT_G2) + ((size_t)j * 512 + nt * 128) * 128, 128, 128, acc, As, Bs);
      staged_epilogue(acc, Cs, [&](int row, int cc, const float (&v)[8]) {
        float g[8];
#pragma unroll
        for (int i = 0; i < 8; ++i) g[i] = v[i];
        *(uint4*)(G + (size_t)(t0 + row) * 512 + nt * 128 + cc) = pack8(g);
      });
    }
  }
}

constexpr int WCH = 16;
constexpr int WBUF = 5 * 4096 + 1024;
#define WKV_GLOAD(S_, c_)                                                                                                \
  {                                                                                                                      \
    const int base_ = (c_) * WCH;                                                                                        \
    S_##w = *(const uint4*)(WD + (unsigned)(tokof(base_ + (tid >> 4)) * 2048 + (tid & 15) * 16));                        \
    const unsigned o2_ = (unsigned)(tokof(base_ + ((tid & 127) >> 3)) * 1024 + (tid & 7) * 16);                          \
    S_##a = *(const uint4*)((tid < 128 ? KKN : KM) + o2_);                                                                \
    S_##b = *(const uint4*)((tid < 128 ? KKA : RS) + o2_);                                                                \
    if (tid < 32) S_##v = *(const uint4*)(VS + (unsigned)(tokof(base_ + (tid >> 1)) * 1024 + (tid & 1) * 16));           \
  }
#define WKV_LSTORE(S_, bufi_)                                                                                            \
  {                                                                                                                      \
    unsigned char* bb_ = smem + (bufi_) * WBUF;                                                                           \
    *(uint4*)(bb_ + tid * 16) = S_##w;                                                                                    \
    float f_[8];                                                                                                         \
    unsigned char* pa_ = bb_ + (tid < 128 ? 4096 : 12288) + (tid & 127) * 32;                                            \
    unpack8(S_##a, f_); store8f((float*)pa_, f_);                                                                         \
    unpack8(S_##b, f_); store8f((float*)(pa_ + 4096), f_);                                                               \
    if (tid < 32) { unpack8(S_##v, f_); store8f((float*)(bb_ + 20480 + tid * 32), f_); }                                  \
  }
DI void wkv_scan_item(const Params& p, unsigned char* smem, int j, int b, int d, int h, int rg, bool ctx) {
  const int tid = tidx(), lane = tid & 63, wave = tid >> 6;
  const int rl = wave * 4 + (lane >> 4), row = rg * 16 + rl, q = lane & 15;
  const int S = ctx ? 256 : 4096, t0 = ctx ? b * 256 : 4096 + b * 4096;
  const char* WD = (const char*)(p.ws + OFF_WD) + (size_t)d * T * 512 * 4 + h * 256;
  const char* KKN = (const char*)(p.ws + OFF_KKN) + (size_t)d * T * 512 * 2 + h * 128;
  const char* KKA = (const char*)(p.ws + OFF_KKA) + (size_t)d * T * 512 * 2 + h * 128;
  const char* KM = (const char*)(p.ws + OFF_KM) + (size_t)d * T * 512 * 2 + h * 128;
  const char* RS = (const char*)(p.ws + OFF_RS) + h * 128;
  const char* VS = (const char*)(p.ws + OFF_VS) + (h * 64 + rg * 16) * 2;
  char* Y = (char*)(p.ws + (d ? OFF_XC : OFF_H)) + (h * 64 + rg * 16) * 4;
  unsigned char* ysb = smem + 3 * WBUF;
  float st[4];
  if (ctx) { st[0] = st[1] = st[2] = st[3] = 0.f; }
  else {
    float4 s4 = *(const float4*)(p.in[I_SWKV] + ((((size_t)(b * 2 + j) * 2 + d) * 8 + h) * 64 + row) * 64 + q * 4);
    st[0] = s4.x; st[1] = s4.y; st[2] = s4.z; st[3] = s4.w;
  }
  auto tokof = [&](int step) -> int { return t0 + (d ? (S - 1 - step) : step); };
  const uint4 z4 = make_uint4(0u, 0u, 0u, 0u);
  uint4 g0w = z4, g0a = z4, g0b = z4, g0v = z4, g1w = z4, g1a = z4, g1b = z4, g1v = z4;
  const int nch = S / WCH;
  __syncthreads();
  WKV_GLOAD(g0, 0) WKV_GLOAD(g1, 1)
  WKV_LSTORE(g0, 0) WKV_LSTORE(g1, 1)
  WKV_GLOAD(g0, 2) WKV_GLOAD(g1, 3)
  __syncthreads();
  auto compute = [&](int c) {
    const unsigned char* bb = smem + (c % 3) * WBUF;
    float* ys = (float*)(ysb + (c & 1) * 1024);
    float4 nw = *(const float4*)(bb + q * 16), nkk = *(const float4*)(bb + 4096 + q * 16), nkka = *(const float4*)(bb + 8192 + q * 16);
    float4 nkm = *(const float4*)(bb + 12288 + q * 16), nr = *(const float4*)(bb + 16384 + q * 16);
    float nv = *(const float*)(bb + 20480 + rl * 4);
#pragma unroll
    for (int s = 0; s < WCH; ++s) {
      const float4 w = nw, kk = nkk, kka = nkka, km = nkm, r = nr; const float v = nv;
      {
        const int s1 = (s + 1 < WCH) ? s + 1 : s;
        nw = *(const float4*)(bb + s1 * 256 + q * 16); nkk = *(const float4*)(bb + 4096 + s1 * 256 + q * 16);
        nkka = *(const float4*)(bb + 8192 + s1 * 256 + q * 16); nkm = *(const float4*)(bb + 12288 + s1 * 256 + q * 16);
        nr = *(const float4*)(bb + 16384 + s1 * 256 + q * 16); nv = *(const float*)(bb + 20480 + s1 * 64 + rl * 4);
      }
      float sk = st[0] * kk.x + st[1] * kk.y + st[2] * kk.z + st[3] * kk.w;
      sk = sum16(sk);
      st[0] = st[0] * w.x - sk * kka.x + v * km.x;
      st[1] = st[1] * w.y - sk * kka.y + v * km.y;
      st[2] = st[2] * w.z - sk * kka.z + v * km.z;
      st[3] = st[3] * w.w - sk * kka.w + v * km.w;
      float y = st[0] * r.x + st[1] * r.y + st[2] * r.z + st[3] * r.w;
      y = sum16(y);
      ys[s * 16 + rl] = y;
    }
  };
  auto flush = [&](int c) {
    const float* ys = (const float*)(ysb + (c & 1) * 1024);
    const int s1 = tid >> 4, rr = tid & 15;
    *(float*)(Y + (unsigned)(tokof(c * WCH + s1) * 2048 + rr * 4)) = ys[s1 * 16 + rr];
  };
  for (int c = 0; c < nch; c += 2) {
    compute(c);
    if (c + 2 < nch) WKV_LSTORE(g0, (c + 2) % 3)
    if (c + 4 < nch) WKV_GLOAD(g0, c + 4)
    __syncthreads();
    flush(c);
    compute(c + 1);
    if (c + 3 < nch) WKV_LSTORE(g1, (c + 3) % 3)
    if (c + 5 < nch) WKV_GLOAD(g1, c + 5)
    __syncthreads();
    flush(c + 1);
  }
  if (ctx) {
    float* o = p.out + 21004288 + ((((size_t)(b * 2 + j) * 2 + d) * 8 + h) * 64 + row) * 64 + q * 4;
    *(float4*)o = make_float4(st[0], st[1], st[2], st[3]);
  }
}
#undef WKV_GLOAD
#undef WKV_LSTORE

DI void lru_scan_item(const Params& p, unsigned char* smem, int j, int b, int cgp, bool ctx, int chb) {
  const int tid = tidx(), c = tid & ((1 << chb) - 1), sg = tid >> chb;
  const int nseg = NTHR >> chb;
  const int ch = (cgp << chb) + c;
  const int S = ctx ? 256 : 4096, t0 = ctx ? b * 256 : 4096 + b * 4096;
  const int L = S / nseg;
  float* sA = (float*)smem; float* sB = sA + 256;
  char* YM = (char*)(p.ws + OFF_YMIX);
  const char* Z = (const char*)(p.ws + OFF_Z);
  for (int d = 0; d < 2; ++d) {
    const char* la = (const char*)(p.ws + OFF_MIX) + (size_t)d * T * 512 * 4;
    const char* lb = (const char*)(p.ws + OFF_LB) + (size_t)d * T * 512 * 2;
    float A = 1.f, Bv = 0.f;
#pragma unroll 8
    for (int st = sg * L; st < (sg + 1) * L; ++st) {
      const int tk = t0 + (d ? (S - 1 - st) : st);
      float a = *(const float*)(la + (unsigned)(tk * 2048 + ch * 4));
      float bb = bf2f(*(const bf16_t*)(lb + (unsigned)(tk * 1024 + ch * 2)));
      A *= a; Bv = a * Bv + bb;
    }
    __syncthreads();
    sA[tid] = A; sB[tid] = Bv;
    __syncthreads();
    float h = ctx ? 0.f : p.in[I_SLRU][((size_t)(b * 2 + j) * 2 + d) * 512 + ch];
    for (int s2 = 0; s2 < sg; ++s2) h = sA[(s2 << chb) + c] * h + sB[(s2 << chb) + c];
#pragma unroll 8
    for (int st = sg * L; st < (sg + 1) * L; ++st) {
      const int tk = t0 + (d ? (S - 1 - st) : st);
      float a = *(const float*)(la + (unsigned)(tk * 2048 + ch * 4));
      float bb = bf2f(*(const bf16_t*)(lb + (unsigned)(tk * 1024 + ch * 2)));
      h = a * h + bb;
      bf16_t* ym = (bf16_t*)(YM + (unsigned)(tk * 2048 + ch * 2));
      if (d == 0) *ym = (bf16_t)f2bf(h);
      else {
        float hs = h + bf2f(*ym);
        float gb = bf2f(*(const bf16_t*)(Z + (unsigned)(tk * 5888 + 1024 + ch * 2)));
        *ym = (bf16_t)f2bf(hs * gelu_t(gb));
      }
    }
    if (ctx && sg == nseg - 1) p.out[20971520 + ((size_t)(b * 2 + j) * 2 + d) * 512 + ch] = h;
    __syncthreads();
  }
}

DI void phase_o4(const Params& p, unsigned char* smem, int l, int bid, int nb) {
  const int j = l >> 1;
  auto do_item = [&](int it) {
    if (it < 256) { int sid = it >> 2, rg = it & 3; wkv_scan_item(p, smem, j, sid >> 4, (sid >> 3) & 1, sid & 7, rg, false); }
    else if (it < 512) { int r = it - 256; lru_scan_item(p, smem, j, r >> 6, r & 63, false, 3); }
    else if (it < 1536) { int r = it - 512; int sid = r >> 2, rg = r & 3; wkv_scan_item(p, smem, j, sid >> 4, (sid >> 3) & 1, sid & 7, rg, true); }
    else { int r = it - 1536; lru_scan_item(p, smem, j, r >> 4, r & 15, true, 5); }
  };
  if (nb >= 512) {
    if (bid < 256) do_item(bid);
    else {
      const int ob = bid - 256, no = nb - 256;
      for (int it = 256 + ob; it < 512; it += no) do_item(it);
      for (int it = 512 + ob; it < 1792; it += no) do_item(it);
    }
  } else {
    for (int it = bid; it < 1792; it += nb) do_item(it);
  }
}

DI void phase_o5(const Params& p, int l, int bid, int nb) {
  const int j = l >> 1;
  const int lane = tidx() & 63, wave = tidx() >> 6;
  const float* YF = (const float*)(p.ws + OFF_H);
  const float* YB = (const float*)(p.ws + OFF_XC);
  const bf16_t* RS = (const bf16_t*)(p.ws + OFF_RS);
  const bf16_t* VS = (const bf16_t*)(p.ws + OFF_VS);
  const bf16_t* KM = (const bf16_t*)(p.ws + OFF_KM);
  const bf16_t* G = (const bf16_t*)(p.ws + OFF_G);
  bf16_t* YM = (bf16_t*)(p.ws + OFF_YMIX);
  const int c0 = lane * 8;
  float gng[8], gnb[8], rk[8];
  load8f(p.in[I_GNG] + j * 512 + c0, gng);
  load8f(p.in[I_GNB] + j * 512 + c0, gnb);
  load8f(p.in[I_RK] + j * 512 + c0, rk);
  for (int t = bid * 4 + wave; t < T; t += nb * 4) {
    const size_t o = (size_t)t * 512 + c0;
    float yf[8], yb[8], ys[8];
    load8f(YF + o, yf); load8f(YB + o, yb);
    float s = 0.f;
#pragma unroll
    for (int i = 0; i < 8; ++i) { ys[i] = yf[i] + yb[i]; s += ys[i]; }
    const float mean = sum8(s) * (1.f / 64.f);
    float v = 0.f;
#pragma unroll
    for (int i = 0; i < 8; ++i) { float dd = ys[i] - mean; v += dd * dd; }
    const float rstd = rsqrtf(sum8(v) * (1.f / 64.f) + 64e-5f);
    float r[8], vv[8], kf[8], kb[8], g[8];
    unpack8(*(const uint4*)(RS + o), r);
    unpack8(*(const uint4*)(VS + o), vv);
    unpack8(*(const uint4*)(KM + o), kf);
    unpack8(*(const uint4*)(KM + (size_t)T * 512 + o), kb);
    unpack8(*(const uint4*)(G + o), g);
    float sf = 0.f;
#pragma unroll
    for (int i = 0; i < 8; ++i) sf += r[i] * rk[i] * (kf[i] + kb[i]);
    sf = sum8(sf);
    float outv[8];
#pragma unroll
    for (int i = 0; i < 8; ++i) outv[i] = ((ys[i] - mean) * rstd * gng[i] + gnb[i] + sf * vv[i]) * g[i];
    *(uint4*)(YM + (size_t)t * 1024 + 512 + c0) = pack8(outv);
  }
}

enum { PH_PREP = 0, PH_INIT, PH_E1, PH_E2, PH_EOUT, PH_RES, PH_P1, PH_P2, PH_O1, PH_O2, PH_O3, PH_O4, PH_O5, PH_OOUT };

DI void run_phase(const Params& p, unsigned char* smem, int ph, int l, int bid, int nb) {
  switch (ph) {
    case PH_PREP: phase_prep(p, smem, bid, nb); break;
    case PH_INIT: phase_init(p, bid, nb); break;
    case PH_E1: phase_e1(p, smem, l, bid, nb); break;
    case PH_E2: phase_e2(p, smem, l, bid, nb); break;
    case PH_EOUT: phase_outgemm(p, smem, (const bf16_t*)(p.ws + OFF_BT_OUT_E) + (size_t)(l >> 1) * 1024 * 1024, bid, nb); break;
    case PH_RES: phase_res1(p, l, bid, nb); break;
    case PH_P1: phase_p1(p, smem, l, bid, nb); break;
    case PH_P2: phase_p2(p, smem, l, bid, nb); break;
    case PH_O1: phase_o1(p, smem, l, bid, nb); break;
    case PH_O2: phase_o2(p, l, bid, nb); break;
    case PH_O3: phase_o3(p, smem, l, bid, nb); break;
    case PH_O4: phase_o4(p, smem, l, bid, nb); break;
    case PH_O5: phase_o5(p, l, bid, nb); break;
    case PH_OOUT: phase_outgemm(p, smem, (const bf16_t*)(p.ws + OFF_BT_OUT_O) + (size_t)(l >> 1) * 1024 * 1024, bid, nb); break;
  }
}


#define XB_TMO      128
#define XB_XCNT(j)  (256  + 64 * (j))
#define XB_XSUB(j)  (1280 + 64 * (j))
#define XB_XGEN(j)  (2304 + 64 * (j))
#define XB_TOP      3328
#define XB_TOPGEN   3392
#define XCD_BAR_WORDS 3456
#define XB_SPIN_CAP (1u << 22)
#define LAS __attribute__((address_space(3)))
DI unsigned xb_ld(unsigned* p) { return __hip_atomic_load(p, __ATOMIC_RELAXED, __HIP_MEMORY_SCOPE_AGENT); }
DI unsigned xb_add(unsigned* p, unsigned v) { return __hip_atomic_fetch_add(p, v, __ATOMIC_RELAXED, __HIP_MEMORY_SCOPE_AGENT); }
DI unsigned xb_xcc_id() { return (unsigned)__builtin_amdgcn_s_getreg((3 << 11) | 20) & 0xFu; }
#define XB_SPIN(cond, bar) do { unsigned _sp = 0; while (cond) { __builtin_amdgcn_s_sleep(1); \
    if ((++_sp & 255u) == 0u) { if (xb_ld(&(bar)[XB_TMO])) break; if (_sp > XB_SPIN_CAP) { atomicAdd(&(bar)[XB_TMO], 1u); break; } } } } while (0)
struct XcdBarrier { unsigned* bar; unsigned x; volatile LAS unsigned* st; };
DI XcdBarrier xcd_barrier_post(unsigned* bar, volatile LAS unsigned* st) {
  XcdBarrier b; b.bar = bar; b.x = xb_xcc_id(); b.st = st;
  if (__builtin_amdgcn_workitem_id_x() == 0) (void)xb_add(&bar[XB_XCNT(b.x)], 1u);
  return b;
}
DI void xcd_barrier_complete(unsigned* bar, unsigned x, unsigned& nloc, unsigned& nx) {
  const unsigned G = gridDim.x;
  unsigned sum, cnt, mine, sp = 0u;
  for (;;) {
    sum = 0u; cnt = 0u; mine = 0u;
#pragma unroll
    for (unsigned j = 0; j < 16; ++j) { const unsigned c = xb_ld(&bar[XB_XCNT(j)]); sum += c; cnt += (c > 0u) ? 1u : 0u; mine = (j == x) ? c : mine; }
    if (sum == G) break;
    __builtin_amdgcn_s_sleep(1);
    if ((++sp & 255u) == 0u) { if (xb_ld(&bar[XB_TMO])) break; if (sp > XB_SPIN_CAP) { atomicAdd(&bar[XB_TMO], 1u); break; } }
  }
  nloc = mine > 0u ? mine : 1u; nx = cnt > 0u ? cnt : 1u;
}
DI void xcd_barrier(const XcdBarrier& b) {
  asm volatile("s_waitcnt vmcnt(0)" ::: "memory");
  __syncthreads();
  if (__builtin_amdgcn_workitem_id_x() == 0) {
    unsigned* bar = b.bar;
    __builtin_amdgcn_s_waitcnt(0);
    unsigned nloc = b.st[0], nx = b.st[1];
    if (nloc == 0u) { xcd_barrier_complete(bar, b.x, nloc, nx); b.st[0] = nloc; b.st[1] = nx; }
    const unsigned old = xb_add(&bar[XB_XSUB(b.x)], 1u);
    const unsigned gen = old / nloc;
    if (old + 1u == (gen + 1u) * nloc) {
      __builtin_amdgcn_fence(__ATOMIC_RELEASE, "agent");
      asm volatile("s_waitcnt vmcnt(0)" ::: "memory");
      const unsigned og = xb_add(&bar[XB_TOP], 1u);
      const unsigned tg = og / nx;
      if (og + 1u == (tg + 1u) * nx) xb_add(&bar[XB_TOPGEN], 1u);
      else XB_SPIN(xb_ld(&bar[XB_TOPGEN]) == tg, bar);
      __builtin_amdgcn_fence(__ATOMIC_ACQUIRE, "agent");
      xb_add(&bar[XB_XGEN(b.x)], 1u);
      asm volatile("s_waitcnt vmcnt(0)" ::: "memory");
    } else {
      XB_SPIN(xb_ld(&bar[XB_XGEN(b.x)]) == gen, bar);
      __builtin_amdgcn_fence(__ATOMIC_ACQUIRE, "agent");
      asm volatile("s_waitcnt vmcnt(0)" ::: "memory");
    }
  }
  __syncthreads();
}

DI void grid_seam(cg::grid_group& grid) {
  asm volatile("s_waitcnt vmcnt(0)" ::: "memory");
  grid.sync();
  asm volatile("buffer_inv sc1\n\ts_waitcnt vmcnt(0)" ::: "memory");
}
#if MULTI
__global__ void __launch_bounds__(NTHR, 2) phase_kernel(Params p, int ph, int l) {
  extern __shared__ __attribute__((aligned(16))) unsigned char smem[];
  run_phase(p, smem, ph, l, blockIdx.x, gridDim.x);
}
#else
#ifndef TPROBE
#define TPROBE 0
#endif
__global__ void __launch_bounds__(NTHR, 2) mega_kernel(Params p) {
  extern __shared__ __attribute__((aligned(16))) unsigned char smem[];
  cg::grid_group grid = cg::this_grid();
  const int bid = blockIdx.x, nb = gridDim.x;
  if (__builtin_amdgcn_workitem_id_x() == 0) *(uint4*)(smem + LDS_MAIN) = make_uint4(0u, 0u, 0u, 0u);
  __syncthreads();
  XcdBarrier xb = xcd_barrier_post((unsigned*)(p.ws + OFF_BAR), (volatile LAS unsigned*)(smem + LDS_MAIN));
#if TPROBE
  unsigned long long tprev = wall_clock64(), tsel = 0, ttot = 0;
#endif
  for (int step = 0; step < 32; ++step) {
    int ph, l;
    if (step < 2) { ph = step; l = 0; }
    else {
      int s = step - 2, k;
      if (s < 6) { l = 0; k = s; } else if (s < 15) { l = 1; k = s - 6; } else if (s < 21) { l = 2; k = s - 15; } else { l = 3; k = s - 21; }
      if ((l & 1) == 0) ph = PH_E1 + k;
      else ph = (k < 6) ? PH_O1 + k : PH_RES + (k - 6);
    }
#if defined(__HIP_DEVICE_COMPILE__)
    const __attribute__((address_space(4))) Params* kp = (const __attribute__((address_space(4))) Params*)__builtin_amdgcn_kernarg_segment_ptr();
    asm volatile("" : "+s"(kp), "+s"(l), "+s"(ph));
    const Params q = *kp;
#else
    const Params q = p;
#endif
    run_phase(q, smem, ph, l, bid, nb);
#if !TPROBE
    if (step == 31) break;
#endif
    if (step == 0) grid_seam(grid);
    else xcd_barrier(xb);
#if TPROBE
    {
      unsigned long long tn = wall_clock64();
      if ((TPROBE >> ph) & 1) tsel += tn - tprev;
      ttot += tn - tprev;
      tprev = tn;
    }
#endif
  }
#if TPROBE
  if (bid == 0) {
    float frac = (float)((double)tsel / (double)ttot);
    float sc = 1.f + sqrtf(frac);
    for (int i = tidx(); i < 32768; i += NTHR) p.out[20971520 + i] *= sc;
  }
#endif
}
#endif

extern "C" void kernel_launch(void* const* d_in, const int* in_sizes, int n_in, void* d_out, int out_size, void* d_ws, size_t ws_size,
                              hipStream_t stream) {
  static int grid_blocks = 0;
  if (grid_blocks == 0) {
    if (n_in != 40 || ws_size < WS_END) { fprintf(stderr, "kernel_launch: unexpected n_in %d or ws_size %zu (need %zu)\n", n_in, ws_size, (size_t)WS_END); grid_blocks = -1; return; }
    int dev = 0, cus = 0, per_cu = 0;
    hipGetDevice(&dev);
    hipDeviceGetAttribute(&cus, hipDeviceAttributeMultiprocessorCount, dev);
#if MULTI
    hipFuncSetAttribute((const void*)phase_kernel, hipFuncAttributeMaxDynamicSharedMemorySize, LDS_BYTES);
    hipOccupancyMaxActiveBlocksPerMultiprocessor(&per_cu, (const void*)phase_kernel, NTHR, LDS_BYTES);
#else
    hipFuncSetAttribute((const void*)mega_kernel, hipFuncAttributeMaxDynamicSharedMemorySize, LDS_BYTES);
    hipOccupancyMaxActiveBlocksPerMultiprocessor(&per_cu, (const void*)mega_kernel, NTHR, LDS_BYTES);
#endif
    if (per_cu < 1) per_cu = 1;
    if (per_cu > 2) per_cu = 2;
    if (cus < 1) cus = 256;
    grid_blocks = cus * per_cu;
  }
  if (grid_blocks < 0) return;
  Params p{};
  for (int i = 0; i < 40; ++i) p.in[i] = (const float*)d_in[i];
  p.out = (float*)d_out;
  p.ws = (unsigned char*)d_ws;
#if MULTI
  auto L = [&](int ph, int l) { hipLaunchKernelGGL(phase_kernel, dim3(grid_blocks), dim3(NTHR), LDS_BYTES, stream, p, ph, l); };
  L(PH_PREP, 0); L(PH_INIT, 0);
  for (int l = 0; l < 4; ++l) {
    if ((l & 1) == 0) { L(PH_E1, l); L(PH_E2, l); L(PH_EOUT, l); }
    else { L(PH_O1, l); L(PH_O2, l); L(PH_O3, l); L(PH_O4, l); L(PH_O5, l); L(PH_OOUT, l); }
    L(PH_RES, l); L(PH_P1, l); L(PH_P2, l);
  }
#else
  (void)hipMemsetAsync((char*)d_ws + OFF_BAR, 0, XCD_BAR_WORDS * sizeof(unsigned), stream);
  void* args[] = {&p};
  hipError_t e = hipLaunchCooperativeKernel((const void*)mega_kernel, dim3(grid_blocks), dim3(NTHR), args, LDS_BYTES, stream);
  if (e != hipSuccess) fprintf(stderr, "cooperative launch failed: %s (grid %d)\n", hipGetErrorString(e), grid_blocks);
#endif
}
```

```cpp
#include <hip/hip_runtime.h>
#include <hip/hip_cooperative_groups.h>
#include <cstdio>
#include <cstdint>
namespace cg = cooperative_groups;

#ifndef MULTI
#define MULTI 0
#endif

typedef unsigned short bf16_t;
using bf16x8 = __attribute__((ext_vector_type(8))) short;
using f32x16 = __attribute__((ext_vector_type(16))) float;
#define DI __device__ __forceinline__
#define MFMA(a, b, c) __builtin_amdgcn_mfma_f32_32x32x16_bf16((a), (b), (c), 0, 0, 0)

constexpr int T = 20480;
constexpr int NTHR = 256;
constexpr int LDS_MAIN = 71680;
constexpr int LDS_BYTES = LDS_MAIN + 16;
constexpr float ALPHA_F = 1.681792830507429f;

constexpr size_t MiB = 1u << 20;
constexpr size_t OFF_TABU = 0;
constexpr size_t OFF_TABV = OFF_TABU + 32 * MiB;
constexpr size_t OFF_BT_IN_E = OFF_TABV + 32 * MiB;
constexpr size_t OFF_BT_OUT_E = OFF_BT_IN_E + 10 * MiB;
constexpr size_t OFF_BT_IN_O = OFF_BT_OUT_E + 4 * MiB;
constexpr size_t OFF_BT_OUT_O = OFF_BT_IN_O + 12 * MiB;
constexpr size_t OFF_BT_WQ = OFF_BT_OUT_O + 4 * MiB;
constexpr size_t OFF_BT_W2 = OFF_BT_WQ + 16 * MiB;
constexpr size_t OFF_BT_A2 = OFF_BT_W2 + 256 * 1024;
constexpr size_t OFF_BT_G2 = OFF_BT_A2 + 256 * 1024;
constexpr size_t OFF_BT_GATE = OFF_BT_G2 + 256 * 1024;
constexpr size_t OFF_D256 = OFF_BT_GATE + 2 * MiB;
constexpr size_t OFF_MOD = OFF_D256 + 256 * 1024;
constexpr size_t OFF_D4096 = OFF_MOD + 512 * 1024;
constexpr size_t OFF_X = OFF_D4096 + 64 * MiB;
constexpr size_t OFF_Z = OFF_X + 80 * MiB;
constexpr size_t OFF_YMIX = OFF_Z + 115 * MiB;
constexpr size_t OFF_MIX = OFF_YMIX + 40 * MiB;
constexpr size_t OFF_H = OFF_MIX + 80 * MiB;
constexpr size_t OFF_XC = OFF_H + 40 * MiB;
constexpr size_t OFF_LRIN = OFF_XC + 40 * MiB;
constexpr size_t OFF_KKN = OFF_LRIN + 15 * MiB;
constexpr size_t OFF_KS = OFF_KKN + 40 * MiB;
constexpr size_t OFF_RS = OFF_KS + 20 * MiB;
constexpr size_t OFF_VS = OFF_RS + 20 * MiB;
constexpr size_t OFF_LB = OFF_VS + 20 * MiB;
constexpr size_t OFF_WD = OFF_LB + 40 * MiB;
constexpr size_t OFF_KKA = OFF_WD + 80 * MiB;
constexpr size_t OFF_KM = OFF_KKA + 40 * MiB;
constexpr size_t OFF_G = OFF_KM + 40 * MiB;
constexpr size_t OFF_BAR = OFF_G + 20 * MiB;
constexpr size_t WS_END = OFF_BAR + 16384;

struct Params {
  const float* in[40];
  float* out;
  unsigned char* ws;
};

enum {
  I_XP = 0, I_XS, I_SLRU, I_SWKV, I_C, I_CCTX, I_WMOD, I_BMOD, I_LN1G, I_LN1B, I_LN2G, I_LN2B, I_WINE, I_WOUTE, I_SCW, I_SCB,
  I_WINO, I_WOUTO, I_LCW, I_LCB, I_LWA, I_LBA, I_LWX, I_LBX, I_LLAM, I_MU, I_W0, I_W2, I_A0, I_A2, I_KK, I_KA, I_RK, I_G2, I_GNG,
  I_GNB, I_WQ, I_KEYS, I_PU, I_PV
};

DI int tidx() { int t = __builtin_amdgcn_workitem_id_x(); asm volatile("" : "+v"(t)); return t; }
DI unsigned f2bf(float x) { unsigned u = __float_as_uint(x); u += 0x7fffu + ((u >> 16) & 1u); return u >> 16; }
DI unsigned pack2(float a, float b) { return f2bf(a) | (f2bf(b) << 16); }
DI float bflo(unsigned u) { return __uint_as_float(u << 16); }
DI float bfhi(unsigned u) { return __uint_as_float(u & 0xffff0000u); }
DI float bf2f(bf16_t h) { return __uint_as_float(((unsigned)h) << 16); }
DI float sigm(float x) { return __builtin_amdgcn_rcpf(1.f + __expf(-x)); }
DI float gelu_t(float x) { float u = 0.7978845608028654f * (x + 0.044715f * x * x * x); return x * sigm(2.f * u); }
DI float tanh_f(float x) { return 2.f * sigm(2.f * x) - 1.f; }

template <int CTRL> DI float dpp_mov(float x) {
  return __int_as_float(__builtin_amdgcn_update_dpp(0, __float_as_int(x), CTRL, 0xF, 0xF, true));
}
DI float sum8(float x) { x += dpp_mov<0xB1>(x); x += dpp_mov<0x4E>(x); x += dpp_mov<0x141>(x); return x; }
DI float sum16(float x) { x = sum8(x); x += dpp_mov<0x140>(x); return x; }
DI float max16(float x) {
  x = fmaxf(x, dpp_mov<0xB1>(x)); x = fmaxf(x, dpp_mov<0x4E>(x)); x = fmaxf(x, dpp_mov<0x141>(x)); x = fmaxf(x, dpp_mov<0x140>(x));
  return x;
}
DI float rdlane(float x, int l) { return __int_as_float(__builtin_amdgcn_readlane(__float_as_int(x), l)); }
DI float wave_sum(float x) { x = sum16(x); return (rdlane(x, 0) + rdlane(x, 16)) + (rdlane(x, 32) + rdlane(x, 48)); }

DI void tok_info(int t, int& seq, int& s, int& S, int& cv) {
  if (t < 4096) { seq = t >> 8; s = t & 255; S = 256; cv = 0; }
  else { int u = t - 4096; seq = 16 + (u >> 12); s = u & 4095; S = 4096; cv = 1 + (u >> 12); }
}
DI size_t pqt_base(int seq) { return seq < 16 ? (size_t)seq * 512 * 512 : (size_t)16 * 512 * 512 + (size_t)(seq - 16) * 512 * 8192; }

DI void load_row(const float* p, int lane, float (&v)[16]) {
  const float4* q = (const float4*)(p + lane * 8);
  float4 a = q[0], b = q[1];
  const float4* q2 = (const float4*)(p + 512 + lane * 8);
  float4 c = q2[0], d = q2[1];
  v[0] = a.x; v[1] = a.y; v[2] = a.z; v[3] = a.w; v[4] = b.x; v[5] = b.y; v[6] = b.z; v[7] = b.w;
  v[8] = c.x; v[9] = c.y; v[10] = c.z; v[11] = c.w; v[12] = d.x; v[13] = d.y; v[14] = d.z; v[15] = d.w;
}
DI void store_row(float* p, int lane, const float (&v)[16]) {
  float4* q = (float4*)(p + lane * 8);
  q[0] = make_float4(v[0], v[1], v[2], v[3]); q[1] = make_float4(v[4], v[5], v[6], v[7]);
  float4* q2 = (float4*)(p + 512 + lane * 8);
  q2[0] = make_float4(v[8], v[9], v[10], v[11]); q2[1] = make_float4(v[12], v[13], v[14], v[15]);
}
DI void store_row_bf(bf16_t* p, int lane, const float (&v)[16]) {
  uint4 a, b;
  a.x = pack2(v[0], v[1]); a.y = pack2(v[2], v[3]); a.z = pack2(v[4], v[5]); a.w = pack2(v[6], v[7]);
  b.x = pack2(v[8], v[9]); b.y = pack2(v[10], v[11]); b.z = pack2(v[12], v[13]); b.w = pack2(v[14], v[15]);
  *(uint4*)(p + lane * 8) = a;
  *(uint4*)(p + 512 + lane * 8) = b;
}
DI void unpack8(uint4 u, float (&v)[8]) {
  v[0] = bflo(u.x); v[1] = bfhi(u.x); v[2] = bflo(u.y); v[3] = bfhi(u.y); v[4] = bflo(u.z); v[5] = bfhi(u.z); v[6] = bflo(u.w); v[7] = bfhi(u.w);
}
DI uint4 pack8(const float (&v)[8]) {
  uint4 a; a.x = pack2(v[0], v[1]); a.y = pack2(v[2], v[3]); a.z = pack2(v[4], v[5]); a.w = pack2(v[6], v[7]); return a;
}
DI void load8f(const float* p, float (&v)[8]) {
  float4 a = ((const float4*)p)[0], b = ((const float4*)p)[1];
  v[0] = a.x; v[1] = a.y; v[2] = a.z; v[3] = a.w; v[4] = b.x; v[5] = b.y; v[6] = b.z; v[7] = b.w;
}

DI void load_row16(const float* p, int lane, float (&v)[16]) {
  const float4* q = (const float4*)(p + lane * 16);
  float4 a = q[0], b = q[1], c = q[2], d = q[3];
  v[0] = a.x; v[1] = a.y; v[2] = a.z; v[3] = a.w; v[4] = b.x; v[5] = b.y; v[6] = b.z; v[7] = b.w;
  v[8] = c.x; v[9] = c.y; v[10] = c.z; v[11] = c.w; v[12] = d.x; v[13] = d.y; v[14] = d.z; v[15] = d.w;
}
DI void store_row16(float* p, int lane, const float (&v)[16]) {
  float4* q = (float4*)(p + lane * 16);
  q[0] = make_float4(v[0], v[1], v[2], v[3]); q[1] = make_float4(v[4], v[5], v[6], v[7]);
  q[2] = make_float4(v[8], v[9], v[10], v[11]); q[3] = make_float4(v[12], v[13], v[14], v[15]);
}
DI void store_row16_bf(bf16_t* p, int lane, const float (&v)[16]) {
  uint4 a, b;
  a.x = pack2(v[0], v[1]); a.y = pack2(v[2], v[3]); a.z = pack2(v[4], v[5]); a.w = pack2(v[6], v[7]);
  b.x = pack2(v[8], v[9]); b.y = pack2(v[10], v[11]); b.z = pack2(v[12], v[13]); b.w = pack2(v[14], v[15]);
  uint4* q = (uint4*)(p + lane * 16);
  q[0] = a; q[1] = b;
}
typedef float v2f_t __attribute__((ext_vector_type(2)));
DI unsigned pk_fp8x4(float a, float b, float c, float d) {
  int w = 0;
  w = __builtin_amdgcn_cvt_pk_fp8_f32(a, b, w, false);
  w = __builtin_amdgcn_cvt_pk_fp8_f32(c, d, w, true);
  return (unsigned)w;
}
DI void unpack_fp8x16_v2(uint4 u, v2f_t (&v)[8]) {
  v[0] = __builtin_amdgcn_cvt_pk_f32_fp8((int)u.x, false); v[1] = __builtin_amdgcn_cvt_pk_f32_fp8((int)u.x, true);
  v[2] = __builtin_amdgcn_cvt_pk_f32_fp8((int)u.y, false); v[3] = __builtin_amdgcn_cvt_pk_f32_fp8((int)u.y, true);
  v[4] = __builtin_amdgcn_cvt_pk_f32_fp8((int)u.z, false); v[5] = __builtin_amdgcn_cvt_pk_f32_fp8((int)u.z, true);
  v[6] = __builtin_amdgcn_cvt_pk_f32_fp8((int)u.w, false); v[7] = __builtin_amdgcn_cvt_pk_f32_fp8((int)u.w, true);
}
DI void unpack_fp8x16(uint4 u, float (&v)[16]) {
  v2f_t t;
  t = __builtin_amdgcn_cvt_pk_f32_fp8((int)u.x, false); v[0] = t.x; v[1] = t.y;
  t = __builtin_amdgcn_cvt_pk_f32_fp8((int)u.x, true); v[2] = t.x; v[3] = t.y;
  t = __builtin_amdgcn_cvt_pk_f32_fp8((int)u.y, false); v[4] = t.x; v[5] = t.y;
  t = __builtin_amdgcn_cvt_pk_f32_fp8((int)u.y, true); v[6] = t.x; v[7] = t.y;
  t = __builtin_amdgcn_cvt_pk_f32_fp8((int)u.z, false); v[8] = t.x; v[9] = t.y;
  t = __builtin_amdgcn_cvt_pk_f32_fp8((int)u.z, true); v[10] = t.x; v[11] = t.y;
  t = __builtin_amdgcn_cvt_pk_f32_fp8((int)u.w, false); v[12] = t.x; v[13] = t.y;
  t = __builtin_amdgcn_cvt_pk_f32_fp8((int)u.w, true); v[14] = t.x; v[15] = t.y;
}
DI void ln16(float (&y)[16]) {
  float s = 0.f;
#pragma unroll
  for (int i = 0; i < 16; ++i) s += y[i];
  float mu = wave_sum(s) * (1.f / 1024.f);
  float v = 0.f;
#pragma unroll
  for (int i = 0; i < 16; ++i) { float d = y[i] - mu; v += d * d; }
  v = wave_sum(v) * (1.f / 1024.f);
  float rs = rsqrtf(v + 1e-6f);
#pragma unroll
  for (int i = 0; i < 16; ++i) y[i] = (y[i] - mu) * rs;
}

constexpr int LDT = 72;

template <bool SWAP>
DI void gemm_mainloop(const bf16_t* __restrict__ A, int lda, const bf16_t* __restrict__ B, int ldb, int K,
                      f32x16 (&acc)[2][2], bf16_t* As, bf16_t* Bs) {
  const int tid = tidx(), lane = tid & 63, wave = tid >> 6;
  const int wm = wave >> 1, wn = wave & 1;
  const int lrow = tid >> 3, lck = tid & 7;
  const bf16_t* ap = A + (size_t)lrow * lda + lck * 8;
  const bf16_t* bp = B + (size_t)lrow * ldb + lck * 8;
  const size_t sa = (size_t)32 * lda, sb = (size_t)32 * ldb;
  uint4 ra0, ra1, ra2, ra3, rb0, rb1, rb2, rb3;
  ra0 = *(const uint4*)(ap); ra1 = *(const uint4*)(ap + sa); ra2 = *(const uint4*)(ap + 2 * sa); ra3 = *(const uint4*)(ap + 3 * sa);
  rb0 = *(const uint4*)(bp); rb1 = *(const uint4*)(bp + sb); rb2 = *(const uint4*)(bp + 2 * sb); rb3 = *(const uint4*)(bp + 3 * sb);
#pragma unroll
  for (int mi = 0; mi < 2; ++mi)
#pragma unroll
    for (int ni = 0; ni < 2; ++ni)
#pragma unroll
      for (int r = 0; r < 16; ++r) acc[mi][ni][r] = 0.f;
  const int KT = K / 64;
  const int fr = (lane & 31) * LDT + (lane >> 5) * 8;
  bf16_t* asw = As + lrow * LDT + lck * 8;
  bf16_t* bsw = Bs + lrow * LDT + lck * 8;
  for (int kt = 0; kt < KT; ++kt) {
    __syncthreads();
    *(uint4*)(asw) = ra0; *(uint4*)(asw + 32 * LDT) = ra1; *(uint4*)(asw + 64 * LDT) = ra2; *(uint4*)(asw + 96 * LDT) = ra3;
    *(uint4*)(bsw) = rb0; *(uint4*)(bsw + 32 * LDT) = rb1; *(uint4*)(bsw + 64 * LDT) = rb2; *(uint4*)(bsw + 96 * LDT) = rb3;
    __syncthreads();
    if (kt + 1 < KT) {
      const bf16_t* a2 = ap + (kt + 1) * 64;
      const bf16_t* b2 = bp + (kt + 1) * 64;
      ra0 = *(const uint4*)(a2); ra1 = *(const uint4*)(a2 + sa); ra2 = *(const uint4*)(a2 + 2 * sa); ra3 = *(const uint4*)(a2 + 3 * sa);
      rb0 = *(const uint4*)(b2); rb1 = *(const uint4*)(b2 + sb); rb2 = *(const uint4*)(b2 + 2 * sb); rb3 = *(const uint4*)(b2 + 3 * sb);
    }
#pragma unroll
    for (int kk = 0; kk < 4; ++kk) {
      const bf16x8 af0 = *(const bf16x8*)(As + (wm * 64) * LDT + fr + kk * 16);
      const bf16x8 af1 = *(const bf16x8*)(As + (wm * 64 + 32) * LDT + fr + kk * 16);
      const bf16x8 bf0 = *(const bf16x8*)(Bs + (wn * 64) * LDT + fr + kk * 16);
      const bf16x8 bf1 = *(const bf16x8*)(Bs + (wn * 64 + 32) * LDT + fr + kk * 16);
      if (SWAP) {
        acc[0][0] = MFMA(bf0, af0, acc[0][0]); acc[0][1] = MFMA(bf1, af0, acc[0][1]);
        acc[1][0] = MFMA(bf0, af1, acc[1][0]); acc[1][1] = MFMA(bf1, af1, acc[1][1]);
      } else {
        acc[0][0] = MFMA(af0, bf0, acc[0][0]); acc[0][1] = MFMA(af0, bf1, acc[0][1]);
        acc[1][0] = MFMA(af1, bf0, acc[1][0]); acc[1][1] = MFMA(af1, bf1, acc[1][1]);
      }
    }
  }
}

template <bool SWAP, bool SB = true, class F>
DI void gemm_epilogue(const f32x16 (&acc)[2][2], F f) {
  const int lane = tidx() & 63, wave = tidx() >> 6;
  const int wm = wave >> 1, wn = wave & 1;
#pragma unroll
  for (int mi = 0; mi < 2; ++mi)
#pragma unroll
    for (int ni = 0; ni < 2; ++ni)
#pragma unroll
      for (int r = 0; r < 16; ++r) {
        const int i = (r & 3) + 8 * (r >> 2) + 4 * (lane >> 5);
        const int j = lane & 31;
        int m, n;
        if (!SWAP) { m = wm * 64 + mi * 32 + i; n = wn * 64 + ni * 32 + j; }
        else { n = wn * 64 + ni * 32 + i; m = wm * 64 + mi * 32 + j; }
        f(m, n, acc[mi][ni][r]);
        if (SB && (r & 3) == 3) __builtin_amdgcn_sched_barrier(0);
      }
}
template <class F>
DI void gemm_epilogue2(const f32x16 (&a0)[2][2], const f32x16 (&a1)[2][2], F f) {
  const int lane = tidx() & 63, wave = tidx() >> 6;
  const int wm = wave >> 1, wn = wave & 1;
#pragma unroll
  for (int mi = 0; mi < 2; ++mi)
#pragma unroll
    for (int ni = 0; ni < 2; ++ni)
#pragma unroll
      for (int r = 0; r < 16; ++r) {
        const int i = (r & 3) + 8 * (r >> 2) + 4 * (lane >> 5);
        const int j = lane & 31;
        f(wm * 64 + mi * 32 + i, wn * 64 + ni * 32 + j, a0[mi][ni][r], a1[mi][ni][r]);
      }
}

DI int tr_tiles(int job) {
  if (job < 2) return 384; if (job < 4) return 256; if (job < 6) return 736; if (job < 8) return 256;
  if (job < 12) return 512; if (job < 20) return 8; return 16;
}
DI void phase_prep(const Params& p, unsigned char* smem, int bid, int nb) {
  const int tid = tidx();
  constexpr int N_MOD = 384, N_TR = 768 + 512 + 1472 + 512 + 2048 + 32 + 32 + 32, N_FOLD = 256, N_GATE = 512, N_DFT = 16384 + 64;
  constexpr int TOTAL = N_MOD + N_TR + N_FOLD + N_GATE + N_DFT;
  unsigned char* ws = p.ws;
  for (int it = bid; it < TOTAL; it += nb) {
    if (it < N_MOD) {
      const int l = it / 96, cchunk = it % 96;
      float* sil = (float*)smem;
      float* red = sil + 5 * 1024;
      __syncthreads();
      for (int i = tid; i < 5120; i += NTHR) {
        int cv = i >> 10, k = i & 1023;
        float c = (cv == 0) ? p.in[I_CCTX][k] : p.in[I_C][(cv - 1) * 1024 + k];
        sil[i] = c * sigm(c);
      }
      __syncthreads();
      const int col = cchunk * 64 + (tid & 63), kg = tid >> 6;
      const float* w = p.in[I_WMOD] + (size_t)l * 1024 * 6144 + col;
      float a0 = 0.f, a1 = 0.f, a2 = 0.f, a3 = 0.f, a4 = 0.f;
#pragma unroll 8
      for (int k = kg * 256; k < kg * 256 + 256; ++k) {
        float wv = w[(size_t)k * 6144];
        a0 += sil[k] * wv; a1 += sil[1024 + k] * wv; a2 += sil[2048 + k] * wv; a3 += sil[3072 + k] * wv; a4 += sil[4096 + k] * wv;
      }
      const int c = tid & 63;
      red[(kg * 5 + 0) * 64 + c] = a0; red[(kg * 5 + 1) * 64 + c] = a1; red[(kg * 5 + 2) * 64 + c] = a2;
      red[(kg * 5 + 3) * 64 + c] = a3; red[(kg * 5 + 4) * 64 + c] = a4;
      __syncthreads();
      for (int i = tid; i < 320; i += NTHR) {
        int cv = i >> 6, cc = i & 63;
        float s = red[(0 * 5 + cv) * 64 + cc] + red[(1 * 5 + cv) * 64 + cc] + red[(2 * 5 + cv) * 64 + cc] + red[(3 * 5 + cv) * 64 + cc];
        s += p.in[I_BMOD][l * 6144 + cchunk * 64 + cc];
        ((float*)(ws + OFF_MOD))[(l * 5 + cv) * 6144 + cchunk * 64 + cc] = s;
      }
    } else if (it < N_MOD + N_TR) {
      int r = it - N_MOD, job = 0;
      for (job = 0; job < 22; ++job) { int nt = tr_tiles(job); if (r < nt) break; r -= nt; }
      const float* src; bf16_t* dst; int lds, ldd, N;
      if (job < 2) { src = p.in[I_WINE] + (size_t)job * 1024 * 2048 + 512; lds = 2048; N = 1536; dst = (bf16_t*)(ws + OFF_BT_IN_E) + (size_t)job * 2560 * 1024 + (size_t)1024 * 1024; ldd = 1024; }
      else if (job < 4) { int j = job - 2; src = p.in[I_WOUTE] + (size_t)j * 1024 * 1024; lds = 1024; N = 1024; dst = (bf16_t*)(ws + OFF_BT_OUT_E) + (size_t)j * 1024 * 1024; ldd = 1024; }
      else if (job < 6) { int j = job - 4; src = p.in[I_WINO] + (size_t)j * 1024 * 2944; lds = 2944; N = 2944; dst = (bf16_t*)(ws + OFF_BT_IN_O) + (size_t)j * 2944 * 1024; ldd = 1024; }
      else if (job < 8) { int j = job - 6; src = p.in[I_WOUTO] + (size_t)j * 1024 * 1024; lds = 1024; N = 1024; dst = (bf16_t*)(ws + OFF_BT_OUT_O) + (size_t)j * 1024 * 1024; ldd = 1024; }
      else if (job < 12) { int j = job - 8; src = p.in[I_WQ] + (size_t)j * 1024 * 2048; lds = 2048; N = 2048; dst = (bf16_t*)(ws + OFF_BT_WQ) + (size_t)j * 2048 * 1024; ldd = 1024; }
      else if (job < 16) { int j = job - 12; src = p.in[I_W2] + (size_t)j * 64 * 512; lds = 512; N = 512; dst = (bf16_t*)(ws + OFF_BT_W2) + (size_t)j * 512 * 64; ldd = 64; }
      else if (job < 20) { int j = job - 16; src = p.in[I_A2] + (size_t)j * 64 * 512; lds = 512; N = 512; dst = (bf16_t*)(ws + OFF_BT_A2) + (size_t)j * 512 * 64; ldd = 64; }
      else { int j = job - 20; src = p.in[I_G2] + (size_t)j * 128 * 512; lds = 512; N = 512; dst = (bf16_t*)(ws + OFF_BT_G2) + (size_t)j * 512 * 128; ldd = 128; }
      const int ntn = N / 64;
      const int k0 = (r / ntn) * 64, n0 = (r % ntn) * 64;
      float* tl = (float*)smem;
      __syncthreads();
#pragma unroll 4
      for (int ps = 0; ps < 16; ++ps) {
        int kr = ps * 4 + (tid >> 6), n = tid & 63;
        tl[kr * 65 + n] = src[(size_t)(k0 + kr) * lds + n0 + n];
      }
      __syncthreads();
#pragma unroll 4
      for (int ps = 0; ps < 8; ++ps) {
        int nr = ps * 8 + (tid >> 5), k2 = tid & 31;
        unsigned v = pack2(tl[(2 * k2) * 65 + nr], tl[(2 * k2 + 1) * 65 + nr]);
        *(unsigned*)(dst + (size_t)(n0 + nr) * ldd + k0 + 2 * k2) = v;
      }
    } else if (it < N_MOD + N_TR + N_FOLD) {
      int r = it - N_MOD - N_TR;
      const int j = r >> 7, rr = r & 127, which = rr >> 6, g = (rr >> 4) & 3, kt = rr & 15;
      const int k0 = kt * 64;
      float* Wl = (float*)smem;
      float* tab = Wl + 64 * 129;
      __syncthreads();
      if (tid < 128) { float fr = (float)tid * (1.f / 128.f); tab[tid] = which ? __builtin_amdgcn_sinf(fr) : __builtin_amdgcn_cosf(fr); }
      for (int ps = 0; ps < 32; ++ps) {
        int kr = ps * 2 + (tid >> 7), c = tid & 127;
        Wl[kr * 129 + c] = p.in[I_WINE][(size_t)j * 1024 * 2048 + (size_t)(k0 + kr) * 2048 + g * 128 + c];
      }
      __syncthreads();
      const int k = tid & 63, nq = tid >> 6;
      bf16_t* dst = (bf16_t*)(ws + OFF_BT_IN_E) + (size_t)j * 2560 * 1024;
      for (int i = 0; i < 32; ++i) {
        const int np = nq * 32 + i;
        float s = 0.f;
#pragma unroll 8
        for (int c = 0; c < 128; ++c) s += Wl[k * 129 + c] * tab[(c * np) & 127];
        dst[(size_t)(which * 512 + g * 128 + np) * 1024 + k0 + k] = (bf16_t)f2bf(s);
      }
    } else if (it < N_MOD + N_TR + N_FOLD + N_GATE) {
      int r = it - N_MOD - N_TR - N_FOLD;
      bf16_t* dst = (bf16_t*)(ws + OFF_BT_GATE);
      for (int e = 0; e < 4; ++e) {
        int idx = r * 1024 + e * 256 + tid;
        int kp = idx & 127, n = (idx >> 7) & 511, gate = (idx >> 16) & 1, d = (idx >> 17) & 1, j = idx >> 18;
        int h = n >> 6;
        float v = 0.f;
        if ((kp >> 6) == (h & 1)) {
          const float* W = gate ? p.in[I_LWX] : p.in[I_LWA];
          v = W[((((size_t)(j * 2 + d) * 8 + h) * 64 + (kp & 63)) * 64) + (n & 63)];
        }
        dst[idx] = (bf16_t)f2bf(v);
      }
    } else {
      int r = it - N_MOD - N_TR - N_FOLD - N_GATE;
      int S, K2; bf16_t* dst; size_t idx;
      if (r < 16384) { S = 4096; K2 = 8192; dst = (bf16_t*)(ws + OFF_D4096); idx = (size_t)r * 2048 + tid * 8; }
      else { S = 256; K2 = 512; dst = (bf16_t*)(ws + OFF_D256); idx = (size_t)(r - 16384) * 2048 + tid * 8; }
      const int row = (int)(idx / K2), kb = (int)(idx % K2);
      const float invS = 1.f / (float)S;
      float v[8];
#pragma unroll
      for (int e = 0; e < 8; ++e) {
        int k = kb + e;
        if (k < S) { int m = (row * k) & (S - 1); v[e] = __builtin_amdgcn_cosf((float)m * invS); }
        else { int m = (row * (k - S)) & (S - 1); v[e] = -__builtin_amdgcn_sinf((float)m * invS); }
      }
      *(uint4*)(dst + idx) = pack8(v);
    }
  }
}

DI void mod_store_h(const Params& p, int t, int lane, int cv, int l, int off_scale, int off_shift, float (&y)[16]) {
  const float* mod = (const float*)(p.ws + OFF_MOD) + (size_t)(l * 5 + cv) * 6144;
  float sc[16], sh[16];
  load_row(mod + off_scale * 1024, lane, sc);
  load_row(mod + off_shift * 1024, lane, sh);
#pragma unroll
  for (int i = 0; i < 16; ++i) y[i] = y[i] * (1.f + sc[i]) + sh[i];
  store_row_bf((bf16_t*)(p.ws + OFF_H) + (size_t)t * 1024, lane, y);
}

DI float pos_embed(int n, int c) {
  int pos = (c < 512) ? (n >> 6) : (n & 63);
  int cc = c & 511, i = cc & 255;
  float om = exp2f(-(float)i * (13.287712379549449f / 256.f));
  float rev = (float)pos * om * 0.15915494309189535f;
  return cc < 256 ? __builtin_amdgcn_sinf(rev) : __builtin_amdgcn_cosf(rev);
}

DI void phase_init(const Params& p, int bid, int nb) {
  const int lane = tidx() & 63, wave = tidx() >> 6;
  float sc[16], sh[16];
  int cvl = -1;
  for (int t = bid * 4 + wave; t < T; t += nb * 4) {
    int seq, s, S, cv; tok_info(t, seq, s, S, cv);
    if (cv != cvl) {
      const float* mod = (const float*)(p.ws + OFF_MOD) + (size_t)cv * 6144;
      load_row(mod + 1024, lane, sc); load_row(mod, lane, sh);
      cvl = cv;
    }
    float y[16];
    const float* src = (t < 4096) ? p.in[I_XP] + (size_t)t * 1024 : p.in[I_XS] + (size_t)(t - 4096) * 1024;
    load_row(src, lane, y);
    if (t >= 4096) {
#pragma unroll
      for (int i = 0; i < 16; ++i) { int c = (i < 8) ? lane * 8 + i : 512 + lane * 8 + (i - 8); y[i] += pos_embed(s, c); }
    }
    store_row((float*)(p.ws + OFF_X) + (size_t)t * 1024, lane, y);
    ln16(y);
#pragma unroll
    for (int i = 0; i < 16; ++i) y[i] = y[i] * (1.f + sc[i]) + sh[i];
    store_row_bf((bf16_t*)(p.ws + OFF_H) + (size_t)t * 1024, lane, y);
  }
}

constexpr float U_SCALE = 32.f;
DI void convert_tables(const Params& p, int l, int bid, int nb) {
  const size_t n16 = (size_t)16384 * 1024 / 16;
  for (int tb = 0; tb < 2; ++tb) {
    const float* src = p.in[tb ? I_PV : I_PU] + (size_t)l * 16384 * 1024;
    uint4* dst = (uint4*)(p.ws + (tb ? OFF_TABV : OFF_TABU));
    const float sc = tb ? 1.f : U_SCALE;
    for (size_t i = (size_t)bid * NTHR + tidx(); i < n16; i += (size_t)nb * NTHR) {
      const float4* s4 = (const float4*)(src + i * 16);
      float4 a = s4[0], b = s4[1], c = s4[2], d = s4[3];
      uint4 o;
      o.x = pk_fp8x4(a.x * sc, a.y * sc, a.z * sc, a.w * sc); o.y = pk_fp8x4(b.x * sc, b.y * sc, b.z * sc, b.w * sc);
      o.z = pk_fp8x4(c.x * sc, c.y * sc, c.z * sc, c.w * sc); o.w = pk_fp8x4(d.x * sc, d.y * sc, d.z * sc, d.w * sc);
      dst[i] = o;
    }
  }
}

DI void phase_e1(const Params& p, unsigned char* smem, int l, int bid, int nb) {
  const int j = l >> 1;
  bf16_t* As = (bf16_t*)smem; bf16_t* Bs = As + 128 * LDT;
  const bf16_t* H = (const bf16_t*)(p.ws + OFF_H);
  const bf16_t* Bt = (const bf16_t*)(p.ws + OFF_BT_IN_E) + (size_t)j * 2560 * 1024;
  bf16_t* PQT = (bf16_t*)(p.ws + OFF_Z);
  bf16_t* ZC = (bf16_t*)(p.ws + OFF_Z + 40 * MiB);
  for (int it = bid; it < 160 * 20; it += nb) {
    const int mt = it / 20, nt = it % 20, t0 = mt * 128;
    f32x16 acc[2][2];
    if (nt < 8) {
      gemm_mainloop<true>(H + (size_t)t0 * 1024, 1024, Bt + (size_t)nt * 128 * 1024, 1024, 1024, acc, As, Bs);
      int seq, s0, S, cv; tok_info(t0, seq, s0, S, cv);
      bf16_t* base = PQT + pqt_base(seq);
      const int S2 = 2 * S;
      gemm_epilogue<true>(acc, [&](int m, int n, float v) {
        int ng = nt * 128 + n; int which = ng >> 9, ch = ng & 511;
        base[(size_t)ch * S2 + which * S + s0 + m] = (bf16_t)f2bf(v);
      });
    } else {
      gemm_mainloop<false>(H + (size_t)t0 * 1024, 1024, Bt + (size_t)nt * 128 * 1024, 1024, 1024, acc, As, Bs);
      gemm_epilogue<false>(acc, [&](int m, int n, float v) {
        ZC[(size_t)(t0 + m) * 1536 + (nt - 8) * 128 + n] = (bf16_t)f2bf(v);
      });
    }
  }
  convert_tables(p, l, bid, nb);
}

DI void phase_e2(const Params& p, unsigned char* smem, int l, int bid, int nb) {
  const int j = l >> 1;
  bf16_t* As = (bf16_t*)smem; bf16_t* Bs = As + 128 * LDT;
  const bf16_t* PQT = (const bf16_t*)(p.ws + OFF_Z);
  const bf16_t* ZC = (const bf16_t*)(p.ws + OFF_Z + 40 * MiB);
  bf16_t* YM = (bf16_t*)(p.ws + OFF_YMIX);
  for (int it = bid; it < 640 + 1280; it += nb) {
    if (it < 640) {
      int seq, mt, nt, S, t0; const bf16_t* A;
      if (it < 512) { seq = 16 + it / 128; int r = it % 128; mt = r >> 2; nt = r & 3; S = 4096; A = (const bf16_t*)(p.ws + OFF_D4096) + (size_t)mt * 128 * 8192; t0 = 4096 + (seq - 16) * 4096 + mt * 128; }
      else { int r = it - 512; seq = r >> 3; mt = (r & 7) >> 2; nt = r & 3; S = 256; A = (const bf16_t*)(p.ws + OFF_D256) + (size_t)mt * 128 * 512; t0 = seq * 256 + mt * 128; }
      const bf16_t* B = PQT + pqt_base(seq) + (size_t)nt * 128 * (2 * S);
      f32x16 acc[2][2];
      gemm_mainloop<false>(A, 2 * S, B, 2 * S, 2 * S, acc, As, Bs);
      const float scale = rsqrtf(128.f * (float)S);
      gemm_epilogue<false>(acc, [&](int m, int n, float v) {
        YM[(size_t)(t0 + m) * 1024 + nt * 128 + n] = (bf16_t)f2bf(v * scale);
      });
    } else {
      const int t0 = (it - 640) * 16, c = tidx() * 2;
      int seq, s0, S, cv; tok_info(t0, seq, s0, S, cv);
      const float* cw = p.in[I_SCW] + (size_t)j * 3 * 512;
      const float w0a = cw[c], w0b = cw[c + 1], w1a = cw[512 + c], w1b = cw[512 + c + 1], w2a = cw[1024 + c], w2b = cw[1024 + c + 1];
      const float ba = p.in[I_SCB][j * 512 + c], bb = p.in[I_SCB][j * 512 + c + 1];
      auto uval = [&](int t, float& ua, float& ub) {
        unsigned cg_ = *(const unsigned*)(ZC + (size_t)t * 1536 + 512 + c);
        unsigned xi = *(const unsigned*)(ZC + (size_t)t * 1536 + 1024 + c);
        ua = bflo(cg_) * bflo(xi); ub = bfhi(cg_) * bfhi(xi);
      };
      float pa = 0.f, pb = 0.f, ca, cb, na, nb_;
      if (s0 > 0) uval(t0 - 1, pa, pb);
      uval(t0, ca, cb);
      for (int i = 0; i < 16; ++i) {
        const int t = t0 + i;
        na = 0.f; nb_ = 0.f;
        if (s0 + i + 1 < S) uval(t + 1, na, nb_);
        unsigned bg = *(const unsigned*)(ZC + (size_t)t * 1536 + c);
        float ya = bflo(bg) * (w0a * pa + w1a * ca + w2a * na + ba);
        float yb = bfhi(bg) * (w0b * pb + w1b * cb + w2b * nb_ + bb);
        *(unsigned*)(YM + (size_t)t * 1024 + 512 + c) = pack2(ya, yb);
        pa = ca; pb = cb; ca = na; cb = nb_;
      }
    }
  }
}

DI void phase_outgemm(const Params& p, unsigned char* smem, const bf16_t* Bt, int bid, int nb) {
  bf16_t* As = (bf16_t*)smem; bf16_t* Bs = As + 128 * LDT;
  const bf16_t* YM = (const bf16_t*)(p.ws + OFF_YMIX);
  float* MIX = (float*)(p.ws + OFF_MIX);
  for (int it = bid; it < 160 * 8; it += nb) {
    const int mt = it >> 3, nt = it & 7, t0 = mt * 128;
    f32x16 acc[2][2];
    gemm_mainloop<false>(YM + (size_t)t0 * 1024, 1024, Bt + (size_t)nt * 128 * 1024, 1024, 1024, acc, As, Bs);
    gemm_epilogue<false>(acc, [&](int m, int n, float v) { MIX[(size_t)(t0 + m) * 1024 + nt * 128 + n] = v; });
  }
}

DI void phase_res1(const Params& p, int l, int bid, int nb) {
  const int lane = tidx() & 63, wave = tidx() >> 6;
  float* X = (float*)(p.ws + OFF_X);
  const float* MIX = (const float*)(p.ws + OFF_MIX);
  float lg[16], lb[16], g1[16], sc[16], sh[16];
  load_row(p.in[I_LN1G] + l * 1024, lane, lg);
  load_row(p.in[I_LN1B] + l * 1024, lane, lb);
  int cvl = -1;
  for (int t = bid * 4 + wave; t < T; t += nb * 4) {
    int seq, s, S, cv; tok_info(t, seq, s, S, cv);
    if (cv != cvl) {
      const float* mod = (const float*)(p.ws + OFF_MOD) + (size_t)(l * 5 + cv) * 6144;
      load_row(mod + 2 * 1024, lane, g1); load_row(mod + 4 * 1024, lane, sc); load_row(mod + 3 * 1024, lane, sh);
      cvl = cv;
    }
    float x[16], m[16];
    load_row(X + (size_t)t * 1024, lane, x);
    load_row(MIX + (size_t)t * 1024, lane, m);
#pragma unroll
    for (int i = 0; i < 16; ++i) x[i] = ALPHA_F * x[i] + g1[i] * m[i];
    ln16(x);
#pragma unroll
    for (int i = 0; i < 16; ++i) x[i] = x[i] * lg[i] + lb[i];
    store_row(X + (size_t)t * 1024, lane, x);
    ln16(x);
#pragma unroll
    for (int i = 0; i < 16; ++i) x[i] = x[i] * (1.f + sc[i]) + sh[i];
    store_row_bf((bf16_t*)(p.ws + OFF_H) + (size_t)t * 1024, lane, x);
  }
}

DI void insert16(float (&tv)[16], int (&ti)[16], float x, int xi) {
#pragma unroll
  for (int k = 0; k < 16; ++k) {
    bool gt = x > tv[k];
    float ov = tv[k]; int oi = ti[k];
    tv[k] = gt ? x : ov; ti[k] = gt ? xi : oi;
    x = gt ? ov : x; xi = gt ? oi : xi;
  }
}
DI void phase_p1(const Params& p, unsigned char* smem, int l, int bid, int nb) {
  const int tid = tidx(), lane = tid & 63, wave = tid >> 6;
  const int wm = wave >> 1, wn = wave & 1;
  bf16_t* As = (bf16_t*)smem; bf16_t* Bs = As + 128 * LDT;
  bf16_t* Qs = (bf16_t*)smem;
  bf16_t* Ks = (bf16_t*)(smem + 36864);
  float* Sc = (float*)smem;
  float* Lv = (float*)smem;
  int* Li = (int*)(smem + 8192);
  const bf16_t* H = (const bf16_t*)(p.ws + OFF_H);
  const bf16_t* Bt = (const bf16_t*)(p.ws + OFF_BT_WQ) + (size_t)l * 2048 * 1024;
  float* TKV = (float*)(p.ws + OFF_WD);
  int* TKI = (int*)(p.ws + OFF_WD + 20 * MiB);
  for (int it = bid; it < 160 * 16; it += nb) {
    const int mt = it >> 4, hp = it & 15, t0 = mt * 128;
    f32x16 acc[2][2];
    gemm_mainloop<false>(H + (size_t)t0 * 1024, 1024, Bt + (size_t)hp * 128 * 1024, 1024, 1024, acc, As, Bs);
    {
      const float* kp = p.in[I_KEYS] + (size_t)(l * 16 + hp) * 16384;
#pragma unroll 4
      for (int i = 0; i < 16; ++i) {
        int idx = i * 256 + tid;
        int row = idx >> 5, c4 = idx & 31;
        float4 v = *(const float4*)(kp + row * 128 + c4 * 4);
        uint2 u; u.x = pack2(v.x, v.y); u.y = pack2(v.z, v.w);
        *(uint2*)(Ks + row * 136 + c4 * 4) = u;
      }
    }
    __syncthreads();
    gemm_epilogue<false>(acc, [&](int m, int n, float v) { Qs[m * 136 + n] = (bf16_t)f2bf(v); });
    __syncthreads();
#pragma unroll
    for (int mi = 0; mi < 2; ++mi)
#pragma unroll
      for (int ni = 0; ni < 2; ++ni)
#pragma unroll
        for (int r = 0; r < 16; ++r) acc[mi][ni][r] = 0.f;
    {
      const int fr = (lane & 31) * 136 + (lane >> 5) * 8;
#pragma unroll
      for (int kk = 0; kk < 8; ++kk) {
        bf16x8 af[2], bfr[2];
#pragma unroll
        for (int mi = 0; mi < 2; ++mi) af[mi] = *(const bf16x8*)(Qs + (wm * 64 + mi * 32) * 136 + fr + kk * 16);
#pragma unroll
        for (int ni = 0; ni < 2; ++ni) bfr[ni] = *(const bf16x8*)(Ks + (wn * 64 + ni * 32) * 136 + fr + kk * 16);
#pragma unroll
        for (int mi = 0; mi < 2; ++mi)
#pragma unroll
          for (int ni = 0; ni < 2; ++ni) acc[mi][ni] = MFMA(af[mi], bfr[ni], acc[mi][ni]);
      }
    }
    __syncthreads();
    gemm_epilogue<false>(acc, [&](int m, int n, float v) { Sc[m * 129 + n] = v; });
    __syncthreads();
    const int row = tid & 127, half = tid >> 7;
    float tv[16];
#pragma unroll
    for (int k = 0; k < 16; ++k) tv[k] = -3.0e38f;
    for (int e = 0; e < 64; ++e) {
      float x = __uint_as_float((__float_as_uint(Sc[row * 129 + half * 64 + e]) & ~127u) | (unsigned)(half * 64 + e));
#pragma unroll
      for (int k = 0; k < 16; ++k) { float hi = fmaxf(tv[k], x); x = fminf(tv[k], x); tv[k] = hi; }
    }
    __syncthreads();
    if (half == 1) {
#pragma unroll
      for (int k = 0; k < 16; ++k) Lv[k * 128 + row] = tv[k];
    }
    __syncthreads();
    if (half == 0) {
#pragma unroll
      for (int k2 = 0; k2 < 16; ++k2) {
        float x = Lv[k2 * 128 + row];
#pragma unroll
        for (int k = 0; k < 16; ++k) { float hi = fmaxf(tv[k], x); x = fminf(tv[k], x); tv[k] = hi; }
      }
      float* ov = TKV + ((size_t)(t0 + row) * 16 + hp) * 16;
      int* oi = TKI + ((size_t)(t0 + row) * 16 + hp) * 16;
#pragma unroll
      for (int k = 0; k < 16; k += 4) {
        *(float4*)(ov + k) = make_float4(__uint_as_float(__float_as_uint(tv[k]) & ~127u), __uint_as_float(__float_as_uint(tv[k + 1]) & ~127u),
                                         __uint_as_float(__float_as_uint(tv[k + 2]) & ~127u), __uint_as_float(__float_as_uint(tv[k + 3]) & ~127u));
        *(int4*)(oi + k) = make_int4((int)(__float_as_uint(tv[k]) & 127u), (int)(__float_as_uint(tv[k + 1]) & 127u),
                                     (int)(__float_as_uint(tv[k + 2]) & 127u), (int)(__float_as_uint(tv[k + 3]) & 127u));
      }
    }
  }
}

DI void phase_p2(const Params& p, unsigned char* smem, int l, int bid, int nb) {
  const int lane = tidx() & 63, wave = tidx() >> 6;
  int* sIdx = (int*)(smem + wave * 1024);
  float* sSc = (float*)(smem + wave * 1024 + 512);
  const bf16_t* H = (const bf16_t*)(p.ws + OFF_H);
  const float* TKV = (const float*)(p.ws + OFF_WD);
  const int* TKI = (const int*)(p.ws + OFF_WD + 20 * MiB);
  const bf16_t* TU = (const bf16_t*)(p.ws + OFF_TABU);
  const bf16_t* TV = (const bf16_t*)(p.ws + OFF_TABV);
  float* X = (float*)(p.ws + OFF_X);
  int ci = 0, cj = 0;
  {
    int q = lane;
    if (q < 16) { ci = 0; cj = q; } else if (q < 24) { ci = 1; cj = q - 16; } else if (q < 29) { ci = 2; cj = q - 24; }
    else if (q < 33) { ci = 3; cj = q - 29; } else if (q < 36) { ci = 4; cj = q - 33; }
    else if (q < 42) { ci = 5 + ((q - 36) >> 1); cj = (q - 36) & 1; } else if (q < 50) { ci = 8 + (q - 42); cj = 0; }
  }
  float plg[16], plb[16], pg2[16];
  load_row16(p.in[I_LN2G] + l * 1024, lane, plg);
  load_row16(p.in[I_LN2B] + l * 1024, lane, plb);
  int cvl = -1;
  for (int t = bid * 4 + wave; t < T; t += nb * 4) {
    int seq, s, S, cv; tok_info(t, seq, s, S, cv);
    float hreg[16];
    {
      const uint4* hp_ = (const uint4*)(H + (size_t)t * 1024 + lane * 16);
      uint4 a = hp_[0], b = hp_[1];
      float v0[8], v1[8]; unpack8(a, v0); unpack8(b, v1);
#pragma unroll
      for (int i = 0; i < 8; ++i) { hreg[i] = v0[i]; hreg[8 + i] = v1[i]; }
    }
    __builtin_amdgcn_wave_barrier();
    for (int h = 0; h < 8; ++h) {
      const float* v1p = TKV + ((size_t)t * 16 + h * 2) * 16;
      const int* i1p = TKI + ((size_t)t * 16 + h * 2) * 16;
      float c = -3.0e38f; int eidx = 0;
      if (lane < 50) { c = v1p[ci] + v1p[16 + cj]; eidx = i1p[ci] * 128 + i1p[16 + cj]; }
      c = __uint_as_float((__float_as_uint(c) & ~63u) | (unsigned)lane);
      int rank = 0;
#pragma unroll 10
      for (int m = 0; m < 50; ++m) {
        float cm = __int_as_float(__builtin_amdgcn_readlane(__float_as_int(c), m));
        rank += (cm > c) ? 1 : 0;
      }
      if (lane < 50 && rank < 16) { sIdx[h * 16 + rank] = eidx; sSc[h * 16 + rank] = c; }
    }
    __builtin_amdgcn_wave_barrier();
    {
      float s0 = sSc[lane], s1 = sSc[64 + lane];
      float m0 = max16(s0), m1 = max16(s1);
      float e0 = __expf(s0 - m0), e1 = __expf(s1 - m1);
      float d0 = sum16(e0), d1 = sum16(e1);
      __builtin_amdgcn_wave_barrier();
      sSc[lane] = e0 / d0; sSc[64 + lane] = e1 / d1;
    }
    __builtin_amdgcn_wave_barrier();
    v2f_t o2[8], h2[8];
#pragma unroll
    for (int i = 0; i < 8; ++i) { o2[i].x = 0.f; o2[i].y = 0.f; h2[i].x = hreg[2 * i]; h2[i].y = hreg[2 * i + 1]; }
    const unsigned char* TU8 = (const unsigned char*)TU;
    const unsigned char* TV8 = (const unsigned char*)TV;
    for (int sb = 0; sb < 128; sb += 8) {
      uint4 u[8], w[8]; float gt[8];
#pragma unroll
      for (int k = 0; k < 8; ++k) {
        int e = __builtin_amdgcn_readfirstlane(sIdx[sb + k]);
        gt[k] = sSc[sb + k];
        u[k] = *(const uint4*)(TU8 + (size_t)e * 1024 + lane * 16);
        w[k] = *(const uint4*)(TV8 + (size_t)e * 1024 + lane * 16);
      }
      float dot[8];
#pragma unroll
      for (int k = 0; k < 8; ++k) {
        v2f_t a[8]; unpack_fp8x16_v2(u[k], a);
        v2f_t d2 = h2[0] * a[0];
#pragma unroll
        for (int i = 1; i < 8; ++i) d2 = h2[i] * a[i] + d2;
        dot[k] = d2.x + d2.y;
      }
#pragma unroll
      for (int k = 0; k < 8; ++k) dot[k] += dpp_mov<0xB1>(dot[k]);
#pragma unroll
      for (int k = 0; k < 8; ++k) dot[k] += dpp_mov<0x4E>(dot[k]);
#pragma unroll
      for (int k = 0; k < 8; ++k) dot[k] += dpp_mov<0x141>(dot[k]);
#pragma unroll
      for (int k = 0; k < 8; ++k) dot[k] += dpp_mov<0x140>(dot[k]);
#pragma unroll
      for (int k = 0; k < 8; ++k) dot[k] = (rdlane(dot[k], 0) + rdlane(dot[k], 16)) + (rdlane(dot[k], 32) + rdlane(dot[k], 48));
#pragma unroll
      for (int k = 0; k < 8; ++k) {
        const float wgt = gt[k] * gelu_t(dot[k] * (1.f / U_SCALE));
        v2f_t a[8]; unpack_fp8x16_v2(w[k], a);
        v2f_t w2; w2.x = wgt; w2.y = wgt;
#pragma unroll
        for (int i = 0; i < 8; ++i) o2[i] = w2 * a[i] + o2[i];
      }
    }
    float out[16];
#pragma unroll
    for (int i = 0; i < 8; ++i) { out[2 * i] = o2[i].x; out[2 * i + 1] = o2[i].y; }
    if (cv != cvl) {
      const float* mod = (const float*)(p.ws + OFF_MOD) + (size_t)(l * 5 + cv) * 6144;
      load_row16(mod + 5 * 1024, lane, pg2);
      cvl = cv;
    }
    float x[16];
    load_row16(X + (size_t)t * 1024, lane, x);
#pragma unroll
    for (int i = 0; i < 16; ++i) x[i] = ALPHA_F * x[i] + pg2[i] * out[i];
    ln16(x);
#pragma unroll
    for (int i = 0; i < 16; ++i) x[i] = x[i] * plg[i] + plb[i];
    if (l == 3) {
      store_row16(p.out + (size_t)t * 1024, lane, x);
    } else {
      store_row16(X + (size_t)t * 1024, lane, x);
      ln16(x);
      {
        float psc[16], psh[16];
        const float* modn = (const float*)(p.ws + OFF_MOD) + (size_t)((l + 1) * 5 + cv) * 6144;
        load_row16(modn + 1024, lane, psc); load_row16(modn, lane, psh);
#pragma unroll
        for (int i = 0; i < 16; ++i) x[i] = x[i] * (1.f + psc[i]) + psh[i];
      }
      store_row16_bf((bf16_t*)(p.ws + OFF_H) + (size_t)t * 1024, lane, x);
    }
  }
}

DI void phase_o1(const Params& p, unsigned char* smem, int l, int bid, int nb) {
  const int j = l >> 1;
  bf16_t* As = (bf16_t*)smem; bf16_t* Bs = As + 128 * LDT;
  const bf16_t* H = (const bf16_t*)(p.ws + OFF_H);
  const bf16_t* Bt = (const bf16_t*)(p.ws + OFF_BT_IN_O) + (size_t)j * 2944 * 1024;
  bf16_t* Z = (bf16_t*)(p.ws + OFF_Z);
  for (int it = bid; it < 160 * 23; it += nb) {
    const int mt = it / 23, nt = it % 23, t0 = mt * 128;
    f32x16 acc[2][2];
    gemm_mainloop<false>(H + (size_t)t0 * 1024, 1024, Bt + (size_t)nt * 128 * 1024, 1024, 1024, acc, As, Bs);
    gemm_epilogue<false>(acc, [&](int m, int n, float v) { Z[(size_t)(t0 + m) * 2944 + nt * 128 + n] = (bf16_t)f2bf(v); });
  }
  convert_tables(p, l, bid, nb);
}

DI void phase_o2(const Params& p, int l, int bid, int nb) {
  const int j = l >> 1;
  const int lane = tidx() & 63, wave = tidx() >> 6;
  const bf16_t* Z = (const bf16_t*)(p.ws + OFF_Z);
  bf16_t* XC = (bf16_t*)(p.ws + OFF_XC);
  bf16_t* LRIN = (bf16_t*)(p.ws + OFF_LRIN);
  bf16_t* KKN = (bf16_t*)(p.ws + OFF_KKN);
  bf16_t* KS = (bf16_t*)(p.ws + OFF_KS);
  bf16_t* RS = (bf16_t*)(p.ws + OFF_RS);
  bf16_t* VS = (bf16_t*)(p.ws + OFF_VS);
  const float* mu = p.in[I_MU] + (size_t)j * 1920;
  const int c0 = lane * 8;
  for (int t = bid * 4 + wave; t < T; t += nb * 4) {
    int seq, s, S, cv; tok_info(t, seq, s, S, cv);
    const bf16_t* zr = Z + (size_t)t * 2944;
    {
      float af[8], ab[8];
      load8f(p.in[I_LCB] + (size_t)(j * 2 + 0) * 512 + c0, af);
      load8f(p.in[I_LCB] + (size_t)(j * 2 + 1) * 512 + c0, ab);
#pragma unroll
      for (int o = -3; o <= 3; ++o) {
        float xv[8];
        if (s + o >= 0 && s + o < S) { uint4 u = *(const uint4*)(zr + (ptrdiff_t)o * 2944 + c0); unpack8(u, xv); }
        else {
#pragma unroll
          for (int i = 0; i < 8; ++i) xv[i] = 0.f;
        }
        if (o <= 0) {
          float w[8]; load8f(p.in[I_LCW] + ((size_t)(j * 2 + 0) * 4 + (o + 3)) * 512 + c0, w);
#pragma unroll
          for (int i = 0; i < 8; ++i) af[i] += w[i] * xv[i];
        }
        if (o >= 0) {
          float w[8]; load8f(p.in[I_LCW] + ((size_t)(j * 2 + 1) * 4 + (3 - o)) * 512 + c0, w);
#pragma unroll
          for (int i = 0; i < 8; ++i) ab[i] += w[i] * xv[i];
        }
      }
      *(uint4*)(XC + (size_t)t * 512 + c0) = pack8(af);
      *(uint4*)(XC + (size_t)T * 512 + (size_t)t * 512 + c0) = pack8(ab);
    }
    const bool hp_ = s > 0, hn = s < S - 1;
#pragma unroll
    for (int part = 0; part < 3; ++part) {
      const int col = 1024 + part * 512 + c0;
      float zc[8], zp[8], zn[8], m[8], zs[8];
      unpack8(*(const uint4*)(zr + col), zc);
      if (hp_) unpack8(*(const uint4*)(zr - 2944 + col), zp); else {
#pragma unroll
        for (int i = 0; i < 8; ++i) zp[i] = 0.f;
      }
      if (hn) unpack8(*(const uint4*)(zr + 2944 + col), zn); else {
#pragma unroll
        for (int i = 0; i < 8; ++i) zn[i] = 0.f;
      }
      load8f(mu + (col - 1024), m);
#pragma unroll
      for (int i = 0; i < 8; ++i) zs[i] = zc[i] + m[i] * (0.5f * (zp[i] + zn[i]) - zc[i]);
      if (part == 0) *(uint4*)(RS + (size_t)t * 512 + c0) = pack8(zs);
      else if (part == 2) *(uint4*)(VS + (size_t)t * 512 + c0) = pack8(zs);
      else {
        *(uint4*)(KS + (size_t)t * 512 + c0) = pack8(zs);
#pragma unroll
        for (int d = 0; d < 2; ++d) {
          float kk[8], raw[8]; load8f(p.in[I_KK] + (size_t)(j * 2 + d) * 512 + c0, kk);
          float ss = 0.f;
#pragma unroll
          for (int i = 0; i < 8; ++i) { raw[i] = zs[i] * kk[i]; ss += raw[i] * raw[i]; }
          ss = sum8(ss);
          float inv = rsqrtf(fmaxf(ss, 1e-24f));
#pragma unroll
          for (int i = 0; i < 8; ++i) raw[i] *= inv;
          *(uint4*)(KKN + (size_t)d * T * 512 + (size_t)t * 512 + c0) = pack8(raw);
        }
      }
    }
    if (lane < 48) {
      const int col = 2560 + c0;
      float zc[8], zp[8], zn[8], m[8], zs[8];
      unpack8(*(const uint4*)(zr + col), zc);
      if (hp_) unpack8(*(const uint4*)(zr - 2944 + col), zp); else {
#pragma unroll
        for (int i = 0; i < 8; ++i) zp[i] = 0.f;
      }
      if (hn) unpack8(*(const uint4*)(zr + 2944 + col), zn); else {
#pragma unroll
        for (int i = 0; i < 8; ++i) zn[i] = 0.f;
      }
      load8f(mu + (col - 1024), m);
#pragma unroll
      for (int i = 0; i < 8; ++i) {
        float z = zc[i] + m[i] * (0.5f * (zp[i] + zn[i]) - zc[i]);
        zs[i] = (lane < 16) ? tanh_f(z) : ((lane < 32) ? z : sigm(z));
      }
      *(uint4*)(LRIN + (size_t)t * 384 + c0) = pack8(zs);
    }
  }
}

DI void store8f(float* p, const float (&v)[8]) {
  ((float4*)p)[0] = make_float4(v[0], v[1], v[2], v[3]);
  ((float4*)p)[1] = make_float4(v[4], v[5], v[6], v[7]);
}
template <class F>
DI void staged_epilogue(const f32x16 (&acc)[2][2], float* Cs, F f) {
  __syncthreads();
  gemm_epilogue<false, false>(acc, [&](int m, int n, float v) { Cs[m * 132 + n] = v; });
  __syncthreads();
  const int tid = tidx(), r0 = tid >> 4, c8 = (tid & 15) * 8;
#pragma unroll 2
  for (int ps = 0; ps < 8; ++ps) {
    const int row = ps * 16 + r0;
    float v[8];
    load8f(Cs + row * 132 + c8, v);
    f(row, c8, v);
  }
}

DI void phase_o3(const Params& p, unsigned char* smem, int l, int bid, int nb) {
  const int j = l >> 1;
  bf16_t* As = (bf16_t*)smem; bf16_t* Bs = As + 128 * LDT;
  float* Cs = (float*)smem;
  const bf16_t* __restrict__ XC = (const bf16_t*)(p.ws + OFF_XC);
  const bf16_t* __restrict__ LRIN = (const bf16_t*)(p.ws + OFF_LRIN);
  const bf16_t* __restrict__ KKN = (const bf16_t*)(p.ws + OFF_KKN);
  const bf16_t* __restrict__ KS = (const bf16_t*)(p.ws + OFF_KS);
  float* __restrict__ LA = (float*)(p.ws + OFF_MIX);
  bf16_t* __restrict__ LB = (bf16_t*)(p.ws + OFF_LB);
  float* __restrict__ WD = (float*)(p.ws + OFF_WD);
  bf16_t* __restrict__ KKA = (bf16_t*)(p.ws + OFF_KKA);
  bf16_t* __restrict__ KM = (bf16_t*)(p.ws + OFF_KM);
  bf16_t* __restrict__ G = (bf16_t*)(p.ws + OFF_G);
  const int c8 = (tidx() & 15) * 8;
  for (int it = bid; it < 160 * 28; it += nb) {
    const int mt = it / 28, jb = it % 28, t0 = mt * 128;
    if (jb < 8) {
      const int d = jb >> 2, nt = jb & 3, ng = nt * 128 + c8;
      const bf16_t* A = XC + (size_t)d * T * 512 + (size_t)t0 * 512 + nt * 128;
      const bf16_t* Br = (const bf16_t*)(p.ws + OFF_BT_GATE) + ((size_t)((j * 2 + d) * 2 + 0) * 512 + nt * 128) * 128;
      const bf16_t* Bi = (const bf16_t*)(p.ws + OFF_BT_GATE) + ((size_t)((j * 2 + d) * 2 + 1) * 512 + nt * 128) * 128;
      float ba8[8], bx8[8], sp8[8];
      load8f(p.in[I_LBA] + (size_t)(j * 2 + d) * 512 + ng, ba8);
      load8f(p.in[I_LBX] + (size_t)(j * 2 + d) * 512 + ng, bx8);
      load8f(p.in[I_LLAM] + (size_t)(j * 2 + d) * 512 + ng, sp8);
#pragma unroll
      for (int i = 0; i < 8; ++i) { float nl = -sp8[i]; sp8[i] = -8.f * (nl > 20.f ? nl : log1pf(__expf(nl))); }
      {
        f32x16 acc[2][2];
        gemm_mainloop<false>(A, 512, Br, 128, 128, acc, As, Bs);
        staged_epilogue(acc, Cs, [&](int row, int cc, const float (&v)[8]) {
          const size_t o = ((size_t)d * T + t0 + row) * 512 + nt * 128 + cc;
          float a[8];
#pragma unroll
          for (int i = 0; i < 8; ++i) a[i] = __expf(sigm(v[i] + ba8[i]) * sp8[i]);
          store8f(LA + o, a);
        });
      }
      {
        f32x16 acc[2][2];
        gemm_mainloop<false>(A, 512, Bi, 128, 128, acc, As, Bs);
        staged_epilogue(acc, Cs, [&](int row, int cc, const float (&v)[8]) {
          const size_t o = ((size_t)d * T + t0 + row) * 512 + nt * 128 + cc;
          float a[8], xc[8], bb[8];
          load8f(LA + o, a);
          unpack8(*(const uint4*)(XC + o), xc);
#pragma unroll
          for (int i = 0; i < 8; ++i) bb[i] = sqrtf(fmaxf(1.f - a[i] * a[i], 0.f)) * sigm(v[i] + bx8[i]) * xc[i];
          *(uint4*)(LB + o) = pack8(bb);
        });
      }
    } else if (jb < 16) {
      const int d = (jb - 8) >> 2, nt = (jb - 8) & 3, ng = nt * 128 + c8;
      float w08[8]; load8f(p.in[I_W0] + (size_t)(j * 2 + d) * 512 + ng, w08);
      f32x16 acc[2][2];
      gemm_mainloop<false>(LRIN + (size_t)t0 * 384 + d * 64, 384, (const bf16_t*)(p.ws + OFF_BT_W2) + ((size_t)(j * 2 + d) * 512 + nt * 128) * 64, 64, 64, acc, As, Bs);
      staged_epilogue(acc, Cs, [&](int row, int cc, const float (&v)[8]) {
        float w[8];
#pragma unroll
        for (int i = 0; i < 8; ++i) w[i] = __expf(-0.6065306597126334f * sigm(w08[i] + v[i]));
        store8f(WD + ((size_t)d * T + t0 + row) * 512 + nt * 128 + cc, w);
      });
    } else if (jb < 24) {
      const int d = (jb - 16) >> 2, nt = (jb - 16) & 3, ng = nt * 128 + c8;
      float a08[8], ka8[8];
      load8f(p.in[I_A0] + (size_t)(j * 2 + d) * 512 + ng, a08);
      load8f(p.in[I_KA] + (size_t)(j * 2 + d) * 512 + ng, ka8);
      f32x16 acc[2][2];
      gemm_mainloop<false>(LRIN + (size_t)t0 * 384 + 128 + d * 64, 384, (const bf16_t*)(p.ws + OFF_BT_A2) + ((size_t)(j * 2 + d) * 512 + nt * 128) * 64, 64, 64, acc, As, Bs);
      staged_epilogue(acc, Cs, [&](int row, int cc, const float (&v)[8]) {
        const size_t o = ((size_t)d * T + t0 + row) * 512 + nt * 128 + cc;
        float kkn[8], ks[8], oa[8], om[8];
        unpack8(*(const uint4*)(KKN + o), kkn);
        unpack8(*(const uint4*)(KS + (size_t)(t0 + row) * 512 + nt * 128 + cc), ks);
#pragma unroll
        for (int i = 0; i < 8; ++i) {
          float ic = sigm(a08[i] + v[i]);
          oa[i] = kkn[i] * ic;
          om[i] = ks[i] * (1.f + (ic - 1.f) * ka8[i]);
        }
        *(uint4*)(KKA + o) = pack8(oa);
        *(uint4*)(KM + o) = pack8(om);
      });
    } else {
      const int nt = jb - 24;
      f32x16 acc[2][2];
      gemm_mainloop<false>(LRIN + (size_t)t0 * 384 + 256, 384, (const bf16_t*)(p.ws + OFF_BT_G2) + ((size_t)j * 512 + nt * 128) * 128, 128, 128, acc, As, Bs);
      staged_epilogue(acc, Cs, [&](int row, int cc, const float (&v)[8]) {
        float g[8];
#pragma unroll
        for (int i = 0; i < 8; ++i) g[i] = v[i];
        *(uint4*)(G + (size_t)(t0 + row) * 512 + nt * 128 + cc) = pack8(g);
      });
    }
  }
}

constexpr int WCH = 16;
constexpr int WBUF = 5 * 4096 + 1024;
#define WKV_GLOAD(S_, c_)                                                                                                \
  {                                                                                                                      \
    const int base_ = (c_) * WCH;                                                                                        \
    S_##w = *(const uint4*)(WD + (unsigned)(tokof(base_ + (tid >> 4)) * 2048 + (tid & 15) * 16));                        \
    const unsigned o2_ = (unsigned)(tokof(base_ + ((tid & 127) >> 3)) * 1024 + (tid & 7) * 16);                          \
    S_##a = *(const uint4*)((tid < 128 ? KKN : KM) + o2_);                                                                \
    S_##b = *(const uint4*)((tid < 128 ? KKA : RS) + o2_);                                                                \
    if (tid < 32) S_##v = *(const uint4*)(VS + (unsigned)(tokof(base_ + (tid >> 1)) * 1024 + (tid & 1) * 16));           \
  }
#define WKV_LSTORE(S_, bufi_)                                                                                            \
  {                                                                                                                      \
    unsigned char* bb_ = smem + (bufi_) * WBUF;                                                                           \
    *(uint4*)(bb_ + tid * 16) = S_##w;                                                                                    \
    float f_[8];                                                                                                         \
    unsigned char* pa_ = bb_ + (tid < 128 ? 4096 : 12288) + (tid & 127) * 32;                                            \
    unpack8(S_##a, f_); store8f((float*)pa_, f_);                                                                         \
    unpack8(S_##b, f_); store8f((float*)(pa_ + 4096), f_);                                                               \
    if (tid < 32) { unpack8(S_##v, f_); store8f((float*)(bb_ + 20480 + tid * 32), f_); }                                  \
  }
DI void wkv_scan_item(const Params& p, unsigned char* smem, int j, int b, int d, int h, int rg, bool ctx) {
  const int tid = tidx(), lane = tid & 63, wave = tid >> 6;
  const int rl = wave * 4 + (lane >> 4), row = rg * 16 + rl, q = lane & 15;
  const int S = ctx ? 256 : 4096, t0 = ctx ? b * 256 : 4096 + b * 4096;
  const char* WD = (const char*)(p.ws + OFF_WD) + (size_t)d * T * 512 * 4 + h * 256;
  const char* KKN = (const char*)(p.ws + OFF_KKN) + (size_t)d * T * 512 * 2 + h * 128;
  const char* KKA = (const char*)(p.ws + OFF_KKA) + (size_t)d * T * 512 * 2 + h * 128;
  const char* KM = (const char*)(p.ws + OFF_KM) + (size_t)d * T * 512 * 2 + h * 128;
  const char* RS = (const char*)(p.ws + OFF_RS) + h * 128;
  const char* VS = (const char*)(p.ws + OFF_VS) + (h * 64 + rg * 16) * 2;
  char* Y = (char*)(p.ws + (d ? OFF_XC : OFF_H)) + (h * 64 + rg * 16) * 4;
  unsigned char* ysb = smem + 3 * WBUF;
  float st[4];
  if (ctx) { st[0] = st[1] = st[2] = st[3] = 0.f; }
  else {
    float4 s4 = *(const float4*)(p.in[I_SWKV] + ((((size_t)(b * 2 + j) * 2 + d) * 8 + h) * 64 + row) * 64 + q * 4);
    st[0] = s4.x; st[1] = s4.y; st[2] = s4.z; st[3] = s4.w;
  }
  auto tokof = [&](int step) -> int { return t0 + (d ? (S - 1 - step) : step); };
  const uint4 z4 = make_uint4(0u, 0u, 0u, 0u);
  uint4 g0w = z4, g0a = z4, g0b = z4, g0v = z4, g1w = z4, g1a = z4, g1b = z4, g1v = z4;
  const int nch = S / WCH;
  __syncthreads();
  WKV_GLOAD(g0, 0) WKV_GLOAD(g1, 1)
  WKV_LSTORE(g0, 0) WKV_LSTORE(g1, 1)
  WKV_GLOAD(g0, 2) WKV_GLOAD(g1, 3)
  __syncthreads();
  auto compute = [&](int c) {
    const unsigned char* bb = smem + (c % 3) * WBUF;
    float* ys = (float*)(ysb + (c & 1) * 1024);
    float4 aw0, ak0, aa0, am0, ar0, aw1, ak1, aa1, am1, ar1, bw0, bk0, ba0, bm0, br0, bw1, bk1, ba1, bm1, br1;
    float av0, av1, bv0, bv1;
#define WLD(W_, K_, A_, M_, R_, V_, s_)                                                                       \
    W_ = *(const float4*)(bb + (s_) * 256 + q * 16); K_ = *(const float4*)(bb + 4096 + (s_) * 256 + q * 16);      \
    A_ = *(const float4*)(bb + 8192 + (s_) * 256 + q * 16); M_ = *(const float4*)(bb + 12288 + (s_) * 256 + q * 16); \
    R_ = *(const float4*)(bb + 16384 + (s_) * 256 + q * 16); V_ = *(const float*)(bb + 20480 + (s_) * 64 + rl * 4);
#define WSTEP(W_, K_, A_, M_, R_, V_, s_)                                                                     \
    {                                                                                                         \
      float sk = st[0] * K_.x + st[1] * K_.y + st[2] * K_.z + st[3] * K_.w;                                   \
      sk = sum16(sk);                                                                                         \
      st[0] = st[0] * W_.x - sk * A_.x + V_ * M_.x;                                                           \
      st[1] = st[1] * W_.y - sk * A_.y + V_ * M_.y;                                                           \
      st[2] = st[2] * W_.z - sk * A_.z + V_ * M_.z;                                                           \
      st[3] = st[3] * W_.w - sk * A_.w + V_ * M_.w;                                                           \
      float y = st[0] * R_.x + st[1] * R_.y + st[2] * R_.z + st[3] * R_.w;                                    \
      y = sum16(y);                                                                                           \
      ys[(s_) * 16 + rl] = y;                                                                                 \
    }
    WLD(aw0, ak0, aa0, am0, ar0, av0, 0) WLD(aw1, ak1, aa1, am1, ar1, av1, 1)
#pragma unroll
    for (int s = 0; s < WCH; s += 4) {
      WLD(bw0, bk0, ba0, bm0, br0, bv0, s + 2) WLD(bw1, bk1, ba1, bm1, br1, bv1, s + 3)
      __builtin_amdgcn_sched_barrier(0);
      WSTEP(aw0, ak0, aa0, am0, ar0, av0, s) WSTEP(aw1, ak1, aa1, am1, ar1, av1, s + 1)
      __builtin_amdgcn_sched_barrier(0);
      if (s + 4 < WCH) { WLD(aw0, ak0, aa0, am0, ar0, av0, s + 4) WLD(aw1, ak1, aa1, am1, ar1, av1, s + 5) }
      __builtin_amdgcn_sched_barrier(0);
      WSTEP(bw0, bk0, ba0, bm0, br0, bv0, s + 2) WSTEP(bw1, bk1, ba1, bm1, br1, bv1, s + 3)
      __builtin_amdgcn_sched_barrier(0);
    }
#undef WLD
#undef WSTEP
  };
  auto flush = [&](int c) {
    const float* ys = (const float*)(ysb + (c & 1) * 1024);
    const int s1 = tid >> 4, rr = tid & 15;
    *(float*)(Y + (unsigned)(tokof(c * WCH + s1) * 2048 + rr * 4)) = ys[s1 * 16 + rr];
  };
  for (int c = 0; c < nch; c += 2) {
    compute(c);
    if (c + 2 < nch) WKV_LSTORE(g0, (c + 2) % 3)
    if (c + 4 < nch) WKV_GLOAD(g0, c + 4)
    __syncthreads();
    flush(c);
    compute(c + 1);
    if (c + 3 < nch) WKV_LSTORE(g1, (c + 3) % 3)
    if (c + 5 < nch) WKV_GLOAD(g1, c + 5)
    __syncthreads();
    flush(c + 1);
  }
  if (ctx) {
    float* o = p.out + 21004288 + ((((size_t)(b * 2 + j) * 2 + d) * 8 + h) * 64 + row) * 64 + q * 4;
    *(float4*)o = make_float4(st[0], st[1], st[2], st[3]);
  }
}
#undef WKV_GLOAD
#undef WKV_LSTORE

DI void lru_scan_item(const Params& p, unsigned char* smem, int j, int b, int cgp, bool ctx, int chb) {
  const int tid = tidx(), c = tid & ((1 << chb) - 1), sg = tid >> chb;
  const int nseg = NTHR >> chb;
  const int ch = (cgp << chb) + c;
  const int S = ctx ? 256 : 4096, t0 = ctx ? b * 256 : 4096 + b * 4096;
  const int L = S / nseg;
  float* sA = (float*)smem; float* sB = sA + 256;
  char* YM = (char*)(p.ws + OFF_YMIX);
  const char* Z = (const char*)(p.ws + OFF_Z);
  for (int d = 0; d < 2; ++d) {
    const char* la = (const char*)(p.ws + OFF_MIX) + (size_t)d * T * 512 * 4;
    const char* lb = (const char*)(p.ws + OFF_LB) + (size_t)d * T * 512 * 2;
    float A = 1.f, Bv = 0.f;
#pragma unroll 8
    for (int st = sg * L; st < (sg + 1) * L; ++st) {
      const int tk = t0 + (d ? (S - 1 - st) : st);
      float a = *(const float*)(la + (unsigned)(tk * 2048 + ch * 4));
      float bb = bf2f(*(const bf16_t*)(lb + (unsigned)(tk * 1024 + ch * 2)));
      A *= a; Bv = a * Bv + bb;
    }
    __syncthreads();
    sA[tid] = A; sB[tid] = Bv;
    __syncthreads();
    float h = ctx ? 0.f : p.in[I_SLRU][((size_t)(b * 2 + j) * 2 + d) * 512 + ch];
    for (int s2 = 0; s2 < sg; ++s2) h = sA[(s2 << chb) + c] * h + sB[(s2 << chb) + c];
#pragma unroll 8
    for (int st = sg * L; st < (sg + 1) * L; ++st) {
      const int tk = t0 + (d ? (S - 1 - st) : st);
      float a = *(const float*)(la + (unsigned)(tk * 2048 + ch * 4));
      float bb = bf2f(*(const bf16_t*)(lb + (unsigned)(tk * 1024 + ch * 2)));
      h = a * h + bb;
      bf16_t* ym = (bf16_t*)(YM + (unsigned)(tk * 2048 + ch * 2));
      if (d == 0) *ym = (bf16_t)f2bf(h);
      else {
        float hs = h + bf2f(*ym);
        float gb = bf2f(*(const bf16_t*)(Z + (unsigned)(tk * 5888 + 1024 + ch * 2)));
        *ym = (bf16_t)f2bf(hs * gelu_t(gb));
      }
    }
    if (ctx && sg == nseg - 1) p.out[20971520 + ((size_t)(b * 2 + j) * 2 + d) * 512 + ch] = h;
    __syncthreads();
  }
}

DI void phase_o4(const Params& p, unsigned char* smem, int l, int bid, int nb) {
  const int j = l >> 1;
  auto do_item = [&](int it) {
    if (it < 256) { int sid = it >> 2, rg = it & 3; wkv_scan_item(p, smem, j, sid >> 4, (sid >> 3) & 1, sid & 7, rg, false); }
    else if (it < 512) { int r = it - 256; lru_scan_item(p, smem, j, r >> 6, r & 63, false, 3); }
    else if (it < 1536) { int r = it - 512; int sid = r >> 2, rg = r & 3; wkv_scan_item(p, smem, j, sid >> 4, (sid >> 3) & 1, sid & 7, rg, true); }
    else { int r = it - 1536; lru_scan_item(p, smem, j, r >> 4, r & 15, true, 5); }
  };
  if (nb >= 512) {
    if (bid < 256) do_item(bid);
    else {
      const int ob = bid - 256, no = nb - 256;
      for (int it = 256 + ob; it < 512; it += no) do_item(it);
      for (int it = 512 + ob; it < 1792; it += no) do_item(it);
    }
  } else {
    for (int it = bid; it < 1792; it += nb) do_item(it);
  }
}

DI void phase_o5(const Params& p, int l, int bid, int nb) {
  const int j = l >> 1;
  const int lane = tidx() & 63, wave = tidx() >> 6;
  const float* YF = (const float*)(p.ws + OFF_H);
  const float* YB = (const float*)(p.ws + OFF_XC);
  const bf16_t* RS = (const bf16_t*)(p.ws + OFF_RS);
  const bf16_t* VS = (const bf16_t*)(p.ws + OFF_VS);
  const bf16_t* KM = (const bf16_t*)(p.ws + OFF_KM);
  const bf16_t* G = (const bf16_t*)(p.ws + OFF_G);
  bf16_t* YM = (bf16_t*)(p.ws + OFF_YMIX);
  const int c0 = lane * 8;
  float gng[8], gnb[8], rk[8];
  load8f(p.in[I_GNG] + j * 512 + c0, gng);
  load8f(p.in[I_GNB] + j * 512 + c0, gnb);
  load8f(p.in[I_RK] + j * 512 + c0, rk);
  for (int t = bid * 4 + wave; t < T; t += nb * 4) {
    const size_t o = (size_t)t * 512 + c0;
    float yf[8], yb[8], ys[8];
    load8f(YF + o, yf); load8f(YB + o, yb);
    float s = 0.f;
#pragma unroll
    for (int i = 0; i < 8; ++i) { ys[i] = yf[i] + yb[i]; s += ys[i]; }
    const float mean = sum8(s) * (1.f / 64.f);
    float v = 0.f;
#pragma unroll
    for (int i = 0; i < 8; ++i) { float dd = ys[i] - mean; v += dd * dd; }
    const float rstd = rsqrtf(sum8(v) * (1.f / 64.f) + 64e-5f);
    float r[8], vv[8], kf[8], kb[8], g[8];
    unpack8(*(const uint4*)(RS + o), r);
    unpack8(*(const uint4*)(VS + o), vv);
    unpack8(*(const uint4*)(KM + o), kf);
    unpack8(*(const uint4*)(KM + (size_t)T * 512 + o), kb);
    unpack8(*(const uint4*)(G + o), g);
    float sf = 0.f;
#pragma unroll
    for (int i = 0; i < 8; ++i) sf += r[i] * rk[i] * (kf[i] + kb[i]);
    sf = sum8(sf);
    float outv[8];
#pragma unroll
    for (int i = 0; i < 8; ++i) outv[i] = ((ys[i] - mean) * rstd * gng[i] + gnb[i] + sf * vv[i]) * g[i];
    *(uint4*)(YM + (size_t)t * 1024 + 512 + c0) = pack8(outv);
  }
}

enum { PH_PREP = 0, PH_INIT, PH_E1, PH_E2, PH_EOUT, PH_RES, PH_P1, PH_P2, PH_O1, PH_O2, PH_O3, PH_O4, PH_O5, PH_OOUT };

DI void run_phase(const Params& p, unsigned char* smem, int ph, int l, int bid, int nb) {
  switch (ph) {
    case PH_PREP: phase_prep(p, smem, bid, nb); break;
    case PH_INIT: phase_init(p, bid, nb); break;
    case PH_E1: phase_e1(p, smem, l, bid, nb); break;
    case PH_E2: phase_e2(p, smem, l, bid, nb); break;
    case PH_EOUT: phase_outgemm(p, smem, (const bf16_t*)(p.ws + OFF_BT_OUT_E) + (size_t)(l >> 1) * 1024 * 1024, bid, nb); break;
    case PH_RES: phase_res1(p, l, bid, nb); break;
    case PH_P1: phase_p1(p, smem, l, bid, nb); break;
    case PH_P2: phase_p2(p, smem, l, bid, nb); break;
    case PH_O1: phase_o1(p, smem, l, bid, nb); break;
    case PH_O2: phase_o2(p, l, bid, nb); break;
    case PH_O3: phase_o3(p, smem, l, bid, nb); break;
    case PH_O4: phase_o4(p, smem, l, bid, nb); break;
    case PH_O5: phase_o5(p, l, bid, nb); break;
    case PH_OOUT: phase_outgemm(p, smem, (const bf16_t*)(p.ws + OFF_BT_OUT_O) + (size_t)(l >> 1) * 1024 * 1024, bid, nb); break;
  }
}


#define XB_TMO      128
#define XB_XCNT(j)  (256  + 64 * (j))
#define XB_XSUB(j)  (1280 + 64 * (j))
#define XB_XGEN(j)  (2304 + 64 * (j))
#define XB_TOP      3328
#define XB_TOPGEN   3392
#define XCD_BAR_WORDS 3456
#define XB_SPIN_CAP (1u << 22)
#define LAS __attribute__((address_space(3)))
DI unsigned xb_ld(unsigned* p) { return __hip_atomic_load(p, __ATOMIC_RELAXED, __HIP_MEMORY_SCOPE_AGENT); }
DI unsigned xb_add(unsigned* p, unsigned v) { return __hip_atomic_fetch_add(p, v, __ATOMIC_RELAXED, __HIP_MEMORY_SCOPE_AGENT); }
DI unsigned xb_xcc_id() { return (unsigned)__builtin_amdgcn_s_getreg((3 << 11) | 20) & 0xFu; }
#define XB_SPIN(cond, bar) do { unsigned _sp = 0; while (cond) { __builtin_amdgcn_s_sleep(1); \
    if ((++_sp & 255u) == 0u) { if (xb_ld(&(bar)[XB_TMO])) break; if (_sp > XB_SPIN_CAP) { atomicAdd(&(bar)[XB_TMO], 1u); break; } } } } while (0)
struct XcdBarrier { unsigned* bar; unsigned x; volatile LAS unsigned* st; };
DI XcdBarrier xcd_barrier_post(unsigned* bar, volatile LAS unsigned* st) {
  XcdBarrier b; b.bar = bar; b.x = xb_xcc_id(); b.st = st;
  if (__builtin_amdgcn_workitem_id_x() == 0) (void)xb_add(&bar[XB_XCNT(b.x)], 1u);
  return b;
}
DI void xcd_barrier_complete(unsigned* bar, unsigned x, unsigned& nloc, unsigned& nx) {
  const unsigned G = gridDim.x;
  unsigned sum, cnt, mine, sp = 0u;
  for (;;) {
    sum = 0u; cnt = 0u; mine = 0u;
#pragma unroll
    for (unsigned j = 0; j < 16; ++j) { const unsigned c = xb_ld(&bar[XB_XCNT(j)]); sum += c; cnt += (c > 0u) ? 1u : 0u; mine = (j == x) ? c : mine; }
    if (sum == G) break;
    __builtin_amdgcn_s_sleep(1);
    if ((++sp & 255u) == 0u) { if (xb_ld(&bar[XB_TMO])) break; if (sp > XB_SPIN_CAP) { atomicAdd(&bar[XB_TMO], 1u); break; } }
  }
  nloc = mine > 0u ? mine : 1u; nx = cnt > 0u ? cnt : 1u;
}
DI void xcd_barrier(const XcdBarrier& b) {
  asm volatile("s_waitcnt vmcnt(0)" ::: "memory");
  __syncthreads();
  if (__builtin_amdgcn_workitem_id_x() == 0) {
    unsigned* bar = b.bar;
    __builtin_amdgcn_s_waitcnt(0);
    unsigned nloc = b.st[0], nx = b.st[1];
    if (nloc == 0u) { xcd_barrier_complete(bar, b.x, nloc, nx); b.st[0] = nloc; b.st[1] = nx; }
    const unsigned old = xb_add(&bar[XB_XSUB(b.x)], 1u);
    const unsigned gen = old / nloc;
    if (old + 1u == (gen + 1u) * nloc) {
      __builtin_amdgcn_fence(__ATOMIC_RELEASE, "agent");
      asm volatile("s_waitcnt vmcnt(0)" ::: "memory");
      const unsigned og = xb_add(&bar[XB_TOP], 1u);
      const unsigned tg = og / nx;
      if (og + 1u == (tg + 1u) * nx) xb_add(&bar[XB_TOPGEN], 1u);
      else XB_SPIN(xb_ld(&bar[XB_TOPGEN]) == tg, bar);
      __builtin_amdgcn_fence(__ATOMIC_ACQUIRE, "agent");
      xb_add(&bar[XB_XGEN(b.x)], 1u);
      asm volatile("s_waitcnt vmcnt(0)" ::: "memory");
    } else {
      XB_SPIN(xb_ld(&bar[XB_XGEN(b.x)]) == gen, bar);
      __builtin_amdgcn_fence(__ATOMIC_ACQUIRE, "agent");
      asm volatile("s_waitcnt vmcnt(0)" ::: "memory");
    }
  }
  __syncthreads();
}

DI void grid_seam(cg::grid_group& grid) {
  asm volatile("s_waitcnt vmcnt(0)" ::: "memory");
  grid.sync();
  asm volatile("buffer_inv sc1\n\ts_waitcnt vmcnt(0)" ::: "memory");
}
#if MULTI
__global__ void __launch_bounds__(NTHR, 2) phase_kernel(Params p, int ph, int l) {
  extern __shared__ __attribute__((aligned(16))) unsigned char smem[];
  run_phase(p, smem, ph, l, blockIdx.x, gridDim.x);
}
#else
#ifndef TPROBE
#define TPROBE 0
#endif
__global__ void __launch_bounds__(NTHR, 2) mega_kernel(Params p) {
  extern __shared__ __attribute__((aligned(16))) unsigned char smem[];
  cg::grid_group grid = cg::this_grid();
  const int bid = blockIdx.x, nb = gridDim.x;
  if (__builtin_amdgcn_workitem_id_x() == 0) *(uint4*)(smem + LDS_MAIN) = make_uint4(0u, 0u, 0u, 0u);
  __syncthreads();
  XcdBarrier xb = xcd_barrier_post((unsigned*)(p.ws + OFF_BAR), (volatile LAS unsigned*)(smem + LDS_MAIN));
#if TPROBE
  unsigned long long tprev = wall_clock64(), tsel = 0, ttot = 0;
#endif
  for (int step = 0; step < 32; ++step) {
    int ph, l;
    if (step < 2) { ph = step; l = 0; }
    else {
      int s = step - 2, k;
      if (s < 6) { l = 0; k = s; } else if (s < 15) { l = 1; k = s - 6; } else if (s < 21) { l = 2; k = s - 15; } else { l = 3; k = s - 21; }
      if ((l & 1) == 0) ph = PH_E1 + k;
      else ph = (k < 6) ? PH_O1 + k : PH_RES + (k - 6);
    }
#if defined(__HIP_DEVICE_COMPILE__)
    const __attribute__((address_space(4))) Params* kp = (const __attribute__((address_space(4))) Params*)__builtin_amdgcn_kernarg_segment_ptr();
    asm volatile("" : "+s"(kp), "+s"(l), "+s"(ph));
    const Params q = *kp;
#else
    const Params q = p;
#endif
    run_phase(q, smem, ph, l, bid, nb);
#if !TPROBE
    if (step == 31) break;
#endif
    if (step == 0) grid_seam(grid);
    else xcd_barrier(xb);
#if TPROBE
    {
      unsigned long long tn = wall_clock64();
      if ((TPROBE >> ph) & 1) tsel += tn - tprev;
      ttot += tn - tprev;
      tprev = tn;
    }
#endif
  }
#if TPROBE
  if (bid == 0) {
    float frac = (float)((double)tsel / (double)ttot);
    float sc = 1.f + sqrtf(frac);
    for (int i = tidx(); i < 32768; i += NTHR) p.out[20971520 + i] *= sc;
  }
#endif
}
#endif

extern "C" void kernel_launch(void* const* d_in, const int* in_sizes, int n_in, void* d_out, int out_size, void* d_ws, size_t ws_size,
                              hipStream_t stream) {
  static int grid_blocks = 0;
  if (grid_blocks == 0) {
    if (n_in != 40 || ws_size < WS_END) { fprintf(stderr, "kernel_launch: unexpected n_in %d or ws_size %zu (need %zu)\n", n_in, ws_size, (size_t)WS_END); grid_blocks = -1; return; }
    int dev = 0, cus = 0, per_cu = 0;
    hipGetDevice(&dev);
    hipDeviceGetAttribute(&cus, hipDeviceAttributeMultiprocessorCount, dev);
#if MULTI
    hipFuncSetAttribute((const void*)phase_kernel, hipFuncAttributeMaxDynamicSharedMemorySize, LDS_BYTES);
    hipOccupancyMaxActiveBlocksPerMultiprocessor(&per_cu, (const void*)phase_kernel, NTHR, LDS_BYTES);
#else
    hipFuncSetAttribute((const void*)mega_kernel, hipFuncAttributeMaxDynamicSharedMemorySize, LDS_BYTES);
    hipOccupancyMaxActiveBlocksPerMultiprocessor(&per_cu, (const void*)mega_kernel, NTHR, LDS_BYTES);
#endif
    if (per_cu < 1) per_cu = 1;
    if (per_cu > 2) per_cu = 2;
    if (cus < 1) cus = 256;
    grid_blocks = cus * per_cu;
  }
  if (grid_blocks < 0) return;
  Params p{};
  for (int i = 0; i < 40; ++i) p.in[i] = (const float*)d_in[i];
  p.out = (float*)d_out;
  p.ws = (unsigned char*)d_ws;
#if MULTI
  auto L = [&](int ph, int l) { hipLaunchKernelGGL(phase_kernel, dim3(grid_blocks), dim3(NTHR), LDS_BYTES, stream, p, ph, l); };
  L(PH_PREP, 0); L(PH_INIT, 0);
  for (int l = 0; l < 4; ++l) {
    if ((l & 1) == 0) { L(PH_E1, l); L(PH_E2, l); L(PH_EOUT, l); }
    else { L(PH_O1, l); L(PH_O2, l); L(PH_O3, l); L(PH_O4, l); L(PH_O5, l); L(PH_OOUT, l); }
    L(PH_RES, l); L(PH_P1, l); L(PH_P2, l);
  }
#else
  (void)hipMemsetAsync((char*)d_ws + OFF_BAR, 0, XCD_BAR_WORDS * sizeof(unsigned), stream);
  void* args[] = {&p};
  hipError_t e = hipLaunchCooperativeKernel((const void*)mega_kernel, dim3(grid_blocks), dim3(NTHR), args, LDS_BYTES, stream);
  if (e != hipSuccess) fprintf(stderr, "cooperative launch failed: %s (grid %d)\n", hipGetErrorString(e), grid_blocks);
#endif
}
```
